# Optimizing an MI355X kernel written in HIP

```python
import math
import jax, jax.numpy as jnp
from jax import lax
import numpy as np


D_MODEL = 1024
BATCH = 8
SEQ = 2048
DEPTH = 4

CHUNK = 64
D_MIX = D_MODEL
D_MLSTM = D_MIX // 2
D_S5 = D_MIX - D_MLSTM
MLSTM_HEADS = 4
MLSTM_HEAD_DIM = D_MLSTM // MLSTM_HEADS
CONV_WIDTH = 4
S5_GROUP = 16
S5_GROUPS = D_S5 // S5_GROUP
S5_STATE = 64
PLE_DIM = 256
N_EXPERT_GROUPS = 4
EXPERTS_PER_GROUP = 8
N_EXPERTS = N_EXPERT_GROUPS * EXPERTS_PER_GROUP
TOP_K = 2
D_EXPERT = D_MODEL // 2
MOE_BLOCK = 128
D_IN = 3 * D_MLSTM + 2 * MLSTM_HEADS + D_S5
DEEPNORM_ALPHA = (2 * DEPTH) ** 0.25
DEEPNORM_BETA = (8 * DEPTH) ** -0.25
EPS = 1e-5

kernel_name = 'hybrid_mlstm_s5_hmoe_deepnorm'


def layer_norm(x, g, b):
    xf = x.astype(jnp.float32)
    mu = xf.mean(-1, keepdims=True)
    var = jnp.square(xf - mu).mean(-1, keepdims=True)
    y = (xf - mu) * lax.rsqrt(var + EPS) * g.astype(jnp.float32) + b.astype(jnp.float32)
    return y.astype(x.dtype)


def rms_norm(x, g):
    xf = x.astype(jnp.float32)
    y = xf * lax.rsqrt(jnp.mean(xf * xf, -1, keepdims=True) + EPS) * g.astype(jnp.float32)
    return y.astype(x.dtype)


def head_norm(h, g):
    B, S, H, Dh = h.shape
    mu = h.mean(-1, keepdims=True)
    var = jnp.square(h - mu).mean(-1, keepdims=True)
    y = ((h - mu) * lax.rsqrt(var + EPS)).reshape(B, S, H * Dh)
    return y * g.astype(jnp.float32)


def causal_conv(u, w, b):
    C = u.shape[-1]
    y = lax.conv_general_dilated(u, w[:, None, :].astype(u.dtype), window_strides=(1,),
                                 padding=[(CONV_WIDTH - 1, 0)],
                                 dimension_numbers=('NWC', 'WIO', 'NWC'),
                                 feature_group_count=C)
    return y + b.astype(u.dtype)


def mlstm_chunkwise(q, k, v, i_pre, f_pre):
    B, S, H, Dh = q.shape
    NC = S // CHUNK
    f32 = jnp.float32

    def chunks(t):
        return t.astype(f32).reshape(B, NC, CHUNK, H, -1).transpose(0, 3, 1, 2, 4)

    qc, kc, vc = chunks(q), chunks(k), chunks(v)
    ig = chunks(i_pre[..., None])[..., 0]
    lf = jax.nn.log_sigmoid(chunks(f_pre[..., None])[..., 0])
    bcum = jnp.cumsum(lf, axis=-1)
    g = bcum[..., -1]
    a = g[..., None] - bcum + ig
    m_loc = a.max(-1)
    wk = jnp.exp(a - m_loc[..., None])[..., None] * kc
    chunk_C = jnp.einsum('bhcsk,bhcsv->bhckv', wk, vc)
    chunk_n = wk.sum(-2)

    def step(carry, inp):
        C, n, m = carry
        g_c, ml, Cc, nc = inp
        m_new = jnp.maximum(g_c + m, ml)
        s_old = jnp.exp(g_c + m - m_new)
        s_new = jnp.exp(ml - m_new)
        C_new = s_old[..., None, None] * C + s_new[..., None, None] * Cc
        n_new = s_old[..., None] * n + s_new[..., None] * nc
        return (C_new, n_new, m_new), (C, n, m)

    init = (jnp.zeros((B, H, Dh, Dh), f32), jnp.zeros((B, H, Dh), f32), jnp.zeros((B, H), f32))
    xs = (jnp.moveaxis(g, 2, 0), jnp.moveaxis(m_loc, 2, 0),
          jnp.moveaxis(chunk_C, 2, 0), jnp.moveaxis(chunk_n, 2, 0))
    _, (C_prev, n_prev, m_prev) = lax.scan(step, init, xs)
    C_prev = jnp.moveaxis(C_prev, 0, 2)
    n_prev = jnp.moveaxis(n_prev, 0, 2)
    m_prev = jnp.moveaxis(m_prev, 0, 2)

    causal = jnp.tril(jnp.ones((CHUNK, CHUNK), bool))
    log_d = jnp.where(causal, bcum[..., :, None] - bcum[..., None, :] + ig[..., None, :], -jnp.inf)
    log_inter = bcum + m_prev[..., None]
    m_t = jnp.maximum(log_inter, log_d.max(-1))
    s = jnp.einsum('bhctd,bhcsd->bhcts', qc, kc) * jnp.exp(log_d - m_t[..., None])
    inter = jnp.exp(log_inter - m_t)
    num = (jnp.einsum('bhcts,bhcsv->bhctv', s, vc)
           + inter[..., None] * jnp.einsum('bhctk,bhckv->bhctv', qc, C_prev))
    den = s.sum(-1) + inter * jnp.einsum('bhctk,bhck->bhct', qc, n_prev)
    den = jnp.maximum(jnp.abs(den), jnp.exp(-m_t))
    h = num / den[..., None]
    return h.transpose(0, 2, 3, 1, 4).reshape(B, S, H, Dh)


def complex_affine(e1, e2):
    a1r, a1i, b1r, b1i = e1
    a2r, a2i, b2r, b2i = e2
    return (a2r * a1r - a2i * a1i, a2r * a1i + a2i * a1r,
            a2r * b1r - a2i * b1i + b2r, a2r * b1i + a2i * b1r + b2i)


def s5_glu(u, lam_re, lam_im, log_dt, b_re, b_im, c_re, c_im, d_skip, w_glu, b_glu):
    B, S, _ = u.shape
    f32 = jnp.float32
    uf = u.astype(f32).reshape(B, S, S5_GROUPS, S5_GROUP)
    lr, li = lam_re.astype(f32), lam_im.astype(f32)
    dt = jnp.exp(log_dt.astype(f32))[:, None]
    er = jnp.exp(lr * dt)
    ar, ai = er * jnp.cos(li * dt), er * jnp.sin(li * dt)
    mag2 = lr * lr + li * li
    xr, xi = ar - 1.0, ai
    cr = (xr * lr + xi * li) / mag2
    ci = (xi * lr - xr * li) / mag2
    br, bi = b_re.astype(f32), b_im.astype(f32)
    bbr = cr[..., None] * br - ci[..., None] * bi
    bbi = cr[..., None] * bi + ci[..., None] * br
    bur = jnp.einsum('bsgc,gpc->bsgp', uf, bbr)
    bui = jnp.einsum('bsgc,gpc->bsgp', uf, bbi)
    a_r = jnp.broadcast_to(ar, bur.shape)
    a_i = jnp.broadcast_to(ai, bur.shape)
    _, _, sr, si = lax.associative_scan(complex_affine, (a_r, a_i, bur, bui), axis=1)
    y = (jnp.einsum('bsgp,gcp->bsgc', sr, c_re.astype(f32))
         - jnp.einsum('bsgp,gcp->bsgc', si, c_im.astype(f32))
         + d_skip.astype(f32) * uf).reshape(B, S, D_S5)
    gy = jax.nn.gelu(y)
    out = gy * jax.nn.sigmoid(gy @ w_glu.astype(f32) + b_glu.astype(f32))
    return out


def mixer(x, w_in, conv_w, conv_b, w_q, w_k, b_i, b_f, mh_g, lam_re, lam_im, log_dt,
          b_re, b_im, c_re, c_im, d_skip, w_glu, b_glu, s5_g, w_out):
    B, S, _ = x.shape
    H, Dh = MLSTM_HEADS, MLSTM_HEAD_DIM
    z = x @ w_in
    u_m, v, o_pre, i_pre, f_pre, u_s = jnp.split(
        z, [D_MLSTM, 2 * D_MLSTM, 3 * D_MLSTM, 3 * D_MLSTM + H, 3 * D_MLSTM + 2 * H], axis=-1)
    c = jax.nn.silu(causal_conv(u_m, conv_w, conv_b)).reshape(B, S, H, Dh)
    q = jnp.einsum('bshd,hde->bshe', c, w_q)
    k = jnp.einsum('bshd,hde->bshe', c, w_k) * (Dh ** -0.5)
    h = mlstm_chunkwise(q, k, v.reshape(B, S, H, Dh), i_pre + b_i, f_pre + b_f)
    h = jax.nn.sigmoid(o_pre.astype(jnp.float32)).reshape(B, S, H, Dh) * h
    y_m = head_norm(h, mh_g).astype(x.dtype)
    y_s = rms_norm(s5_glu(u_s, lam_re, lam_im, log_dt, b_re, b_im, c_re, c_im, d_skip,
                          w_glu, b_glu), s5_g).astype(x.dtype)
    return jnp.concatenate([y_m, y_s], axis=-1) @ w_out


def expert_dispatch(xf, e_idx, e_w, w_eg, w_eu, w_ed):
    M, D = xf.shape
    E = w_eg.shape[0]
    A = M * TOP_K
    flat_e = e_idx.reshape(A)
    flat_t = jnp.repeat(jnp.arange(M, dtype=jnp.int32), TOP_K)
    flat_w = e_w.reshape(A)
    order = jnp.argsort(flat_e)
    se, st, sw = flat_e[order], flat_t[order], flat_w[order]
    counts = jnp.bincount(flat_e, length=E)
    starts = jnp.cumsum(counts) - counts
    pcounts = (counts + MOE_BLOCK - 1) // MOE_BLOCK * MOE_BLOCK
    pends = jnp.cumsum(pcounts)
    pstarts = pends - pcounts
    dest = pstarts[se] + (jnp.arange(A) - starts[se])
    NB = -(-A // MOE_BLOCK) + E
    P = NB * MOE_BLOCK
    buf_t = jnp.full((P,), M, jnp.int32).at[dest].set(st)
    buf_w = jnp.zeros((P,), xf.dtype).at[dest].set(sw)
    blk_e = jnp.clip(jnp.searchsorted(pends, jnp.arange(NB) * MOE_BLOCK, side='right'), 0, E - 1)
    xpad = jnp.concatenate([xf, jnp.zeros((1, D), xf.dtype)], axis=0)

    def run_block(args):
        tok, w, e = args
        xb = xpad[tok]
        hb = jax.nn.silu(xb @ w_eg[e]) * (xb @ w_eu[e])
        return (hb @ w_ed[e]) * w[:, None]

    out = lax.map(run_block, (buf_t.reshape(NB, MOE_BLOCK), buf_w.reshape(NB, MOE_BLOCK), blk_e))
    y = jnp.zeros((M + 1, D), xf.dtype).at[buf_t].add(out.reshape(P, D))
    return y[:M]


def moe_ffn(x, w_grp, b_grp, w_rt, b_rt, w_eg, w_eu, w_ed):
    B, S, D = x.shape
    M = B * S
    xf = x.reshape(M, D)
    grp_prob = jax.nn.softmax((xf @ w_grp + b_grp).astype(jnp.float32), axis=-1)
    grp = jnp.argmax(grp_prob, axis=-1).astype(jnp.int32)
    p_grp = jnp.take_along_axis(grp_prob, grp[:, None], axis=-1)
    e_logits = (xf @ w_rt + b_rt).astype(jnp.float32).reshape(M, N_EXPERT_GROUPS, EXPERTS_PER_GROUP)
    e_in = jnp.take_along_axis(e_logits, grp[:, None, None], axis=1)[:, 0]
    top_v, top_i = lax.top_k(e_in, TOP_K)
    e_w = (p_grp * jax.nn.softmax(top_v, axis=-1)).astype(x.dtype)
    e_idx = grp[:, None] * EXPERTS_PER_GROUP + top_i.astype(jnp.int32)
    return expert_dispatch(xf, e_idx, e_w, w_eg, w_eu, w_ed).reshape(B, S, D)


def setup_inputs(seed: int = 0) -> dict:
    key = jax.random.key(seed)
    ks = iter(jax.random.split(key, 48))
    L, H, Dh, G, P = DEPTH, MLSTM_HEADS, MLSTM_HEAD_DIM, S5_GROUPS, S5_STATE

    def nrm(shape, scale):
        return scale * jax.random.normal(next(ks), shape, jnp.float32)

    d = {}
    d['x'] = nrm((BATCH, SEQ, D_MODEL), 1.0)
    d['p'] = nrm((DEPTH, BATCH, SEQ, PLE_DIM), 1.0)
    d['w_in'] = nrm((L, D_MODEL, D_IN), D_MODEL ** -0.5)
    d['conv_w'] = nrm((L, CONV_WIDTH, D_MLSTM), CONV_WIDTH ** -0.5)
    d['conv_b'] = nrm((L, D_MLSTM), 0.02)
    d['w_q'] = nrm((L, H, Dh, Dh), Dh ** -0.5)
    d['w_k'] = nrm((L, H, Dh, Dh), Dh ** -0.5)
    d['b_i'] = nrm((L, H), 0.1)
    d['b_f'] = jnp.linspace(3.0, 6.0, H, dtype=jnp.float32)[None, :] + nrm((L, H), 0.1)
    d['mh_g'] = 1.0 + nrm((L, D_MLSTM), 0.02)
    d['lam_re'] = -0.5 + nrm((L, G, P), 0.01)
    d['lam_im'] = jnp.pi * jnp.arange(P, dtype=jnp.float32)[None, None, :] + nrm((L, G, P), 0.01)
    d['log_dt'] = jax.random.uniform(next(ks), (L, G), jnp.float32, math.log(1e-3), math.log(1e-1))
    d['b_re'] = nrm((L, G, P, S5_GROUP), (2 * S5_GROUP) ** -0.5)
    d['b_im'] = nrm((L, G, P, S5_GROUP), (2 * S5_GROUP) ** -0.5)
    d['c_re'] = nrm((L, G, S5_GROUP, P), (2 * P) ** -0.5)
    d['c_im'] = nrm((L, G, S5_GROUP, P), (2 * P) ** -0.5)
    d['d_skip'] = nrm((L, G, S5_GROUP), 1.0)
    d['w_glu'] = nrm((L, D_S5, D_S5), D_S5 ** -0.5)
    d['b_glu'] = nrm((L, D_S5), 0.02)
    d['s5_g'] = 1.0 + nrm((L, D_S5), 0.02)
    d['w_out'] = nrm((L, D_MIX, D_MODEL), DEEPNORM_BETA * D_MIX ** -0.5)
    d['ln1_g'] = 1.0 + nrm((L, D_MODEL), 0.02)
    d['ln1_b'] = nrm((L, D_MODEL), 0.02)
    d['w_grp'] = nrm((L, D_MODEL, N_EXPERT_GROUPS), D_MODEL ** -0.5)
    d['b_grp'] = nrm((L, N_EXPERT_GROUPS), 0.01)
    d['w_rt'] = nrm((L, D_MODEL, N_EXPERTS), D_MODEL ** -0.5)
    d['b_rt'] = nrm((L, N_EXPERTS), 0.01)
    d['w_eg'] = nrm((L, N_EXPERTS, D_MODEL, D_EXPERT), D_MODEL ** -0.5)
    d['w_eu'] = nrm((L, N_EXPERTS, D_MODEL, D_EXPERT), D_MODEL ** -0.5)
    d['w_ed'] = nrm((L, N_EXPERTS, D_EXPERT, D_MODEL), DEEPNORM_BETA * D_EXPERT ** -0.5)
    d['ln2_g'] = 1.0 + nrm((L, D_MODEL), 0.02)
    d['ln2_b'] = nrm((L, D_MODEL), 0.02)
    d['w_pg'] = nrm((L, D_MODEL, D_MODEL), D_MODEL ** -0.5)
    d['b_pg'] = nrm((L, D_MODEL), 0.02)
    d['w_pp'] = nrm((L, PLE_DIM, D_MODEL), PLE_DIM ** -0.5)
    d['ple_g'] = 1.0 + nrm((L, D_MODEL), 0.02)
    return d


def reference(x, p, w_in, conv_w, conv_b, w_q, w_k, b_i, b_f, mh_g, lam_re, lam_im, log_dt,
              b_re, b_im, c_re, c_im, d_skip, w_glu, b_glu, s5_g, w_out, ln1_g, ln1_b,
              w_grp, b_grp, w_rt, b_rt, w_eg, w_eu, w_ed, ln2_g, ln2_b, w_pg, b_pg, w_pp, ple_g):
    for i in range(DEPTH):
        mix = mixer(x, w_in[i], conv_w[i], conv_b[i], w_q[i], w_k[i], b_i[i], b_f[i], mh_g[i],
                    lam_re[i], lam_im[i], log_dt[i], b_re[i], b_im[i], c_re[i], c_im[i],
                    d_skip[i], w_glu[i], b_glu[i], s5_g[i], w_out[i])
        x = layer_norm(DEEPNORM_ALPHA * x + mix, ln1_g[i], ln1_b[i])
        ffn = moe_ffn(x, w_grp[i], b_grp[i], w_rt[i], b_rt[i], w_eg[i], w_eu[i], w_ed[i])
        x = layer_norm(DEEPNORM_ALPHA * x + ffn, ln2_g[i], ln2_b[i])
        gate = jax.nn.sigmoid(x @ w_pg[i] + b_pg[i])
        ple = rms_norm(p[i] @ w_pp[i], ple_g[i])
        x = x + gate * ple
    return x
```

```cpp
#include <hip/hip_runtime.h>
#include <math.h>
#include <stdint.h>

#ifndef MK_MULTI
#define MK_MULTI 0
#endif

#ifndef MK_REP
#define MK_REP -1
#endif

namespace {
#define LAS __attribute__((address_space(3)))
#define DI __device__ __forceinline__
typedef unsigned short bf16_t;
typedef short bf16x8 __attribute__((ext_vector_type(8)));
typedef short s16x4 __attribute__((ext_vector_type(4)));
typedef float f32x4 __attribute__((ext_vector_type(4)));
typedef unsigned u32x4 __attribute__((ext_vector_type(4)));
typedef unsigned u32x2 __attribute__((ext_vector_type(2)));
typedef int v8i __attribute__((ext_vector_type(8)));
typedef int v4i __attribute__((ext_vector_type(4)));

constexpr int NB_ = 8, S_ = 2048, D_ = 1024, M_ = NB_ * S_, L_ = 4;
constexpr int DM_ = 512, H_ = 4, DH_ = 128, DIN_ = 2056, ZLD_ = 1536;
constexpr int G5_ = 32, P5_ = 64;
constexpr int PLE_ = 256, NE_ = 32, DE_ = 512;
constexpr int MT_ = 160, PS2_ = MT_ * 256, ECAP_ = 32768;
constexpr int S5K_ = 384, S5R_ = M_ / 16;
constexpr float ALPHA_ = 1.681792830507429f, EPS_ = 1e-5f;
constexpr int NT_ = 512;
constexpr int LDS_BYTES = 163840;

constexpr size_t al256(size_t x) { return (x + 255) & ~(size_t)255; }
constexpr int XCD_BAR_WORDS = 3456;
constexpr size_t WS_BAR = 0;
constexpr size_t WS_CUR = al256(WS_BAR + XCD_BAR_WORDS * 4);
constexpr size_t WS_DONE = al256(WS_CUR + (size_t)2 * L_ * NE_ * 64);
constexpr size_t WS_LNC = al256(WS_DONE + (size_t)2 * L_ * MT_ * 64);
constexpr size_t WS_CTL_END = al256(WS_LNC + (size_t)L_ * 64 * 64);
constexpr size_t WS_XB = WS_CTL_END;
constexpr size_t WS_XC = al256(WS_XB + (size_t)M_ * D_ * 2);
constexpr size_t WS_XCH = WS_XC;
constexpr size_t WS_LOGIT = WS_XC + ((size_t)16 << 20);
constexpr size_t WS_GHL = WS_XC + ((size_t)24 << 20);
constexpr size_t WS_RTC = WS_XC + ((size_t)26 << 20);
constexpr size_t WS_ZB = al256(WS_XC + (size_t)M_ * D_ * 4);
constexpr size_t WS_AS5 = al256(WS_ZB + (size_t)M_ * ZLD_ * 2);
constexpr size_t WS_ESUM = al256(WS_AS5 + (size_t)G5_ * S5R_ * S5K_ * 2);
constexpr size_t WS_QB = al256(WS_ESUM + (size_t)G5_ * S5R_ * 128 * 4);
constexpr size_t WS_KB = al256(WS_QB + (size_t)M_ * DM_ * 2);
constexpr size_t WS_CSUM = al256(WS_KB + (size_t)M_ * DM_ * 2);
constexpr size_t WS_CPREV = al256(WS_CSUM + (size_t)1024 * DH_ * DH_ * 4);
constexpr size_t WS_NSUM = al256(WS_CPREV + (size_t)1024 * DH_ * DH_ * 2);
constexpr size_t WS_NPREV = al256(WS_NSUM + (size_t)1024 * DH_ * 4);
constexpr size_t WS_GG = al256(WS_NPREV + (size_t)1024 * DH_ * 4);
constexpr size_t WS_MLG = al256(WS_GG + 4096);
constexpr size_t WS_MPREV = al256(WS_MLG + 4096);
constexpr size_t WS_IGG = al256(WS_MPREV + 4096);
constexpr size_t WS_BCUM = al256(WS_IGG + (size_t)M_ * 16);
constexpr size_t WS_YB = al256(WS_BCUM + (size_t)M_ * 16);
constexpr size_t WS_GYB = al256(WS_YB + (size_t)M_ * D_ * 2);
constexpr size_t WS_SSQS = al256(WS_GYB + (size_t)M_ * DM_ * 2);
constexpr size_t WS_X1 = al256(WS_SSQS + (size_t)M_ * 32);
constexpr size_t WS_X1B = al256(WS_X1 + (size_t)M_ * D_ * 4);
constexpr size_t WS_X1Q = al256(WS_X1B + (size_t)M_ * D_ * 2);
constexpr size_t WS_BUFT = al256(WS_X1Q + (size_t)M_ * D_);
constexpr size_t WS_BUFW = al256(WS_BUFT + (size_t)NE_ * ECAP_ * 4);
constexpr size_t WS_SLOT = al256(WS_BUFW + (size_t)NE_ * ECAP_ * 4);
constexpr size_t WS_HB = al256(WS_SLOT + (size_t)M_ * 8);
constexpr size_t WS_YE = al256(WS_HB + (size_t)PS2_ * DE_ * 2);
constexpr size_t WS_X2 = al256(WS_YE + (size_t)PS2_ * D_ * 2);
constexpr size_t WS_X2B = al256(WS_X2 + (size_t)M_ * D_ * 4);
constexpr size_t WS_TB = al256(WS_X2B + (size_t)M_ * D_ * 2);
constexpr size_t WS_SSQT = al256(WS_TB + (size_t)M_ * D_ * 2);
constexpr size_t WS_RSTDT = al256(WS_SSQT + (size_t)M_ * 64);
constexpr size_t WS_PBF = al256(WS_RSTDT + (size_t)M_ * 4);
constexpr size_t WS_WIN = al256(WS_PBF + (size_t)L_ * M_ * PLE_ * 2);
constexpr size_t WS_WOUT = al256(WS_WIN + (size_t)L_ * 2048 * D_ * 2);
constexpr size_t WS_WPG = al256(WS_WOUT + (size_t)L_ * D_ * D_ * 2);
constexpr size_t WS_WPP = al256(WS_WPG + (size_t)L_ * D_ * D_ * 2);
constexpr size_t WS_WGLU = al256(WS_WPP + (size_t)L_ * D_ * PLE_ * 2);
constexpr size_t WS_WQK = al256(WS_WGLU + (size_t)L_ * DM_ * DM_ * 2);
constexpr size_t WS_WGATE = al256(WS_WQK + (size_t)L_ * H_ * 256 * DH_ * 2);
constexpr size_t WS_WET = al256(WS_WGATE + (size_t)L_ * 16 * D_ * 2);
constexpr size_t WS_WYT = al256(WS_WET + (size_t)L_ * G5_ * 256 * 256 * 2);
constexpr size_t WS_A16 = al256(WS_WYT + (size_t)L_ * G5_ * 256 * S5K_ * 2);
constexpr size_t WS_WGU = al256(WS_A16 + (size_t)L_ * G5_ * 128 * 4);
constexpr size_t WS_WED = al256(WS_WGU + (size_t)NE_ * D_ * D_ * 2);
constexpr size_t WS_WRT = al256(WS_WED + (size_t)NE_ * D_ * DE_ * 2);
constexpr size_t WS_END = al256(WS_WRT + (size_t)L_ * 36 * D_ * 4);
static_assert(WS_END <= (size_t)1073741824, "workspace over 1 GiB");

struct P { const float* in[37]; float* out; unsigned char* ws; };
typedef const __attribute__((address_space(4))) P& PR;

typedef float f32x2_ __attribute__((ext_vector_type(2)));
typedef __bf16 bf16x2_ __attribute__((ext_vector_type(2)));
DI unsigned cvt_pk_bf16(float lo, float hi) { const f32x2_ v = {lo, hi}; return __builtin_bit_cast(unsigned, __builtin_convertvector(v, bf16x2_)); }
DI float bf2f(bf16_t v) { return __uint_as_float(((unsigned)v) << 16); }
DI float bflo(unsigned v) { return __uint_as_float(v << 16); }
DI float bfhi(unsigned v) { return __uint_as_float(v & 0xffff0000u); }
DI unsigned pack4_fp8(float a, float b, float c, float d) { int w = 0; w = __builtin_amdgcn_cvt_pk_fp8_f32(a, b, w, false); w = __builtin_amdgcn_cvt_pk_fp8_f32(c, d, w, true); return (unsigned)w; }
constexpr float W8_SCALE = 64.0f, W8_INV = 1.0f / 64.0f, YE_SCALE = 32.0f, YE_INV = 1.0f / 32.0f;
DI bf16_t f2bf(float f) { unsigned u = __float_as_uint(f); u += 0x7fffu + ((u >> 16) & 1u); return (bf16_t)(u >> 16); }
DI float wave_sum(float v) {
#pragma unroll
    for (int o = 32; o > 0; o >>= 1) v += __shfl_xor(v, o);
    return v;
}
DI float sigmoidf_(float x) { return 1.0f / (1.0f + expf(-x)); }
DI float siluf_(float x) { return x * sigmoidf_(x); }
DI float fast_sigmoid(float x) { return __builtin_amdgcn_rcpf(1.0f + __builtin_amdgcn_exp2f(-1.4426950408889634f * x)); }
DI float fast_silu(float x) { return x * fast_sigmoid(x); }
DI float fast_gelu_tanh(float x) { const float z2 = 1.5957691216057308f * (x + 0.044715f * x * x * x); return x * fast_sigmoid(z2); }
DI float log_sigmoid_(float x) { return (x >= 0.f) ? -log1pf(expf(-x)) : (x - log1pf(expf(x))); }
DI f32x4 mfma16(bf16x8 a, bf16x8 b, f32x4 c) { return __builtin_amdgcn_mfma_f32_16x16x32_bf16(a, b, c, 0, 0, 0); }
DI bf16x8 ld_frag_g(const bf16_t* p) { return *(const bf16x8*)p; }
DI bf16x8 cat8(s16x4 lo, s16x4 hi) { return __builtin_shufflevector(lo, hi, 0, 1, 2, 3, 4, 5, 6, 7); }
DI unsigned off_b(unsigned row, unsigned ch) { return 256u * row + 16u * (ch ^ (((row & 3u) << 2) | ((row >> 2) & 3u))); }
DI bf16x8 tile_row_read(const LAS unsigned char* tile, int lane, int rb, int s) {
    return *(const LAS bf16x8*)(tile + off_b((unsigned)((lane & 15) + 16 * rb), (unsigned)(4 * s + (lane >> 4))));
}
DI s16x4 tile_tr_read(const LAS unsigned char* tile, int lane, int row0, int c) {
    const unsigned q = (unsigned)(lane & 15) >> 2, p = (unsigned)lane & 3u;
    const unsigned addr = (unsigned)(size_t)tile + off_b((unsigned)row0 + q, (unsigned)(2 * c) + (p >> 1)) + 8u * (p & 1u);
    s16x4 r; asm volatile("ds_read_b64_tr_b16 %0, %1\n\ts_waitcnt lgkmcnt(0)" : "=&v"(r) : "v"(addr) : "memory"); return r;
}

DI unsigned tr_addr(const LAS unsigned char* tile, int lane, int row0, int c) {
    const unsigned q = (unsigned)(lane & 15) >> 2, p = (unsigned)lane & 3u;
    return (unsigned)(size_t)tile + off_b((unsigned)row0 + q, (unsigned)(2 * c) + (p >> 1)) + 8u * (p & 1u);
}
DI void tile_tr_read4(unsigned a0, unsigned a1, unsigned a2, unsigned a3, s16x4& r0, s16x4& r1, s16x4& r2, s16x4& r3) {
    asm volatile("ds_read_b64_tr_b16 %0, %4\n\tds_read_b64_tr_b16 %1, %5\n\tds_read_b64_tr_b16 %2, %6\n\tds_read_b64_tr_b16 %3, %7\n\ts_waitcnt lgkmcnt(0)"
                 : "=&v"(r0), "=&v"(r1), "=&v"(r2), "=&v"(r3) : "v"(a0), "v"(a1), "v"(a2), "v"(a3) : "memory");
}

#define XB_TMO      128
#define XB_XCNT(j)  (256  + 64 * (j))
#define XB_XSUB(j)  (1280 + 64 * (j))
#define XB_XGEN(j)  (2304 + 64 * (j))
#define XB_TOP      3328
#define XB_TOPGEN   3392
#define XB_SPIN_CAP (1u << 18)
DI unsigned xb_ld(unsigned* p)              { return __hip_atomic_load(p, __ATOMIC_RELAXED, __HIP_MEMORY_SCOPE_AGENT); }
DI unsigned xb_add(unsigned* p, unsigned v) { return __hip_atomic_fetch_add(p, v, __ATOMIC_RELAXED, __HIP_MEMORY_SCOPE_AGENT); }
DI unsigned xb_xcc_id() { return (unsigned)__builtin_amdgcn_s_getreg((3 << 11) | 20) & 0xFu; }
#define XB_SPIN(cond, bar) do { unsigned _sp = 0; while (cond) { __builtin_amdgcn_s_sleep(1); \
    if ((++_sp & 255u) == 0u) { if (xb_ld(&(bar)[XB_TMO])) break; if (_sp > XB_SPIN_CAP) { atomicAdd(&(bar)[XB_TMO], 1u); break; } } } } while (0)
struct XcdBarrier { unsigned* bar; unsigned x; volatile LAS unsigned* st; };
DI XcdBarrier xcd_barrier_post(unsigned* bar, volatile LAS unsigned* st) {
    XcdBarrier b; b.bar = bar; b.x = xb_xcc_id(); b.st = st;
    if (threadIdx.x == 0) (void)xb_add(&bar[XB_XCNT(b.x)], 1u);
    return b;
}
DI void xcd_barrier_complete(unsigned* bar, unsigned x, unsigned& nloc, unsigned& nx) {
    const unsigned G = gridDim.x * gridDim.y * gridDim.z;
    unsigned sum, cnt, mine, sp = 0u;
    for (;;) {
        sum = 0u; cnt = 0u; mine = 0u;
#pragma unroll
        for (unsigned j = 0; j < 16; ++j) { const unsigned c = xb_ld(&bar[XB_XCNT(j)]); sum += c; cnt += (c > 0u) ? 1u : 0u; mine = (j == x) ? c : mine; }
        if (sum == G) break;
        __builtin_amdgcn_s_sleep(1);
        if ((++sp & 255u) == 0u) { if (xb_ld(&bar[XB_TMO])) break; if (sp > XB_SPIN_CAP) { atomicAdd(&bar[XB_TMO], 1u); break; } }
    }
    nloc = mine > 0u ? mine : 1u; nx = cnt > 0u ? cnt : 1u;
}
DI void xcd_barrier(const XcdBarrier& b) {
    asm volatile("s_waitcnt vmcnt(0)" ::: "memory");
    __syncthreads();
    if (threadIdx.x == 0) {
        unsigned* bar = b.bar;
        __builtin_amdgcn_s_waitcnt(0);
        unsigned nloc = b.st[0], nx = b.st[1];
        if (nloc == 0u) { xcd_barrier_complete(bar, b.x, nloc, nx); b.st[0] = nloc; b.st[1] = nx; }
        const unsigned old = xb_add(&bar[XB_XSUB(b.x)], 1u);
        const unsigned gen = old / nloc;
        if (old + 1u == (gen + 1u) * nloc) {
            __builtin_amdgcn_fence(__ATOMIC_RELEASE, "agent");
            asm volatile("s_waitcnt vmcnt(0)" ::: "memory");
            const unsigned og = xb_add(&bar[XB_TOP], 1u);
            const unsigned tg = og / nx;
            if (og + 1u == (tg + 1u) * nx) xb_add(&bar[XB_TOPGEN], 1u);
            else XB_SPIN(xb_ld(&bar[XB_TOPGEN]) == tg, bar);
            __builtin_amdgcn_fence(__ATOMIC_ACQUIRE, "agent");
            xb_add(&bar[XB_XGEN(b.x)], 1u);
            asm volatile("s_waitcnt vmcnt(0)" ::: "memory");
        } else {
            XB_SPIN(xb_ld(&bar[XB_XGEN(b.x)]) == gen, bar);
            __builtin_amdgcn_fence(__ATOMIC_ACQUIRE, "agent");
            asm volatile("s_waitcnt vmcnt(0)" ::: "memory");
        }
    }
    __syncthreads();
}

constexpr int BM = 256, BK = 64, HALF = 128, HTB = HALF * BK * 2, STAGE_BYTES = 8 * HTB, NXCD = 8, WGM = 8;
DI int lds_byte(int r, int c) { const int st = (r >> 4) * 2 + (c >> 5), rr = r & 15, cc = c & 31, ob = rr * 64 + cc * 2; return st * 1024 + (ob ^ (((ob >> 9) & 1) << 5)); }
DI void stage_rc(int b, int& R, int& C) { const int st = b / 1024, sb = b % 1024, swz = sb ^ (((sb >> 9) & 1) << 5); R = (st >> 1) * 16 + swz / 64; C = (st & 1) * 32 + (swz % 64) / 2; }
DI int perm32(int rho) { const int n = rho >> 4, i = rho & 15; return 8 * (i >> 2) + 4 * n + (i & 3); }

struct Unit { const char* A; const char* B; int pm, pn, aux; };
struct Gemm { unsigned lda, ldb; int K; };

struct DenseOrder {
    static constexpr bool GATHER = false;
    const char* A; const char* B; unsigned lda, ldb; int nM, nN, nwg, G, c;
    DI void init(const void* A_, const void* B_, unsigned lda_, unsigned ldb_, int M, int N, int G_, int c_) { A = (const char*)A_; B = (const char*)B_; lda = lda_; ldb = ldb_; nM = M / BM; nN = N / BM; nwg = nM * nN; G = G_; c = c_; }
    DI bool next(int i, Unit& u) const {
        const long Lx = (long)i * G + c; if (Lx >= nwg) return false;
        int wgid = (int)Lx; { const int q = nwg / NXCD, r = nwg % NXCD, xcd = wgid % NXCD, off = wgid / NXCD; wgid = (xcd < r ? xcd * (q + 1) : r * (q + 1) + (xcd - r) * q) + off; }
        const int nig = WGM * nN, gid = wgid / nig, fm = gid * WGM, gsz = (nM - fm) < WGM ? (nM - fm) : WGM;
        u.pm = fm + ((wgid % nig) % gsz); u.pn = (wgid % nig) / gsz; u.aux = 0;
        u.A = A + (size_t)u.pm * BM * lda; u.B = B + (size_t)u.pn * BM * ldb; return true;
    }
    DI unsigned voff(const Unit&, int, int) const { return 0u; }
    DI void a_ready(const Unit&) const {}
};
struct GroupOrder {
    static constexpr bool GATHER = false;
    const char* A; const char* B; size_t astride, bstride; unsigned lda; int nunits, G, c;
    DI bool next(int i, Unit& u) const {
        const int Lx = i * G + c; if (Lx >= nunits) return false;
        const int g = Lx >> 2, pm = Lx & 3; u.pm = pm; u.pn = 0; u.aux = g; u.A = A + (size_t)g * astride + (size_t)pm * BM * lda; u.B = B + (size_t)g * bstride; return true;
    }
    DI unsigned voff(const Unit&, int, int) const { return 0u; }
    DI void a_ready(const Unit&) const {}
};
template <bool GATHER_>
struct MoeOrder {
    static constexpr bool GATHER = GATHER_;
    const char* A; const char* B; unsigned lda, ldb; size_t bstride; const LAS int* tbase; const LAS int* cnt; const int* buf_t; unsigned* done; int nunits, G, c, n3, nb;
    DI bool next(int i, Unit& u) const {
        int Lx;
        if constexpr (GATHER_) { Lx = i * G + c; }
        else { const int cr = (c - n3 + G) % G; const bool bonus = (c >= n3) && (c - n3 < nb); if (bonus && i == 0) Lx = c - n3; else Lx = nb + cr + (bonus ? i - 1 : i) * G; }
        if (Lx >= nunits) return false;
        const int T = Lx >> 2, pn = Lx & 3; int e = 0; while (e < NE_ - 1 && tbase[e + 1] <= T) ++e;
        const int k = T - tbase[e]; u.pm = T; u.pn = pn; u.aux = e * 128 + k;
        u.B = B + (size_t)e * bstride + (size_t)pn * BM * ldb; u.A = GATHER_ ? A : A + (size_t)T * BM * lda; return true;
    }
    DI unsigned voff(const Unit& u, int R, int C) const {
        const int e = u.aux >> 7, idx = (u.aux & 127) * 256 + R; const int tok = (idx < cnt[e]) ? buf_t[(size_t)e * ECAP_ + idx] : 0;
        return (unsigned)tok * lda + (unsigned)C * 2u;
    }
    DI void a_ready(const Unit& u) const {
        if constexpr (!GATHER_) {
            if (threadIdx.x < 64) {
                unsigned spins = 0;
                while ((unsigned)__builtin_amdgcn_readfirstlane(__hip_atomic_load(done + 16 * u.pm, __ATOMIC_RELAXED, __HIP_MEMORY_SCOPE_AGENT)) < 32u) { __builtin_amdgcn_s_sleep(2); if (++spins > (1u << 22)) break; }
                __builtin_amdgcn_fence(__ATOMIC_ACQUIRE, "agent");
                asm volatile("s_waitcnt vmcnt(0)" ::: "memory");
            }
            asm volatile("" ::: "memory"); __builtin_amdgcn_s_barrier(); asm volatile("" ::: "memory");
        }
    }
};

template <class Epi, class Sched>
DI void gemm_phase(LAS unsigned char* lds, const Gemm g, const Sched& S, const Epi& E) {
    int tid = threadIdx.x; asm volatile("" : "+v"(tid)); tid &= 511;
    const int wid = __builtin_amdgcn_readfirstlane(tid >> 6), lane = tid & 63, wr = wid >> 2, wc = wid & 3, fr = lane & 15, fq = lane >> 4;
    const int nt = g.K / BK;
    unsigned voffA[2][2], nvoffA[2][2], voffB[2];
#pragma unroll
    for (int i = 0; i < 2; ++i) { int R, C; stage_rc(tid * 16 + i * 8192, R, C); const int Rb = Epi::PERM ? ((R & ~31) + perm32(R & 31)) : R;
        voffB[i] = (unsigned)Rb * g.ldb + (unsigned)C * 2u;
        voffA[0][i] = (unsigned)R * g.lda + (unsigned)C * 2u; voffA[1][i] = (unsigned)(R + HALF) * g.lda + (unsigned)C * 2u;
        nvoffA[0][i] = voffA[0][i]; nvoffA[1][i] = voffA[1][i]; }
    const size_t kstep = (size_t)(BK * 2);
    const size_t hstepB = (size_t)HALF * g.ldb;
    const unsigned ldsw = (unsigned)wid * 1024u;
    const int aoff = lds_byte(wr * 64 + fr, fq * 8), boff = lds_byte(wc * 32 + fr, fq * 8);
#define PG8_SA(b, h) (((b) * 2 + (h)) * HTB)
#define PG8_SB(b, h) ((4 + (b) * 2 + (h)) * HTB)
#define PG8_STAGE(bufoff, gbase, voff) do { _Pragma("unroll") for (int _i = 0; _i < 2; ++_i) \
        __builtin_amdgcn_global_load_lds((const unsigned*)((const char*)(gbase) + (voff)[_i]), (LAS unsigned*)(lds + (bufoff) + ldsw + _i * 8192), 16, 0, 0); } while (0)
#define PG8_LDA(dst, b, h) do { if constexpr (Epi::FP8) { _Pragma("unroll") for (int m = 0; m < 4; ++m) dst##8[m] = __builtin_shufflevector(*(const LAS v4i*)(lds + PG8_SA(b, h) + aoff + m * 2048), *(const LAS v4i*)(lds + PG8_SA(b, h) + aoff + m * 2048 + 1024), 0, 1, 2, 3, 4, 5, 6, 7); } \
        else { _Pragma("unroll") for (int m = 0; m < 4; ++m) _Pragma("unroll") for (int k = 0; k < 2; ++k) dst[m][k] = *(const LAS bf16x8*)(lds + PG8_SA(b, h) + aoff + m * 2048 + k * 1024); } } while (0)
#define PG8_LDB(dst, b, h) do { if constexpr (Epi::FP8) { _Pragma("unroll") for (int n = 0; n < 2; ++n) dst##8[n] = __builtin_shufflevector(*(const LAS v4i*)(lds + PG8_SB(b, h) + boff + n * 2048), *(const LAS v4i*)(lds + PG8_SB(b, h) + boff + n * 2048 + 1024), 0, 1, 2, 3, 4, 5, 6, 7); } \
        else { _Pragma("unroll") for (int n = 0; n < 2; ++n) _Pragma("unroll") for (int k = 0; k < 2; ++k) dst[n][k] = *(const LAS bf16x8*)(lds + PG8_SB(b, h) + boff + n * 2048 + k * 1024); } } while (0)
#define PG8_MMA(ai, bj, At, Bt) do { __builtin_amdgcn_s_setprio(1); _Pragma("unroll") for (int m = 0; m < 4; ++m) _Pragma("unroll") for (int n = 0; n < 2; ++n) { \
        if constexpr (Epi::FP8)   \
            asm volatile("v_mfma_scale_f32_16x16x128_f8f6f4 %0, %1, %2, %0, %3, %3 op_sel_hi:[0,0,0]" : "+v"(acc[ai][bj][m][n]) : "v"(Bt##8[n]), "v"(At##8[m]), "v"(sc8));   \
        else { _Pragma("unroll") for (int k = 0; k < 2; ++k) acc[ai][bj][m][n] = __builtin_amdgcn_mfma_f32_16x16x32_bf16(Bt[n][k], At[m][k], acc[ai][bj][m][n], 0, 0, 0); } } \
        __builtin_amdgcn_s_setprio(0); } while (0)
#define PG8_WAIT_V(n) asm volatile("s_waitcnt vmcnt(" #n ")" ::: "memory")
#define PG8_WAIT_L(n) asm volatile("s_waitcnt lgkmcnt(" #n ")" ::: "memory")
#define PG8_BAR __builtin_amdgcn_s_barrier()
#define PG8_SCHED __builtin_amdgcn_sched_barrier(0)
    Unit cur, nxt; int ui = 0;
    if (!S.next(0, cur)) return;
    if constexpr (Sched::GATHER) {
#pragma unroll
        for (int i = 0; i < 2; ++i) { int R, C; stage_rc(tid * 16 + i * 8192, R, C); voffA[0][i] = S.voff(cur, R, C); voffA[1][i] = S.voff(cur, R + HALF, C); }
    }
    f32x4 acc[2][2][4][2];
#pragma unroll
    for (int a = 0; a < 2; ++a)
#pragma unroll
        for (int b = 0; b < 2; ++b)
#pragma unroll
            for (int m = 0; m < 4; ++m)
#pragma unroll
                for (int n = 0; n < 2; ++n) acc[a][b][m][n] = (f32x4){0.f, 0.f, 0.f, 0.f};
    const int sc8 = 0x7f7f7f7f;
    bf16x8 At[4][2], B0[2][2], B1[2][2]; v8i At8[4], B08[2], B18[2];
    const char* cA = cur.A; const char* cB = cur.B;
    S.a_ready(cur);
    PG8_STAGE(PG8_SB(0, 0), cB, voffB); PG8_STAGE(PG8_SB(0, 1), cB + hstepB, voffB); PG8_STAGE(PG8_SA(0, 0), cA, voffA[0]); PG8_STAGE(PG8_SA(0, 1), cA, voffA[1]);
    if (wr == 1) PG8_BAR;
    PG8_WAIT_V(2); PG8_BAR;
    PG8_STAGE(PG8_SB(1, 0), cB + kstep, voffB); PG8_STAGE(PG8_SA(1, 0), cA + kstep, voffA[0]); PG8_STAGE(PG8_SB(1, 1), cB + hstepB + kstep, voffB);
    PG8_WAIT_V(6); PG8_BAR;
    for (;;) {
        const bool has_next = S.next(ui + 1, nxt);
        const char* nA = has_next ? nxt.A : cA; const char* nB = has_next ? nxt.B : cB;
        if constexpr (Sched::GATHER) {
            if (has_next) {
#pragma unroll
                for (int i = 0; i < 2; ++i) { int R, C; stage_rc(tid * 16 + i * 8192, R, C); nvoffA[0][i] = S.voff(nxt, R, C); nvoffA[1][i] = S.voff(nxt, R + HALF, C); }
            } else {
#pragma unroll
                for (int i = 0; i < 2; ++i) { nvoffA[0][i] = voffA[0][i]; nvoffA[1][i] = voffA[1][i]; }
            }
        }
        for (int t = 0; t < nt; t += 2) {
            const bool last = (t == nt - 2);
            if constexpr (Epi::MIDSCALE) { if (t == nt / 2) E.mid(acc, cur, wr, fr); }
            if (last && has_next) S.a_ready(nxt);
            const char* a1 = cA + (size_t)(t + 1) * kstep;
            const char* a2 = last ? nA : cA + (size_t)(t + 2) * kstep; const char* b2 = last ? nB : cB + (size_t)(t + 2) * kstep;
            const char* a3 = a2 + kstep; const char* b3 = b2 + kstep;
            unsigned va0[2], va1[2];
#pragma unroll
            for (int i = 0; i < 2; ++i) { va0[i] = (Sched::GATHER && last) ? nvoffA[0][i] : voffA[0][i]; va1[i] = (Sched::GATHER && last) ? nvoffA[1][i] : voffA[1][i]; }
            PG8_LDB(B0, 0, 0); PG8_LDB(B1, 0, 1); PG8_SCHED; PG8_LDA(At, 0, 0); PG8_STAGE(PG8_SA(1, 1), a1, voffA[1]);
            PG8_WAIT_V(8); PG8_WAIT_L(0); PG8_BAR; PG8_MMA(0, 0, At, B0); PG8_MMA(0, 1, At, B1); PG8_BAR; PG8_SCHED;
            PG8_LDA(At, 0, 1); PG8_STAGE(PG8_SB(0, 0), b2, voffB); PG8_STAGE(PG8_SB(0, 1), b2 + hstepB, voffB); PG8_STAGE(PG8_SA(0, 0), a2, va0);
            PG8_WAIT_V(8); PG8_WAIT_L(0); PG8_BAR; PG8_MMA(1, 0, At, B0); PG8_MMA(1, 1, At, B1); PG8_BAR; PG8_SCHED;
            PG8_LDB(B0, 1, 0); PG8_LDB(B1, 1, 1); PG8_SCHED; PG8_LDA(At, 1, 0); PG8_STAGE(PG8_SA(0, 1), a2, va1);
            PG8_WAIT_V(8); PG8_WAIT_L(0); PG8_BAR; PG8_MMA(0, 0, At, B0); PG8_MMA(0, 1, At, B1); PG8_BAR; PG8_SCHED;
            PG8_LDA(At, 1, 1); PG8_STAGE(PG8_SB(1, 0), b3, voffB); PG8_STAGE(PG8_SB(1, 1), b3 + hstepB, voffB); PG8_STAGE(PG8_SA(1, 0), a3, va0);
            PG8_WAIT_V(8); PG8_WAIT_L(0); PG8_BAR; PG8_MMA(1, 0, At, B0); PG8_MMA(1, 1, At, B1); PG8_BAR; PG8_SCHED;
        }
        if (wr == 0) PG8_BAR;
        if constexpr (Epi::FP8) {
#define PG8_PIN8(a, b) asm volatile("s_nop 15\n\ts_nop 15" : "+v"(acc[a][b][0][0]), "+v"(acc[a][b][0][1]), "+v"(acc[a][b][1][0]), "+v"(acc[a][b][1][1]), "+v"(acc[a][b][2][0]), "+v"(acc[a][b][2][1]), "+v"(acc[a][b][3][0]), "+v"(acc[a][b][3][1]))
            PG8_PIN8(0, 0); PG8_PIN8(0, 1); PG8_PIN8(1, 0); PG8_PIN8(1, 1);
#undef PG8_PIN8
        }
        { int tz = tid; asm volatile("" : "+v"(tz)); tz &= 511;
          const int wz = __builtin_amdgcn_readfirstlane(tz >> 6), lz = tz & 63; if constexpr (!Epi::AFTER_DRAIN) E(acc, cur, wz >> 2, wz & 3, lz & 15, lz >> 4); }
        if (!has_next) break;
#pragma unroll
        for (int a = 0; a < 2; ++a)
#pragma unroll
            for (int b = 0; b < 2; ++b)
#pragma unroll
                for (int m = 0; m < 4; ++m)
#pragma unroll
                    for (int n = 0; n < 2; ++n) acc[a][b][m][n] = (f32x4){0.f, 0.f, 0.f, 0.f};
        cur = nxt; cA = nA; cB = nB; ++ui;
        if constexpr (Sched::GATHER) {
#pragma unroll
            for (int i = 0; i < 2; ++i) { voffA[0][i] = nvoffA[0][i]; voffA[1][i] = nvoffA[1][i]; }
        }
        if (wr == 1) PG8_BAR;
    }
    PG8_WAIT_V(0);
    PG8_BAR;
    if constexpr (Epi::AFTER_DRAIN) {
        int tz = tid; asm volatile("" : "+v"(tz)); tz &= 511;
        const int wz = __builtin_amdgcn_readfirstlane(tz >> 6), lz = tz & 63; E.fused(acc, cur, wz >> 2, wz & 3, lz & 15, lz >> 4, lds, tz);
    }
#undef PG8_SA
#undef PG8_SB
#undef PG8_STAGE
#undef PG8_LDA
#undef PG8_LDB
#undef PG8_MMA
#undef PG8_WAIT_V
#undef PG8_WAIT_L
#undef PG8_BAR
#undef PG8_SCHED
}


struct EpiInProj {
    static constexpr bool PERM = true, MIDSCALE = false, FP8 = false, AFTER_DRAIN = false;
    bf16_t* zb; bf16_t* AS5;
    DI void operator()(const f32x4 (&acc)[2][2][4][2], const Unit& u, int wr, int wc, int fr, int fq) const {
        const int row0 = u.pm * BM + wr * 64 + fr, col0 = u.pn * BM + wc * 32 + 8 * fq;
#pragma unroll
        for (int ai = 0; ai < 2; ++ai)
#pragma unroll
            for (int m = 0; m < 4; ++m) { const int row = row0 + ai * HALF + m * 16;
#pragma unroll
                for (int bj = 0; bj < 2; ++bj) { const f32x4 v0 = acc[ai][bj][m][0], v1 = acc[ai][bj][m][1]; const int col = col0 + bj * HALF;
                    u32x4 o; o.x = cvt_pk_bf16(v0[0], v0[1]); o.y = cvt_pk_bf16(v0[2], v0[3]); o.z = cvt_pk_bf16(v1[0], v1[1]); o.w = cvt_pk_bf16(v1[2], v1[3]);
                    if (u.pn < 6) *(u32x4*)(zb + (size_t)row * ZLD_ + col) = o;
                    else { const int cs = col - 1536; *(u32x4*)(AS5 + ((size_t)(cs >> 4) * S5R_ + (row >> 4)) * S5K_ + (row & 15) * 16 + (cs & 15)) = o; } } }
    }
};
struct EpiS5E {
    static constexpr bool PERM = false, MIDSCALE = false, FP8 = false, AFTER_DRAIN = false;
    float* E;
    DI void operator()(const f32x4 (&acc)[2][2][4][2], const Unit& u, int wr, int wc, int fr, int fq) const {
        const int row0 = u.pm * BM + wr * 64 + fr, col0 = wc * 32 + 4 * fq;
#pragma unroll
        for (int ai = 0; ai < 2; ++ai)
#pragma unroll
            for (int m = 0; m < 4; ++m) { float* rowp = E + ((size_t)u.aux * S5R_ + row0 + ai * HALF + m * 16) * 128 + col0;
#pragma unroll
                for (int n = 0; n < 2; ++n) *(f32x4*)(rowp + n * 16) = acc[ai][0][m][n]; }
    }
};
struct EpiS5Y {
    static constexpr bool PERM = false, MIDSCALE = false, FP8 = false, AFTER_DRAIN = false;
    bf16_t* gy;
    DI void operator()(const f32x4 (&acc)[2][2][4][2], const Unit& u, int wr, int wc, int fr, int fq) const {
        const int row0 = u.pm * BM + wr * 64 + fr;
#pragma unroll
        for (int ai = 0; ai < 2; ++ai)
#pragma unroll
            for (int m = 0; m < 4; ++m) { const int row = row0 + ai * HALF + m * 16;
#pragma unroll
                for (int bj = 0; bj < 2; ++bj)
#pragma unroll
                    for (int n = 0; n < 2; ++n) { const int j = 8 * bj + 2 * wc + n; const f32x4 v = acc[ai][bj][m][n];
                        u32x2 o; o.x = cvt_pk_bf16(fast_gelu_tanh(v[0]), fast_gelu_tanh(v[1])); o.y = cvt_pk_bf16(fast_gelu_tanh(v[2]), fast_gelu_tanh(v[3]));
                        *(u32x2*)(gy + (size_t)(16 * row + j) * DM_ + 16 * u.aux + 4 * fq) = o; } }
    }
};
struct EpiGlu {
    static constexpr bool PERM = false, MIDSCALE = false, FP8 = false, AFTER_DRAIN = false;
    const bf16_t* gy; const float* b_glu; bf16_t* yb; float* ssqS;
    DI void operator()(const f32x4 (&acc)[2][2][4][2], const Unit& u, int wr, int wc, int fr, int fq) const {
        const int row0 = u.pm * BM + wr * 64 + fr, col0 = u.pn * BM + wc * 32 + 4 * fq;
#pragma unroll
        for (int ai = 0; ai < 2; ++ai)
#pragma unroll
            for (int m = 0; m < 4; ++m) { const int row = row0 + ai * HALF + m * 16; float ss = 0.f;
#pragma unroll
                for (int bj = 0; bj < 2; ++bj)
#pragma unroll
                    for (int n = 0; n < 2; ++n) { const int col = col0 + bj * HALF + n * 16; const f32x4 a = acc[ai][bj][m][n]; const f32x4 bb = *(const f32x4*)(b_glu + col);
                        const u32x2 gv = *(const u32x2*)(gy + (size_t)row * DM_ + col);
                        const float y0 = bflo(gv.x) * fast_sigmoid(a[0] + bb[0]), y1 = bfhi(gv.x) * fast_sigmoid(a[1] + bb[1]), y2 = bflo(gv.y) * fast_sigmoid(a[2] + bb[2]), y3 = bfhi(gv.y) * fast_sigmoid(a[3] + bb[3]);
                        ss += (y0 * y0 + y1 * y1) + (y2 * y2 + y3 * y3);
                        u32x2 o; o.x = cvt_pk_bf16(y0, y1); o.y = cvt_pk_bf16(y2, y3); *(u32x2*)(yb + (size_t)row * D_ + col) = o; }
                ss += __shfl_xor(ss, 16); ss += __shfl_xor(ss, 32);
                if (fq == 0) ssqS[(size_t)row * 8 + u.pn * 4 + wc] = ss; }
    }
};
struct EpiOutProj {
    static constexpr bool PERM = true, MIDSCALE = true, FP8 = false, AFTER_DRAIN = false;
    const bf16_t* xres; const float* ssqS; bf16_t* r1;
    DI void mid(f32x4 (&acc)[2][2][4][2], const Unit& u, int wr, int fr) const {
        const int row0 = u.pm * BM + wr * 64 + fr;
#pragma unroll
        for (int ai = 0; ai < 2; ++ai)
#pragma unroll
            for (int m = 0; m < 4; ++m) { const int row = row0 + ai * HALF + m * 16; const f32x4 s0 = *(const f32x4*)(ssqS + (size_t)row * 8), s1 = *(const f32x4*)(ssqS + (size_t)row * 8 + 4);
                const float rstd = rsqrtf(((s0[0] + s0[1]) + (s0[2] + s0[3]) + (s1[0] + s1[1]) + (s1[2] + s1[3])) * (1.f / DM_) + EPS_);
#pragma unroll
                for (int bj = 0; bj < 2; ++bj)
#pragma unroll
                    for (int n = 0; n < 2; ++n) acc[ai][bj][m][n] = acc[ai][bj][m][n] * rstd; }
    }
    DI void operator()(const f32x4 (&acc)[2][2][4][2], const Unit& u, int wr, int wc, int fr, int fq) const {
        const int row0 = u.pm * BM + wr * 64 + fr, col0 = u.pn * BM + wc * 32 + 8 * fq;
#pragma unroll
        for (int ai = 0; ai < 2; ++ai)
#pragma unroll
            for (int m = 0; m < 4; ++m) { const size_t rb = (size_t)(row0 + ai * HALF + m * 16) * D_ + col0;
#pragma unroll
                for (int bj = 0; bj < 2; ++bj) { const u32x4 xv = *(const u32x4*)(xres + rb + bj * HALF); const f32x4 v0 = acc[ai][bj][m][0], v1 = acc[ai][bj][m][1];
                    u32x4 o; o.x = cvt_pk_bf16(ALPHA_ * bflo(xv.x) + v0[0], ALPHA_ * bfhi(xv.x) + v0[1]); o.y = cvt_pk_bf16(ALPHA_ * bflo(xv.y) + v0[2], ALPHA_ * bfhi(xv.y) + v0[3]);
                    o.z = cvt_pk_bf16(ALPHA_ * bflo(xv.z) + v1[0], ALPHA_ * bfhi(xv.z) + v1[1]); o.w = cvt_pk_bf16(ALPHA_ * bflo(xv.w) + v1[2], ALPHA_ * bfhi(xv.w) + v1[3]);
                    *(u32x4*)(r1 + rb + bj * HALF) = o; } }
    }
};
struct EpiOutLn {
    static constexpr bool PERM = true, MIDSCALE = true, FP8 = false, AFTER_DRAIN = true;
    const bf16_t* xres; const float* ssqS; const bf16_t* ghl; const float* rtc; const float* ln_g; const float* ln_b;
    float* xch; unsigned* cnt; bf16_t* x1b; unsigned char* x1q; unsigned* cur; int* buf_t; float* buf_w; int* slot_of;
    DI void mid(f32x4 (&acc)[2][2][4][2], const Unit& u, int wr, int fr) const {
        const int row0 = u.pm * BM + wr * 64 + fr;
#pragma unroll
        for (int ai = 0; ai < 2; ++ai)
#pragma unroll
            for (int m = 0; m < 4; ++m) { const int row = row0 + ai * HALF + m * 16; const f32x4 s0 = *(const f32x4*)(ssqS + (size_t)row * 8), s1 = *(const f32x4*)(ssqS + (size_t)row * 8 + 4);
                const float rstd = rsqrtf(((s0[0] + s0[1]) + (s0[2] + s0[3]) + (s1[0] + s1[1]) + (s1[2] + s1[3])) * (1.f / DM_) + EPS_);
#pragma unroll
                for (int bj = 0; bj < 2; ++bj)
#pragma unroll
                    for (int n = 0; n < 2; ++n) acc[ai][bj][m][n] = acc[ai][bj][m][n] * rstd; }
    }
    DI void operator()(const f32x4 (&)[2][2][4][2], const Unit&, int, int, int, int) const {}
    DI void fused(f32x4 (&acc)[2][2][4][2], const Unit& u, int wr, int wc, int fr, int fq, LAS unsigned char* lds, int tid) const {
        LAS float* PT4 = (LAS float*)lds;
        LAS float* MS = (LAS float*)(lds + 81920);
        const int row0 = u.pm * BM + wr * 64 + fr, col0 = u.pn * BM + wc * 32 + 8 * fq;
        u32x4 gtv[6];
#pragma unroll
        for (int i = 0; i < 6; ++i) { const int idx = tid + i * NT_; gtv[i] = *(const u32x4*)(ghl + (size_t)(idx >> 5) * D_ + u.pn * BM + (idx & 31) * 8); }
#pragma unroll
        for (int ai = 0; ai < 2; ++ai) {
#pragma unroll
            for (int m = 0; m < 4; ++m) { const size_t rb = (size_t)(row0 + ai * HALF + m * 16) * D_ + col0;
#pragma unroll
                for (int bj = 0; bj < 2; ++bj) { const u32x4 xv = *(const u32x4*)(xres + rb + bj * HALF); f32x4 v0 = acc[ai][bj][m][0], v1 = acc[ai][bj][m][1];
                    v0[0] += ALPHA_ * bflo(xv.x); v0[1] += ALPHA_ * bfhi(xv.x); v0[2] += ALPHA_ * bflo(xv.y); v0[3] += ALPHA_ * bfhi(xv.y);
                    v1[0] += ALPHA_ * bflo(xv.z); v1[1] += ALPHA_ * bfhi(xv.z); v1[2] += ALPHA_ * bflo(xv.w); v1[3] += ALPHA_ * bfhi(xv.w);
                    acc[ai][bj][m][0] = v0; acc[ai][bj][m][1] = v1; } } }
        asm volatile("" ::: "memory");
        LAS unsigned char* GT = lds + 83968;
        LAS float* LG = (LAS float*)(lds + 134656);
        LAS int* cntL = (LAS int*)(lds + 144896); LAS int* baseL = cntL + 32; LAS int* tokE = baseL + 32; LAS float* tokW = (LAS float*)(tokE + 128);
        if (tid < 32) cntL[tid] = 0;
#pragma unroll
        for (int i = 0; i < 6; ++i) { const int idx = tid + i * NT_; *(LAS u32x4*)(GT + (idx >> 5) * 528 + (idx & 31) * 16) = gtv[i]; }
        __syncthreads();
        const LAS unsigned char* gfrag = GT + fr * 528 + (wc * 32 + 8 * fq) * 2;
        float* xq = xch + (size_t)(u.pm * 4 + u.pn) * 256 * 40;
#pragma unroll
        for (int ai = 0; ai < 2; ++ai) {
#pragma unroll
            for (int m = 0; m < 4; ++m) {
                f32x4 d[3]; d[0] = (f32x4){0.f, 0.f, 0.f, 0.f}; d[1] = d[0]; d[2] = d[0]; float s2 = 0.f;
#pragma unroll
                for (int bj = 0; bj < 2; ++bj) { const f32x4 v0 = acc[ai][bj][m][0], v1 = acc[ai][bj][m][1];
                    u32x4 h, lo; h.x = cvt_pk_bf16(v0[0], v0[1]); h.y = cvt_pk_bf16(v0[2], v0[3]); h.z = cvt_pk_bf16(v1[0], v1[1]); h.w = cvt_pk_bf16(v1[2], v1[3]);
                    lo.x = cvt_pk_bf16(v0[0] - bflo(h.x), v0[1] - bfhi(h.x)); lo.y = cvt_pk_bf16(v0[2] - bflo(h.y), v0[3] - bfhi(h.y));
                    lo.z = cvt_pk_bf16(v1[0] - bflo(h.z), v1[1] - bfhi(h.z)); lo.w = cvt_pk_bf16(v1[2] - bflo(h.w), v1[3] - bfhi(h.w));
                    const bf16x8 ah = __builtin_bit_cast(bf16x8, h), al = __builtin_bit_cast(bf16x8, lo);
#pragma unroll
                    for (int ob = 0; ob < 3; ++ob) { const bf16x8 gh = *(const LAS bf16x8*)(gfrag + ob * 16 * 528 + bj * 256), gl = *(const LAS bf16x8*)(gfrag + (48 + ob * 16) * 528 + bj * 256);
                        d[ob] = mfma16(gh, ah, d[ob]); d[ob] = mfma16(gl, ah, d[ob]); d[ob] = mfma16(gh, al, d[ob]); }
                    s2 += ((v0[0] * v0[0] + v0[1] * v0[1]) + (v0[2] * v0[2] + v0[3] * v0[3])) + ((v1[0] * v1[0] + v1[1] * v1[1]) + (v1[2] * v1[2] + v1[3] * v1[3])); }
                s2 += __shfl_xor(s2, 16); s2 += __shfl_xor(s2, 32);
                if (fq == 1) d[2][1] = s2;
                LAS float* rp = PT4 + (wc * 128 + wr * 64 + m * 16 + fr) * 40;
                *(LAS f32x4*)(rp + 4 * fq) = d[0]; *(LAS f32x4*)(rp + 16 + 4 * fq) = d[1]; if (fq < 2) *(LAS f32x4*)(rp + 32 + 4 * fq) = d[2];
            }
            __syncthreads();
            for (int idx = tid; idx < 1280; idx += NT_) { const LAS f32x4* q4 = (const LAS f32x4*)PT4 + idx; const f32x4 s = ((q4[0] + q4[1280]) + q4[2560]) + q4[3840];
                unsigned long long* dst = (unsigned long long*)(xq + (size_t)ai * 5120 + (size_t)idx * 4);
                __hip_atomic_store(dst, ((unsigned long long)__float_as_uint(s[1]) << 32) | __float_as_uint(s[0]), __ATOMIC_RELAXED, __HIP_MEMORY_SCOPE_AGENT);
                __hip_atomic_store(dst + 1, ((unsigned long long)__float_as_uint(s[3]) << 32) | __float_as_uint(s[2]), __ATOMIC_RELAXED, __HIP_MEMORY_SCOPE_AGENT); }
            __syncthreads();
        }
        f32x4 gg[2][2], bb[2][2];
#pragma unroll
        for (int bj = 0; bj < 2; ++bj)
#pragma unroll
            for (int n = 0; n < 2; ++n) { gg[bj][n] = *(const f32x4*)(ln_g + col0 + bj * HALF + 4 * n); bb[bj][n] = *(const f32x4*)(ln_b + col0 + bj * HALF + 4 * n); }
        asm volatile("s_waitcnt vmcnt(0)" ::: "memory");
        if (fr == 0 && fq == 0) __hip_atomic_fetch_add(cnt + 16 * u.pm, 1u, __ATOMIC_RELAXED, __HIP_MEMORY_SCOPE_AGENT);
        if (tid < 64) {
            unsigned spins = 0;
            while ((unsigned)__builtin_amdgcn_readfirstlane(__hip_atomic_load(cnt + 16 * u.pm, __ATOMIC_RELAXED, __HIP_MEMORY_SCOPE_AGENT)) < 32u) { __builtin_amdgcn_s_sleep(2); if (++spins > (1u << 22)) break; }
            __builtin_amdgcn_fence(__ATOMIC_ACQUIRE, "agent");
            asm volatile("s_waitcnt vmcnt(0)" ::: "memory");
        }
        __syncthreads();
        const float* xp = xch + (size_t)u.pm * 4 * 256 * 40;
        {
            const int rl = tid >> 3, rr = u.pn * 64 + rl, q = tid & 7;
            f32x4 pa[4], pb[4]; f32x2_ st[4], sm[4];
#pragma unroll
            for (int t = 0; t < 4; ++t) { const float* rec = xp + ((size_t)t * 256 + rr) * 40; pa[t] = *(const f32x4*)(rec + 4 * q); st[t] = *(const f32x2_*)(rec + 36);
                pb[t] = (f32x4){0.f, 0.f, 0.f, 0.f}; if (q == 0) pb[t] = *(const f32x4*)(rec + 32);
                sm[t] = (f32x2_){0.f, 0.f}; if (tid < 256) sm[t] = *(const f32x2_*)(xp + ((size_t)t * 256 + tid) * 40 + 36); }
            const f32x4 cs = *(const f32x4*)(rtc + 4 * q), bw = *(const f32x4*)(rtc + 40 + 4 * q), cs8 = *(const f32x4*)(rtc + 32), bw8 = *(const f32x4*)(rtc + 72);
            const f32x2_ sr = ((st[0] + st[1]) + st[2]) + st[3], sq = ((sm[0] + sm[1]) + sm[2]) + sm[3];
            const float mean = sr[0] * (1.f / D_), rstd = rsqrtf(fmaxf(sr[1] * (1.f / D_) - mean * mean, 0.f) + EPS_);
            const f32x4 sa = ((pa[0] + pa[1]) + pa[2]) + pa[3], sb = ((pb[0] + pb[1]) + pb[2]) + pb[3];
            *(LAS f32x4*)(LG + rl * 40 + 4 * q) = (sa - cs * mean) * rstd + bw;
            if (q == 0) *(LAS f32x4*)(LG + rl * 40 + 32) = (sb - cs8 * mean) * rstd + bw8;
            if (tid < 256) { const float mq = sq[0] * (1.f / D_); MS[2 * tid] = mq; MS[2 * tid + 1] = rsqrtf(fmaxf(sq[1] * (1.f / D_) - mq * mq, 0.f) + EPS_); }
        }
        __syncthreads();
        if (tid < 64) { const LAS float* lg = LG + tid * 40;
            const f32x4 gl = *(const LAS f32x4*)lg; float mx = gl[0]; int gi = 0;
#pragma unroll
            for (int i = 1; i < 4; ++i) if (gl[i] > mx) { mx = gl[i]; gi = i; }
            float se = 0.f;
#pragma unroll
            for (int i = 0; i < 4; ++i) se += expf(gl[i] - mx);
            const float pg = 1.0f / se;
            const f32x4 e0 = *(const LAS f32x4*)(lg + 4 + gi * 8), e1 = *(const LAS f32x4*)(lg + 8 + gi * 8);
            float ev[8];
#pragma unroll
            for (int i = 0; i < 4; ++i) { ev[i] = e0[i]; ev[4 + i] = e1[i]; }
            int i0 = 0;
#pragma unroll
            for (int i = 1; i < 8; ++i) if (ev[i] > ev[i0]) i0 = i;
            int i1 = (i0 == 0) ? 1 : 0;
#pragma unroll
            for (int i = 0; i < 8; ++i) if (i != i0 && ev[i] > ev[i1]) i1 = i;
            const float e1x = expf(ev[i1] - ev[i0]); const float w0 = 1.f / (1.f + e1x), w1 = e1x / (1.f + e1x);
            const int ea = gi * 8 + i0, eb = gi * 8 + i1;
            const int ra = atomicAdd((int*)&cntL[ea], 1), rb = atomicAdd((int*)&cntL[eb], 1);
            tokE[tid * 2] = (ea << 16) | ra; tokE[tid * 2 + 1] = (eb << 16) | rb; tokW[tid * 2] = pg * w0; tokW[tid * 2 + 1] = pg * w1;
        }
        __syncthreads();
        int basev = 0;
        if (tid < 32) { const int cl = cntL[tid]; basev = cl ? (int)atomicAdd(&cur[tid * 16], (unsigned)cl) : 0; }
#pragma unroll
        for (int ai = 0; ai < 2; ++ai)
#pragma unroll
            for (int m = 0; m < 4; ++m) { const int rl = ai * HALF + wr * 64 + m * 16 + fr; const float mean = MS[2 * rl], rstd = MS[2 * rl + 1]; const size_t rb = (size_t)(u.pm * BM + rl) * D_ + col0;
#pragma unroll
                for (int bj = 0; bj < 2; ++bj) { const f32x4 y0 = (acc[ai][bj][m][0] - mean) * rstd * gg[bj][0] + bb[bj][0], y1 = (acc[ai][bj][m][1] - mean) * rstd * gg[bj][1] + bb[bj][1];
                    u32x4 o; o.x = cvt_pk_bf16(y0[0], y0[1]); o.y = cvt_pk_bf16(y0[2], y0[3]); o.z = cvt_pk_bf16(y1[0], y1[1]); o.w = cvt_pk_bf16(y1[2], y1[3]);
                    *(u32x4*)(x1b + rb + bj * HALF) = o;
                    u32x2 q8; q8.x = pack4_fp8(y0[0], y0[1], y0[2], y0[3]); q8.y = pack4_fp8(y1[0], y1[1], y1[2], y1[3]); *(u32x2*)(x1q + rb + bj * HALF) = q8; } }
        if (tid < 32) baseL[tid] = basev;
        __syncthreads();
        if (tid < 128) { const int v = tokE[tid]; const int e = v >> 16, r = baseL[e] + (v & 0xffff); const int token = u.pm * BM + u.pn * 64 + (tid >> 1);
            buf_t[(size_t)e * ECAP_ + r] = token; buf_w[(size_t)e * ECAP_ + r] = tokW[tid]; slot_of[token * 2 + (tid & 1)] = (e << 16) | r; }
    }
};
struct EpiSiluMul {
    static constexpr bool PERM = true, MIDSCALE = false, FP8 = true, AFTER_DRAIN = false;
    unsigned char* Hb; unsigned* done;
    DI void operator()(const f32x4 (&acc)[2][2][4][2], const Unit& u, int wr, int wc, int fr, int fq) const {
        const int row0 = u.pm * BM + wr * 64 + fr, hu0 = u.pn * 128 + wc * 32 + 8 * fq;
#pragma unroll
        for (int ai = 0; ai < 2; ++ai)
#pragma unroll
            for (int m = 0; m < 4; ++m) { unsigned char* rowp = Hb + (size_t)(row0 + ai * HALF + m * 16) * DE_ + hu0;
                const f32x4 g0 = acc[ai][0][m][0] * W8_INV, g1 = acc[ai][0][m][1] * W8_INV, u0 = acc[ai][1][m][0] * W8_INV, u1 = acc[ai][1][m][1] * W8_INV;
                const unsigned lo = pack4_fp8(fast_silu(g0[0]) * u0[0], fast_silu(g0[1]) * u0[1], fast_silu(g0[2]) * u0[2], fast_silu(g0[3]) * u0[3]);
                const unsigned hi = pack4_fp8(fast_silu(g1[0]) * u1[0], fast_silu(g1[1]) * u1[1], fast_silu(g1[2]) * u1[2], fast_silu(g1[3]) * u1[3]);
                __hip_atomic_store((unsigned long long*)rowp, ((unsigned long long)hi << 32) | lo, __ATOMIC_RELAXED, __HIP_MEMORY_SCOPE_AGENT); }
        asm volatile("s_waitcnt vmcnt(0)" ::: "memory");
        if (fr == 0 && fq == 0) __hip_atomic_fetch_add(done + 16 * u.pm, 1u, __ATOMIC_RELAXED, __HIP_MEMORY_SCOPE_AGENT);
    }
};
struct EpiDown {
    static constexpr bool PERM = true, MIDSCALE = false, FP8 = true, AFTER_DRAIN = false;
    unsigned char* O; const float* buf_w; const LAS int* cnt;
    DI void operator()(const f32x4 (&acc)[2][2][4][2], const Unit& u, int wr, int wc, int fr, int fq) const {
        const int e = u.aux >> 7, kb = (u.aux & 127) * 256, ce = cnt[e];
        const int rl0 = wr * 64 + fr, col0 = u.pn * BM + wc * 32 + 8 * fq;
#pragma unroll
        for (int ai = 0; ai < 2; ++ai)
#pragma unroll
            for (int m = 0; m < 4; ++m) { const int rl = rl0 + ai * HALF + m * 16; const float sc = (kb + rl < ce) ? buf_w[(size_t)e * ECAP_ + kb + rl] * (W8_INV * YE_SCALE) : 0.f;
                unsigned char* rowp = O + (size_t)(u.pm * BM + rl) * D_ + col0;
#pragma unroll
                for (int bj = 0; bj < 2; ++bj) { const f32x4 v0 = acc[ai][bj][m][0] * sc, v1 = acc[ai][bj][m][1] * sc;
                    u32x2 o; o.x = pack4_fp8(v0[0], v0[1], v0[2], v0[3]); o.y = pack4_fp8(v1[0], v1[1], v1[2], v1[3]);
                    *(u32x2*)(rowp + bj * HALF) = o; } }
    }
};
struct EpiT {
    static constexpr bool PERM = false, MIDSCALE = false, FP8 = false, AFTER_DRAIN = false;
    bf16_t* Tb; float* ssqT;
    DI void operator()(const f32x4 (&acc)[2][2][4][2], const Unit& u, int wr, int wc, int fr, int fq) const {
        const int row0 = u.pm * BM + wr * 64 + fr, col0 = u.pn * BM + wc * 32 + 4 * fq;
#pragma unroll
        for (int ai = 0; ai < 2; ++ai)
#pragma unroll
            for (int m = 0; m < 4; ++m) { const int row = row0 + ai * HALF + m * 16; float ss = 0.f;
#pragma unroll
                for (int bj = 0; bj < 2; ++bj)
#pragma unroll
                    for (int n = 0; n < 2; ++n) { const f32x4 a = acc[ai][bj][m][n]; ss += (a[0] * a[0] + a[1] * a[1]) + (a[2] * a[2] + a[3] * a[3]);
                        u32x2 o; o.x = cvt_pk_bf16(a[0], a[1]); o.y = cvt_pk_bf16(a[2], a[3]); *(u32x2*)(Tb + (size_t)row * D_ + col0 + bj * HALF + n * 16) = o; }
                ss += __shfl_xor(ss, 16); ss += __shfl_xor(ss, 32);
                if (fq == 0) ssqT[(size_t)row * 16 + u.pn * 4 + wc] = ss; }
    }
};
struct EpiPle {
    static constexpr bool PERM = true, MIDSCALE = false, FP8 = false, AFTER_DRAIN = false;
    const bf16_t* x2b; const bf16_t* Tb; const float* rstdT; const float* b_pg; const float* ple_g; float* xout; bf16_t* xb;
    DI void operator()(const f32x4 (&acc)[2][2][4][2], const Unit& u, int wr, int wc, int fr, int fq) const {
        const int row0 = u.pm * BM + wr * 64 + fr, col0 = u.pn * BM + wc * 32 + 8 * fq;
        f32x4 bp[2][2], pg[2][2];
#pragma unroll
        for (int bj = 0; bj < 2; ++bj)
#pragma unroll
            for (int n = 0; n < 2; ++n) { bp[bj][n] = *(const f32x4*)(b_pg + col0 + bj * HALF + 4 * n); pg[bj][n] = *(const f32x4*)(ple_g + col0 + bj * HALF + 4 * n); }
#pragma unroll
        for (int ai = 0; ai < 2; ++ai)
#pragma unroll
            for (int m = 0; m < 4; ++m) { const int row = row0 + ai * HALF + m * 16; const float rstd = rstdT[row];
#pragma unroll
                for (int bj = 0; bj < 2; ++bj) { const size_t o = (size_t)row * D_ + col0 + bj * HALF;
                    const u32x4 xv = *(const u32x4*)(x2b + o), tv = *(const u32x4*)(Tb + o);
                    const f32x4 a0 = acc[ai][bj][m][0], a1 = acc[ai][bj][m][1];
                    f32x4 r0, r1;
                    r0[0] = bflo(xv.x) + fast_sigmoid(a0[0] + bp[bj][0][0]) * bflo(tv.x) * rstd * pg[bj][0][0]; r0[1] = bfhi(xv.x) + fast_sigmoid(a0[1] + bp[bj][0][1]) * bfhi(tv.x) * rstd * pg[bj][0][1];
                    r0[2] = bflo(xv.y) + fast_sigmoid(a0[2] + bp[bj][0][2]) * bflo(tv.y) * rstd * pg[bj][0][2]; r0[3] = bfhi(xv.y) + fast_sigmoid(a0[3] + bp[bj][0][3]) * bfhi(tv.y) * rstd * pg[bj][0][3];
                    r1[0] = bflo(xv.z) + fast_sigmoid(a1[0] + bp[bj][1][0]) * bflo(tv.z) * rstd * pg[bj][1][0]; r1[1] = bfhi(xv.z) + fast_sigmoid(a1[1] + bp[bj][1][1]) * bfhi(tv.z) * rstd * pg[bj][1][1];
                    r1[2] = bflo(xv.w) + fast_sigmoid(a1[2] + bp[bj][1][2]) * bflo(tv.w) * rstd * pg[bj][1][2]; r1[3] = bfhi(xv.w) + fast_sigmoid(a1[3] + bp[bj][1][3]) * bfhi(tv.w) * rstd * pg[bj][1][3];
                    if (xout) { *(f32x4*)(xout + o) = r0; *(f32x4*)(xout + o + 4) = r1; }
                    else { u32x4 ob; ob.x = cvt_pk_bf16(r0[0], r0[1]); ob.y = cvt_pk_bf16(r0[2], r0[3]); ob.z = cvt_pk_bf16(r1[0], r1[1]); ob.w = cvt_pk_bf16(r1[2], r1[3]); *(u32x4*)(xb + o) = ob; } } }
    }
};

struct Ctx { int G, bid, tid, lane, w; };
DI const float* IN(PR p, int i) { return p.in[i]; }
template <class T> DI T* WSP(PR p, size_t off) { return (T*)(p.ws + off); }

struct TJob { const float* src0; const float* src1; bf16_t* dst; int ldw, K, N, mode, nmat, krot, kscale_n, fp8; size_t sstr, dstr, kstr; float scale; const float* kscale; };
DI void transpose_job(const TJob& j, int gwave, int nwaves, LAS float* scr, int lane) {
    const int nkb = j.K / 64, nnb = j.N / 32; const long per = (long)nkb * nnb, total = per * j.nmat;
    for (long it = gwave; it < total; it += nwaves) {
        const int mat = (int)(it / per); const int r = (int)(it % per); const int kb = r / nnb, nb = r % nnb, k0 = kb * 64, n0 = nb * 32;
        const int n = n0 + (lane & 31);
        const float* sp; int col;
        if (j.mode == 2) { const int blk = n >> 7; sp = (const float*)((const char*)j.src0 + (ptrdiff_t)(blk & 1) * ((const char*)j.src1 - (const char*)j.src0)); col = 128 * (blk >> 1) + (n & 127); }
        else { sp = j.src0; col = n + ((j.mode == 1 && n >= 1536) ? 8 : 0); }
        sp += (size_t)mat * j.sstr + col;
#pragma unroll
        for (int i = 0; i < 32; ++i) { const int kk = 2 * i + (lane >> 5); const int kd = k0 + kk; const int ksrc = (kd + j.krot) & (j.K - 1);
            float v = sp[(size_t)ksrc * j.ldw] * j.scale; if (j.kscale && kd < j.kscale_n) v *= j.kscale[(size_t)mat * j.kstr + kd];
            scr[kk * 33 + (lane & 31)] = v; }
        __builtin_amdgcn_s_waitcnt(0xC07F); __builtin_amdgcn_wave_barrier();
        const int c = lane & 7;
        bf16_t* d = j.dst + (size_t)mat * j.dstr;
#pragma unroll
        for (int jj = 0; jj < 4; ++jj) { const int nn = (lane >> 3) + 8 * jj; const LAS float* s = scr + (8 * c) * 33 + nn;
            if (j.fp8) { u32x2 o8; o8.x = pack4_fp8(s[0 * 33], s[1 * 33], s[2 * 33], s[3 * 33]); o8.y = pack4_fp8(s[4 * 33], s[5 * 33], s[6 * 33], s[7 * 33]);
                *(u32x2*)((unsigned char*)j.dst + (size_t)mat * j.dstr + (size_t)(n0 + nn) * j.K + k0 + 8 * c) = o8; }
            else { u32x4 o; o.x = cvt_pk_bf16(s[0 * 33], s[1 * 33]); o.y = cvt_pk_bf16(s[2 * 33], s[3 * 33]); o.z = cvt_pk_bf16(s[4 * 33], s[5 * 33]); o.w = cvt_pk_bf16(s[6 * 33], s[7 * 33]);
                *(u32x4*)(d + (size_t)(n0 + nn) * j.K + k0 + 8 * c) = o; } }
        __builtin_amdgcn_s_waitcnt(0xC07F); __builtin_amdgcn_wave_barrier();
    }
}
DI TJob mk_job(const float* s0, const float* s1, int ldw, int K, int N, bf16_t* dst, int mode, int nmat, size_t sstr, size_t dstr, float scale = 1.f) {
    TJob j; j.src0 = s0; j.src1 = s1; j.dst = dst; j.ldw = ldw; j.K = K; j.N = N; j.mode = mode; j.nmat = nmat; j.krot = 0; j.kscale_n = 0; j.fp8 = 0; j.sstr = sstr; j.dstr = dstr; j.kstr = 0; j.scale = scale; j.kscale = nullptr; return j;
}
DI void cvt_rows(const float* __restrict__ src, bf16_t* __restrict__ dst, size_t n8, size_t gt, size_t nthreads) {
    for (size_t i = gt; i < n8; i += nthreads) { const f32x4 a = ((const f32x4*)src)[2 * i], b = ((const f32x4*)src)[2 * i + 1];
        u32x4 o; o.x = cvt_pk_bf16(a[0], a[1]); o.y = cvt_pk_bf16(a[2], a[3]); o.z = cvt_pk_bf16(b[0], b[1]); o.w = cvt_pk_bf16(b[2], b[3]); ((u32x4*)dst)[i] = o; }
}
DI void moe_weight_jobs(PR p, const Ctx& c, int l, LAS unsigned char* lds, bool probe_dummy = false) {
    LAS float* scr = (LAS float*)(lds + c.w * 8448);
    const int gwave = c.bid * 4 + (c.w - 4), nwaves = c.G * 4;
    { TJob j = mk_job(IN(p, 28) + (size_t)l * NE_ * D_ * DE_, IN(p, 29) + (size_t)l * NE_ * D_ * DE_, DE_, D_, D_, probe_dummy ? WSP<bf16_t>(p, WS_YE) : WSP<bf16_t>(p, WS_WGU), 2, NE_, (size_t)D_ * DE_, (size_t)D_ * D_, W8_SCALE); j.fp8 = 1;
      transpose_job(j, gwave, nwaves, scr, c.lane); }
    { TJob j = mk_job(IN(p, 30) + (size_t)l * NE_ * DE_ * D_, nullptr, D_, DE_, D_, probe_dummy ? WSP<bf16_t>(p, WS_YE) + (size_t)NE_ * D_ * D_ / 2 : WSP<bf16_t>(p, WS_WED), 0, NE_, (size_t)DE_ * D_, (size_t)D_ * DE_, W8_SCALE); j.fp8 = 1;
      transpose_job(j, gwave, nwaves, scr, c.lane); }
}

DI void s5_prep_job(PR p, int lg, LAS unsigned char* lds, int tid) {
    LAS float* apr = (LAS float*)lds;
    LAS float* api = apr + 17 * 64;
    LAS float* bbr = api + 17 * 64;
    LAS float* bbi = bbr + 1024;
    LAS float* ccr = bbi + 1024;
    LAS float* cci = ccr + 16 * 68;
    LAS float* kd = cci + 16 * 68;
    const float* lam_re = IN(p, 10); const float* lam_im = IN(p, 11); const float* b_re = IN(p, 13); const float* b_im = IN(p, 14); const float* c_re = IN(p, 15); const float* c_im = IN(p, 16);
    const float dt = expf(IN(p, 12)[lg]);
    __syncthreads();
    for (int idx = tid; idx < 17 * 64; idx += NT_) { const int pp = idx & 63, d = idx >> 6; const float lr = lam_re[lg * 64 + pp], li = lam_im[lg * 64 + pp];
        const float er = expf((float)d * lr * dt), ang = (float)d * li * dt; apr[d * 64 + pp] = er * cosf(ang); api[d * 64 + pp] = er * sinf(ang); }
    for (int idx = tid; idx < 1024; idx += NT_) { const int pp = idx >> 4, ci = idx & 15; const float lr = lam_re[lg * 64 + pp], li = lam_im[lg * 64 + pp];
        const float er = expf(lr * dt), ar = er * cosf(li * dt), ai = er * sinf(li * dt); const float mag2 = lr * lr + li * li, xr0 = ar - 1.f, xi0 = ai;
        const float cr = (xr0 * lr + xi0 * li) / mag2, cim = (xi0 * lr - xr0 * li) / mag2; const float br = b_re[(size_t)(lg * 64 + pp) * 16 + ci], bi = b_im[(size_t)(lg * 64 + pp) * 16 + ci];
        bbr[pp * 16 + ci] = cr * br - cim * bi; bbi[pp * 16 + ci] = cr * bi + cim * br; }
    for (int idx = tid; idx < 1024; idx += NT_) { ccr[(idx >> 6) * 68 + (idx & 63)] = c_re[(size_t)lg * 1024 + idx]; cci[(idx >> 6) * 68 + (idx & 63)] = c_im[(size_t)lg * 1024 + idx]; }
    __syncthreads();
    {
        const int d = tid >> 5, co = (tid >> 1) & 15, hf = tid & 1; f32x4 v0 = (f32x4){0.f, 0.f, 0.f, 0.f}, v1 = v0;
        for (int pp = 0; pp < 64; ++pp) { const float ar = apr[d * 64 + pp], ai = api[d * 64 + pp], cr = ccr[co * 68 + pp], ci_ = cci[co * 68 + pp];
            const float wr_ = cr * ar - ci_ * ai, wi_ = cr * ai + ci_ * ar;
            const f32x4 r0 = *(const LAS f32x4*)(bbr + pp * 16 + hf * 8), r1 = *(const LAS f32x4*)(bbr + pp * 16 + hf * 8 + 4), i0 = *(const LAS f32x4*)(bbi + pp * 16 + hf * 8), i1 = *(const LAS f32x4*)(bbi + pp * 16 + hf * 8 + 4);
            v0 = v0 + r0 * wr_ - i0 * wi_; v1 = v1 + r1 * wr_ - i1 * wi_; }
        if (d == 0) { const float dsk = IN(p, 17)[lg * 16 + co];
#pragma unroll
            for (int e = 0; e < 4; ++e) { if (co == hf * 8 + e) v0[e] += dsk; if (co == hf * 8 + 4 + e) v1[e] += dsk; } }
        *(LAS f32x4*)(kd + (d * 16 + co) * 16 + hf * 8) = v0; *(LAS f32x4*)(kd + (d * 16 + co) * 16 + hf * 8 + 4) = v1; }
    __syncthreads();
    bf16_t* wy = WSP<bf16_t>(p, WS_WYT) + (size_t)lg * 256 * S5K_;
    for (int idx = tid; idx < 256 * 48; idx += NT_) { const int n = idx / 48, kc = idx % 48, j = n >> 4, co = n & 15; f32x4 v0 = (f32x4){0.f, 0.f, 0.f, 0.f}, v1 = v0;
        if (kc < 32) { const int i = kc >> 1, ci0 = (kc & 1) * 8; if (i <= j) { v0 = *(const LAS f32x4*)(kd + ((j - i) * 16 + co) * 16 + ci0); v1 = *(const LAS f32x4*)(kd + ((j - i) * 16 + co) * 16 + ci0 + 4); } }
        else { const int kk0 = (kc - 32) * 8, pp0 = kk0 & 63;
            const f32x4 c0r = *(const LAS f32x4*)(ccr + co * 68 + pp0), c1r = *(const LAS f32x4*)(ccr + co * 68 + pp0 + 4), c0i = *(const LAS f32x4*)(cci + co * 68 + pp0), c1i = *(const LAS f32x4*)(cci + co * 68 + pp0 + 4);
            const f32x4 a0r = *(const LAS f32x4*)(apr + (j + 1) * 64 + pp0), a1r = *(const LAS f32x4*)(apr + (j + 1) * 64 + pp0 + 4), a0i = *(const LAS f32x4*)(api + (j + 1) * 64 + pp0), a1i = *(const LAS f32x4*)(api + (j + 1) * 64 + pp0 + 4);
            if (kk0 < 64) { v0 = c0r * a0r - c0i * a0i; v1 = c1r * a1r - c1i * a1i; } else { v0 = -(c0r * a0i + c0i * a0r); v1 = -(c1r * a1i + c1i * a1r); } }
        u32x4 o; o.x = cvt_pk_bf16(v0[0], v0[1]); o.y = cvt_pk_bf16(v0[2], v0[3]); o.z = cvt_pk_bf16(v1[0], v1[1]); o.w = cvt_pk_bf16(v1[2], v1[3]);
        *(u32x4*)(wy + (size_t)n * S5K_ + kc * 8) = o; }
    bf16_t* we = WSP<bf16_t>(p, WS_WET) + (size_t)lg * 256 * 256;
    for (int idx = tid; idx < 256 * 32; idx += NT_) { const int n = idx >> 5, kc = idx & 31; f32x4 v0 = (f32x4){0.f, 0.f, 0.f, 0.f}, v1 = v0;
        if (n < 128) { const int pp = n & 63, i = kc >> 1, ci0 = (kc & 1) * 8; const float ar = apr[(15 - i) * 64 + pp], ai = api[(15 - i) * 64 + pp];
            const f32x4 r0 = *(const LAS f32x4*)(bbr + pp * 16 + ci0), r1 = *(const LAS f32x4*)(bbr + pp * 16 + ci0 + 4), i0 = *(const LAS f32x4*)(bbi + pp * 16 + ci0), i1 = *(const LAS f32x4*)(bbi + pp * 16 + ci0 + 4);
            if (n < 64) { v0 = r0 * ar - i0 * ai; v1 = r1 * ar - i1 * ai; } else { v0 = i0 * ar + r0 * ai; v1 = i1 * ar + r1 * ai; } }
        u32x4 o; o.x = cvt_pk_bf16(v0[0], v0[1]); o.y = cvt_pk_bf16(v0[2], v0[3]); o.z = cvt_pk_bf16(v1[0], v1[1]); o.w = cvt_pk_bf16(v1[2], v1[3]);
        *(u32x4*)(we + (size_t)n * 256 + kc * 8) = o; }
    if (tid < 64) { float* A16 = WSP<float>(p, WS_A16); A16[(size_t)lg * 128 + tid] = apr[16 * 64 + tid]; A16[(size_t)lg * 128 + 64 + tid] = api[16 * 64 + tid]; }
}

DI void ph_prologue(PR p, const Ctx& c, LAS unsigned char* lds, int sel = 15) {
    const size_t gt = (size_t)c.bid * NT_ + c.tid, nth = (size_t)c.G * NT_;
    if (sel & 1) {
    cvt_rows(IN(p, 0), WSP<bf16_t>(p, WS_XB), (size_t)M_ * D_ / 8, gt, nth);
    cvt_rows(IN(p, 1), WSP<bf16_t>(p, WS_PBF), (size_t)L_ * M_ * PLE_ / 8, gt, nth);
    }
    if (sel & 2) {
    { bf16_t* wg = WSP<bf16_t>(p, WS_WGATE); const float* w_in = IN(p, 2);
      for (size_t i = gt; i < (size_t)L_ * 16 * D_; i += nth) { const int k = (int)(i % D_), n = (int)((i / D_) % 16), l = (int)(i / (16 * D_));
          wg[i] = (n < 8) ? f2bf(w_in[((size_t)l * D_ + k) * DIN_ + 1536 + n]) : (bf16_t)0; } }
    { bf16_t* ghl = WSP<bf16_t>(p, WS_GHL); const float* w_grp = IN(p, 24); const float* w_rt = IN(p, 26); const float* lng = IN(p, 22);
      for (size_t i = gt; i < (size_t)L_ * 48 * D_; i += nth) { const int k = (int)(i % D_), o = (int)((i / D_) % 48), l = (int)(i / (48 * D_));
          const float gk = lng[(size_t)l * D_ + k];
          const float v = (o < 4) ? w_grp[((size_t)l * D_ + k) * 4 + o] * gk : (o < 36) ? w_rt[((size_t)l * D_ + k) * 32 + (o - 4)] * gk : (o == 36 ? 1.f : 0.f);
          const bf16_t h = f2bf(v); ghl[((size_t)(l * 2) * 48 + o) * D_ + k] = h; ghl[((size_t)(l * 2 + 1) * 48 + o) * D_ + k] = f2bf(v - bf2f(h)); } }
    { float* rtc = WSP<float>(p, WS_RTC); const float* w_grp = IN(p, 24); const float* w_rt = IN(p, 26); const float* lng = IN(p, 22); const float* lnb = IN(p, 23);
      for (int job = c.bid * 8 + c.w; job < L_ * 40; job += c.G * 8) { const int l = job / 40, o = job % 40; float cs = 0.f, bw = 0.f;
          if (o < 36) { for (int k = c.lane; k < D_; k += 64) { const float wv = (o < 4) ? w_grp[((size_t)l * D_ + k) * 4 + o] : w_rt[((size_t)l * D_ + k) * 32 + (o - 4)];
                  cs += wv * lng[(size_t)l * D_ + k]; bw += wv * lnb[(size_t)l * D_ + k]; }
              cs = wave_sum(cs); bw = wave_sum(bw) + ((o < 4) ? IN(p, 25)[l * 4 + o] : IN(p, 27)[l * 32 + o - 4]); }
          if (c.lane == 0) { rtc[(l * 2) * 40 + o] = cs; rtc[(l * 2 + 1) * 40 + o] = bw; } } }
    }
    LAS float* scr = (LAS float*)(lds + c.w * 8448);
    const int gwave = c.bid * 8 + c.w, nwaves = c.G * 8;
    const bool split = (sel == 15) && (c.G >= 2 * L_ * G5_);
    if (split) {
        if (c.bid < L_ * G5_) { s5_prep_job(p, c.bid, lds, c.tid); __syncthreads(); }
        else transpose_job(mk_job(IN(p, 2), nullptr, DIN_, D_, 2048, WSP<bf16_t>(p, WS_WIN), 1, L_, (size_t)D_ * DIN_, (size_t)2048 * D_), (c.bid - L_ * G5_) * 8 + c.w, (c.G - L_ * G5_) * 8, scr, c.lane);
    }
    if (sel & 4) {
    if (!split) transpose_job(mk_job(IN(p, 2), nullptr, DIN_, D_, 2048, WSP<bf16_t>(p, WS_WIN), 1, L_, (size_t)D_ * DIN_, (size_t)2048 * D_), gwave, nwaves, scr, c.lane);
    { TJob j = mk_job(IN(p, 21), nullptr, D_, D_, D_, WSP<bf16_t>(p, WS_WOUT), 0, L_, (size_t)D_ * D_, (size_t)D_ * D_); j.krot = 512; j.kscale = IN(p, 20); j.kscale_n = 512; j.kstr = DM_;
      transpose_job(j, gwave, nwaves, scr, c.lane); }
    transpose_job(mk_job(IN(p, 33), nullptr, D_, D_, D_, WSP<bf16_t>(p, WS_WPG), 0, L_, (size_t)D_ * D_, (size_t)D_ * D_), gwave, nwaves, scr, c.lane);
    transpose_job(mk_job(IN(p, 35), nullptr, D_, PLE_, D_, WSP<bf16_t>(p, WS_WPP), 0, L_, (size_t)PLE_ * D_, (size_t)D_ * PLE_), gwave, nwaves, scr, c.lane);
    transpose_job(mk_job(IN(p, 18), nullptr, DM_, DM_, DM_, WSP<bf16_t>(p, WS_WGLU), 0, L_, (size_t)DM_ * DM_, (size_t)DM_ * DM_), gwave, nwaves, scr, c.lane);
    transpose_job(mk_job(IN(p, 5), nullptr, DH_, DH_, DH_, WSP<bf16_t>(p, WS_WQK), 0, L_ * H_, (size_t)DH_ * DH_, (size_t)256 * DH_), gwave, nwaves, scr, c.lane);
    transpose_job(mk_job(IN(p, 6), nullptr, DH_, DH_, DH_, WSP<bf16_t>(p, WS_WQK) + (size_t)DH_ * DH_, 0, L_ * H_, (size_t)DH_ * DH_, (size_t)256 * DH_, 0.08838834764831845f), gwave, nwaves, scr, c.lane);
    }
    if ((sel & 8) && !split) { for (int job = c.bid; job < L_ * G5_; job += c.G) { s5_prep_job(p, job, lds, c.tid); __syncthreads(); } }
}

DI void ph_inproj(PR p, const Ctx& c, int l, LAS unsigned char* lds) {
    DenseOrder S; S.init(WSP<bf16_t>(p, WS_XB), WSP<bf16_t>(p, WS_WIN) + (size_t)l * 2048 * D_, D_ * 2, D_ * 2, M_, 2048, c.G, c.bid);
    EpiInProj E{WSP<bf16_t>(p, WS_ZB), WSP<bf16_t>(p, WS_AS5)};
    gemm_phase<EpiInProj, DenseOrder>(lds, Gemm{(unsigned)(D_ * 2), (unsigned)(D_ * 2), D_}, S, E);
}

DI void mlstm_sum_unit(PR p, const Ctx& c, int l, int unit, LAS unsigned char* lds) {
    LAS unsigned char* ctile = lds;
    LAS unsigned char* ktile = lds + 32768;
    LAS unsigned char* vtile = lds + 65536;
    LAS float* wsS = (LAS float*)(lds + 98304);
    LAS float* gred = wsS + 256;
    const bf16_t* zb = WSP<bf16_t>(p, WS_ZB); const bf16_t* xb = WSP<bf16_t>(p, WS_XB); const bf16_t* wgate = WSP<bf16_t>(p, WS_WGATE) + (size_t)l * 16 * D_;
    const bf16_t* wqkT = WSP<bf16_t>(p, WS_WQK) + (size_t)l * H_ * 256 * DH_;
    const float* cw = IN(p, 3) + (size_t)l * 4 * DM_; const float* cb = IN(p, 4) + (size_t)l * DM_; const float* b_i = IN(p, 7) + l * H_; const float* b_f = IN(p, 8) + l * H_;
    bf16_t* qb = WSP<bf16_t>(p, WS_QB); bf16_t* kb = WSP<bf16_t>(p, WS_KB); bf16_t* Csum = WSP<bf16_t>(p, WS_CSUM); float* nsum = WSP<float>(p, WS_NSUM);
    float* gG = WSP<float>(p, WS_GG); float* mlG = WSP<float>(p, WS_MLG); float* igG = WSP<float>(p, WS_IGG); float* bcumG = WSP<float>(p, WS_BCUM);
    const int tid = c.tid, lane = c.lane, w = c.w, fr = lane & 15, fq = lane >> 4, hh = w >> 2, wq = w & 3;
    const int b = unit / (S_ / 64), cc = unit % (S_ / 64); const int tok0 = b * S_ + cc * 64;
    __syncthreads();
    {
        f32x4 ga[4];
#pragma unroll
        for (int ms = 0; ms < 4; ++ms) ga[ms] = (f32x4){0.f, 0.f, 0.f, 0.f};
#pragma unroll
        for (int kk = 0; kk < 4; ++kk) { const int ks = 4 * w + kk; const bf16x8 bw = ld_frag_g(wgate + (size_t)fr * D_ + 32 * ks + 8 * fq);
#pragma unroll
            for (int ms = 0; ms < 4; ++ms) { const bf16x8 af = ld_frag_g(xb + (size_t)(tok0 + 16 * ms + fr) * D_ + 32 * ks + 8 * fq); ga[ms] = mfma16(af, bw, ga[ms]); } }
#pragma unroll
        for (int ms = 0; ms < 4; ++ms)
#pragma unroll
            for (int r = 0; r < 4; ++r) gred[(w * 64 + 16 * ms + 4 * fq + r) * 16 + fr] = ga[ms][r];
    }
    __syncthreads();
    if (w < 4) {
        const int h = w; const int tok = tok0 + lane; float ip = 0.f, fp = 0.f;
#pragma unroll
        for (int ww = 0; ww < 8; ++ww) { ip += gred[(ww * 64 + lane) * 16 + h]; fp += gred[(ww * 64 + lane) * 16 + 4 + h]; }
        const float ig = ip + b_i[h]; const float lf = log_sigmoid_(fp + b_f[h]);
        float cum = lf;
#pragma unroll
        for (int o = 1; o < 64; o <<= 1) { const float t = __shfl_up(cum, o); if (lane >= o) cum += t; }
        const float g = __shfl(cum, 63); const float a = g - cum + ig;
        float mx = a;
#pragma unroll
        for (int o = 32; o > 0; o >>= 1) mx = fmaxf(mx, __shfl_xor(mx, o));
        wsS[h * 64 + lane] = __expf(a - mx);
        igG[(size_t)tok * 4 + h] = ig; bcumG[(size_t)tok * 4 + h] = cum;
        if (lane == 0) { gG[(b * H_ + h) * 32 + cc] = g; mlG[(b * H_ + h) * 32 + cc] = mx; }
    }
    for (int rd = 0; rd < 2; ++rd) {
        for (int it = tid; it < 2048; it += NT_) { const int hq = it >> 10, sr = (it >> 4) & 63, cg = it & 15; const int t = cc * 64 + sr; const int ch0 = (2 * rd + hq) * DH_ + cg * 8;
            float a[8];
#pragma unroll
            for (int e = 0; e < 8; ++e) a[e] = cb[ch0 + e];
#pragma unroll
            for (int j = 0; j < 4; ++j) { if (t - 3 + j >= 0) { const u32x4 uv = *(const u32x4*)(zb + (size_t)(tok0 + sr - 3 + j) * ZLD_ + ch0);
                    const float* wj = cw + j * DM_ + ch0;
                    a[0] += wj[0] * bflo(uv.x); a[1] += wj[1] * bfhi(uv.x); a[2] += wj[2] * bflo(uv.y); a[3] += wj[3] * bfhi(uv.y);
                    a[4] += wj[4] * bflo(uv.z); a[5] += wj[5] * bfhi(uv.z); a[6] += wj[6] * bflo(uv.w); a[7] += wj[7] * bfhi(uv.w); } }
            u32x4 o; o.x = cvt_pk_bf16(fast_silu(a[0]), fast_silu(a[1])); o.y = cvt_pk_bf16(fast_silu(a[2]), fast_silu(a[3])); o.z = cvt_pk_bf16(fast_silu(a[4]), fast_silu(a[5])); o.w = cvt_pk_bf16(fast_silu(a[6]), fast_silu(a[7]));
            *(LAS u32x4*)(ctile + hq * 16384 + off_b(sr, cg)) = o;
            *(LAS u32x4*)(vtile + hq * 16384 + off_b(sr, cg)) = *(const u32x4*)(zb + (size_t)(tok0 + sr) * ZLD_ + 512 + ch0);
        }
        __syncthreads();
        const int h = 2 * rd + hh;
        const LAS unsigned char* ct = ctile + hh * 16384; LAS unsigned char* kt = ktile + hh * 16384; const LAS unsigned char* vt = vtile + hh * 16384;
        {
            f32x4 acc[4][4];
#pragma unroll
            for (int ms = 0; ms < 4; ++ms)
#pragma unroll
                for (int i = 0; i < 4; ++i) acc[ms][i] = (f32x4){0.f, 0.f, 0.f, 0.f};
#pragma unroll
            for (int ks = 0; ks < 4; ++ks) {
                bf16x8 wf[4];
#pragma unroll
                for (int i = 0; i < 4; ++i) wf[i] = ld_frag_g(wqkT + ((size_t)(h * 256 + 16 * (4 * wq + i) + fr)) * DH_ + 32 * ks + 8 * fq);
#pragma unroll
                for (int ms = 0; ms < 4; ++ms) { const bf16x8 cf = tile_row_read(ct, lane, ms, ks);
#pragma unroll
                    for (int i = 0; i < 4; ++i) acc[ms][i] = mfma16(wf[i], cf, acc[ms][i]); }
            }
#pragma unroll
            for (int ms = 0; ms < 4; ++ms) { const int sr = 16 * ms + fr; const float wsv = wsS[h * 64 + sr];
#pragma unroll
                for (int i = 0; i < 4; ++i) { const int nf = 4 * wq + i; const f32x4 v = acc[ms][i];
                    u32x2 o; o.x = cvt_pk_bf16(v[0], v[1]); o.y = cvt_pk_bf16(v[2], v[3]);
                    if (nf < 8) *(u32x2*)(qb + (size_t)(tok0 + sr) * DM_ + h * DH_ + 16 * nf + 4 * fq) = o;
                    else { const int col = 16 * (nf - 8) + 4 * fq; *(u32x2*)(kb + (size_t)(tok0 + sr) * DM_ + h * DH_ + col) = o;
                        u32x2 o2; o2.x = cvt_pk_bf16(v[0] * wsv, v[1] * wsv); o2.y = cvt_pk_bf16(v[2] * wsv, v[3] * wsv);
                        *(LAS u32x2*)(kt + off_b(sr, col >> 3) + 2 * (col & 7)) = o2; } } }
        }
        __syncthreads();
        {
            f32x4 acc[2][8];
#pragma unroll
            for (int i = 0; i < 2; ++i)
#pragma unroll
                for (int nd = 0; nd < 8; ++nd) acc[i][nd] = (f32x4){0.f, 0.f, 0.f, 0.f};
#pragma unroll
            for (int ks = 0; ks < 2; ++ks) {
                s16x4 va[2][2], kbq[8][2];
                tile_tr_read4(tr_addr(vt, lane, 32 * ks + 8 * fq, 2 * wq), tr_addr(vt, lane, 32 * ks + 8 * fq + 4, 2 * wq), tr_addr(vt, lane, 32 * ks + 8 * fq, 2 * wq + 1), tr_addr(vt, lane, 32 * ks + 8 * fq + 4, 2 * wq + 1),
                              va[0][0], va[0][1], va[1][0], va[1][1]);
#pragma unroll
                for (int nd = 0; nd < 8; nd += 2)
                    tile_tr_read4(tr_addr(kt, lane, 32 * ks + 8 * fq, nd), tr_addr(kt, lane, 32 * ks + 8 * fq + 4, nd), tr_addr(kt, lane, 32 * ks + 8 * fq, nd + 1), tr_addr(kt, lane, 32 * ks + 8 * fq + 4, nd + 1),
                                  kbq[nd][0], kbq[nd][1], kbq[nd + 1][0], kbq[nd + 1][1]);
#pragma unroll
                for (int nd = 0; nd < 8; ++nd) { const bf16x8 kf = cat8(kbq[nd][0], kbq[nd][1]);
#pragma unroll
                    for (int i = 0; i < 2; ++i) acc[i][nd] = mfma16(kf, cat8(va[i][0], va[i][1]), acc[i][nd]); }
            }
            bf16_t* Cp = Csum + ((size_t)((b * H_ + h) * 32 + cc)) * DH_ * DH_;
#pragma unroll
            for (int i = 0; i < 2; ++i)
#pragma unroll
                for (int nd = 0; nd < 8; ++nd) { u32x2 o; o.x = cvt_pk_bf16(acc[i][nd][0], acc[i][nd][1]); o.y = cvt_pk_bf16(acc[i][nd][2], acc[i][nd][3]); *(u32x2*)(Cp + (size_t)(16 * (2 * wq + i) + fr) * DH_ + 16 * nd + 4 * fq) = o; }
            if ((tid & 255) < DH_) { float sacc = 0.f; const int d = tid & 255;
                for (int sr = 0; sr < 64; ++sr) sacc += bf2f(*(const LAS bf16_t*)(kt + off_b(sr, d >> 3) + 2 * (d & 7)));
                nsum[((size_t)((b * H_ + h) * 32 + cc)) * DH_ + d] = sacc; }
        }
        __syncthreads();
    }
}
DI void ph_mix1(PR p, const Ctx& c, int l, LAS unsigned char* lds) {
    for (int unit = c.bid; unit < NB_ * (S_ / 64); unit += c.G) mlstm_sum_unit(p, c, l, unit, lds);
    __syncthreads();
    GroupOrder S; S.A = (const char*)WSP<bf16_t>(p, WS_AS5); S.B = (const char*)(WSP<bf16_t>(p, WS_WET) + (size_t)l * G5_ * 256 * 256); S.astride = (size_t)S5R_ * S5K_ * 2; S.bstride = (size_t)256 * 256 * 2;
    S.lda = S5K_ * 2; S.nunits = G5_ * 4; S.G = c.G; S.c = (c.bid + c.G / 2) % c.G;
    EpiS5E E{WSP<float>(p, WS_ESUM)};
    gemm_phase<EpiS5E, GroupOrder>(lds, Gemm{(unsigned)(S5K_ * 2), 512u, 256}, S, E);
}

DI void ph_scan(PR p, const Ctx& c, int l, LAS unsigned char* lds) {
    const bf16_t* Csum = WSP<bf16_t>(p, WS_CSUM); const float* nsum = WSP<float>(p, WS_NSUM); const float* gG = WSP<float>(p, WS_GG); const float* mlG = WSP<float>(p, WS_MLG);
    bf16_t* CprevT = WSP<bf16_t>(p, WS_CPREV); float* nprev = WSP<float>(p, WS_NPREV); float* mprev = WSP<float>(p, WS_MPREV);
    const float* Esum = WSP<float>(p, WS_ESUM); const float* A16 = WSP<float>(p, WS_A16) + (size_t)l * G5_ * 128; bf16_t* AS5 = WSP<bf16_t>(p, WS_AS5);
    constexpr int NC1 = NB_ * H_ * DH_ * (DH_ / 4), NC2 = NC1 + NB_ * H_ * DH_, NC3 = NC2 + NB_ * G5_ * P5_;
    if (c.w < 4) for (int gid = c.bid * 256 + c.tid; gid < NC3; gid += c.G * 256) {
        if (gid < NC1) {
            const int bh = gid / (DH_ * DH_ / 4), r = gid % (DH_ * DH_ / 4);
            f32x4 C = (f32x4){0.f, 0.f, 0.f, 0.f}; float m = 0.f;
            const size_t base0 = ((size_t)bh * 32) * DH_ * DH_ + (size_t)r * 4;
#pragma unroll 1
            for (int c8 = 0; c8 < 32; c8 += 8) {
                f32x4 cv[8]; float gv[8], mv[8];
#pragma unroll
                for (int k = 0; k < 8; ++k) { const u32x2 cq = *(const u32x2*)(Csum + base0 + (size_t)(c8 + k) * DH_ * DH_); cv[k] = (f32x4){bflo(cq.x), bfhi(cq.x), bflo(cq.y), bfhi(cq.y)}; gv[k] = gG[bh * 32 + c8 + k]; mv[k] = mlG[bh * 32 + c8 + k]; }
#pragma unroll
                for (int k = 0; k < 8; ++k) {
                    u32x2 o; o.x = cvt_pk_bf16(C[0], C[1]); o.y = cvt_pk_bf16(C[2], C[3]); *(u32x2*)(CprevT + base0 + (size_t)(c8 + k) * DH_ * DH_) = o;
                    if (r == 0) mprev[bh * 32 + c8 + k] = m;
                    const float mn = fmaxf(gv[k] + m, mv[k]), so = __expf(gv[k] + m - mn), sn = __expf(mv[k] - mn);
                    C = C * so + cv[k] * sn; m = mn;
                }
            }
        } else if (gid < NC2) {
            const int i = gid - NC1; const int bh = i / DH_, d = i % DH_;
            float n = 0.f, m = 0.f;
#pragma unroll 1
            for (int c8 = 0; c8 < 32; c8 += 8) {
                float nv[8], gv[8], mv[8];
#pragma unroll
                for (int k = 0; k < 8; ++k) { nv[k] = nsum[(size_t)(bh * 32 + c8 + k) * DH_ + d]; gv[k] = gG[bh * 32 + c8 + k]; mv[k] = mlG[bh * 32 + c8 + k]; }
#pragma unroll
                for (int k = 0; k < 8; ++k) {
                    nprev[(size_t)(bh * 32 + c8 + k) * DH_ + d] = n;
                    const float mn = fmaxf(gv[k] + m, mv[k]), so = __expf(gv[k] + m - mn), sn = __expf(mv[k] - mn);
                    n = so * n + sn * nv[k]; m = mn;
                }
            }
        } else {
            const int i = gid - NC2; const int pp = i & 63, g = (i >> 6) & 31, b = i >> 11;
            const float ar = A16[(size_t)g * 128 + pp], ai = A16[(size_t)g * 128 + 64 + pp];
            float xr = 0.f, xi = 0.f;
            const size_t row0 = (size_t)g * S5R_ + b * (S_ / 16);
#pragma unroll 1
            for (int c16 = 0; c16 < S_ / 16; c16 += 16) {
                float er[16], ei[16];
#pragma unroll
                for (int k = 0; k < 16; ++k) { er[k] = Esum[(row0 + c16 + k) * 128 + pp]; ei[k] = Esum[(row0 + c16 + k) * 128 + 64 + pp]; }
#pragma unroll
                for (int k = 0; k < 16; ++k) { const size_t row = row0 + c16 + k;
                    AS5[row * S5K_ + 256 + pp] = f2bf(xr); AS5[row * S5K_ + 320 + pp] = f2bf(xi);
                    const float nr = ar * xr - ai * xi + er[k], ni = ar * xi + ai * xr + ei[k]; xr = nr; xi = ni; }
            }
        }
    }
    else { moe_weight_jobs(p, c, l, lds); if (MK_REP == 97) moe_weight_jobs(p, c, (l + 2) & 3, lds, true); }
    if (MK_REP == 98) { const size_t gt = (size_t)c.bid * NT_ + c.tid, nth = (size_t)c.G * NT_; bf16_t* dmy = WSP<bf16_t>(p, WS_HB);
        cvt_rows(IN(p, 28) + (size_t)l * NE_ * D_ * DE_, dmy, (size_t)NE_ * D_ * DE_ / 8, gt, nth); cvt_rows(IN(p, 29) + (size_t)l * NE_ * D_ * DE_, dmy + (size_t)NE_ * D_ * DE_, (size_t)NE_ * D_ * DE_ / 8, gt, nth);
        cvt_rows(IN(p, 30) + (size_t)l * NE_ * DE_ * D_, dmy + (size_t)2 * NE_ * D_ * DE_, (size_t)NE_ * DE_ * D_ / 8, gt, nth); }
}

DI void mlstm_out_unit(PR p, const Ctx& c, int l, int unit, LAS unsigned char* lds) {
    LAS unsigned char* vt0 = lds;
    LAS unsigned char* kt0 = lds + 32768;
    LAS unsigned char* ct0 = lds + 65536;
    LAS float* RT = (LAS float*)(lds + 131072);
    LAS float* CT = RT + 128;
    LAS float* INr = CT + 128;
    LAS float* EM = INr + 128;
    LAS float* NP = EM + 128;
    const bf16_t* zb = WSP<bf16_t>(p, WS_ZB); const bf16_t* qb = WSP<bf16_t>(p, WS_QB); const bf16_t* kb = WSP<bf16_t>(p, WS_KB); const bf16_t* CprevT = WSP<bf16_t>(p, WS_CPREV);
    const float* nprev = WSP<float>(p, WS_NPREV); const float* mprev = WSP<float>(p, WS_MPREV); const float* igG = WSP<float>(p, WS_IGG); const float* bcumG = WSP<float>(p, WS_BCUM);
    const float* mh_g = IN(p, 9) + (size_t)l * DM_; bf16_t* yb = WSP<bf16_t>(p, WS_YB);
    const int tid = c.tid, lane = c.lane, w = c.w, fr = lane & 15, fq = lane >> 4, hh = w >> 2, nt = w & 3;
    const int b = unit / (S_ / 64), cc = unit % (S_ / 64); const int tok0 = b * S_ + cc * 64;
    for (int rd = 0; rd < 2; ++rd) {
        __syncthreads();
        for (int it = tid; it < 2048; it += NT_) { const int hq = it >> 10, sr = (it >> 4) & 63, cg = it & 15; const int h = 2 * rd + hq;
            *(LAS u32x4*)(vt0 + hq * 16384 + off_b(sr, cg)) = *(const u32x4*)(zb + (size_t)(tok0 + sr) * ZLD_ + 512 + h * DH_ + cg * 8);
            *(LAS u32x4*)(kt0 + hq * 16384 + off_b(sr, cg)) = *(const u32x4*)(kb + (size_t)(tok0 + sr) * DM_ + h * DH_ + cg * 8); }
        for (int it = tid; it < 4096; it += NT_) { const int hq = it >> 11, er = (it >> 4) & 127, cg = it & 15; const int bh = b * H_ + 2 * rd + hq;
            *(LAS u32x4*)(ct0 + hq * 32768 + off_b(er, cg)) = *(const u32x4*)(CprevT + ((size_t)(bh * 32 + cc) * DH_ + er) * DH_ + cg * 8); }
        if (w < 2) { const int h = 2 * rd + w; const int tok = tok0 + lane; const int bh = b * H_ + h;
            const float ig = igG[(size_t)tok * 4 + h], bc = bcumG[(size_t)tok * 4 + h]; const float rt = ig - bc;
            float pm = rt;
#pragma unroll
            for (int o = 1; o < 64; o <<= 1) { const float t = __shfl_up(pm, o); if (lane >= o) pm = fmaxf(pm, t); }
            const float mp = mprev[bh * 32 + cc]; const float li = bc + mp; const float mt = fmaxf(li, bc + pm);
            RT[w * 64 + lane] = rt; CT[w * 64 + lane] = bc - mt; INr[w * 64 + lane] = __expf(li - mt); EM[w * 64 + lane] = __expf(-mt);
            NP[w * 128 + lane] = nprev[(size_t)(bh * 32 + cc) * DH_ + lane]; NP[w * 128 + 64 + lane] = nprev[(size_t)(bh * 32 + cc) * DH_ + 64 + lane];
        }
        __syncthreads();
        {
            const int h = 2 * rd + hh; const LAS unsigned char* vt = vt0 + hh * 16384; const LAS unsigned char* kt = kt0 + hh * 16384; const LAS unsigned char* ct = ct0 + hh * 32768;
            const int trow = 16 * nt + fr;
            bf16x8 qf[4];
#pragma unroll
            for (int ks = 0; ks < 4; ++ks) qf[ks] = ld_frag_g(qb + (size_t)(tok0 + trow) * DM_ + h * DH_ + 32 * ks + 8 * fq);
            f32x4 Sf[4];
#pragma unroll
            for (int ms = 0; ms < 4; ++ms) { Sf[ms] = (f32x4){0.f, 0.f, 0.f, 0.f};
                if (ms <= nt) {
#pragma unroll
                    for (int ks = 0; ks < 4; ++ks) Sf[ms] = mfma16(tile_row_read(kt, lane, ms, ks), qf[ks], Sf[ms]);
                } }
            const float ct_ = CT[hh * 64 + trow];
            float dsum = 0.f;
#pragma unroll
            for (int ms = 0; ms < 4; ++ms)
#pragma unroll
                for (int r = 0; r < 4; ++r) { const int sr = 16 * ms + 4 * fq + r; float v = 0.f;
                    if (ms <= nt && sr <= trow) v = Sf[ms][r] * __expf(RT[hh * 64 + sr] + ct_);
                    Sf[ms][r] = v; dsum += v; }
            dsum += __shfl_xor(dsum, 16); dsum += __shfl_xor(dsum, 32);
            float qn = 0.f;
#pragma unroll
            for (int ks = 0; ks < 4; ++ks)
#pragma unroll
                for (int j = 0; j < 8; ++j) qn += bf2f((bf16_t)qf[ks][j]) * NP[hh * 128 + 32 * ks + 8 * fq + j];
            qn += __shfl_xor(qn, 16); qn += __shfl_xor(qn, 32);
            const float inter = INr[hh * 64 + trow];
            float den = dsum + inter * qn; den = fmaxf(fabsf(den), EM[hh * 64 + trow]); const float rden = __builtin_amdgcn_rcpf(den);
            bf16x8 Pf[2];
#pragma unroll
            for (int k2 = 0; k2 < 2; ++k2) { u32x4 pk; pk.x = cvt_pk_bf16(Sf[2 * k2][0], Sf[2 * k2][1]); pk.y = cvt_pk_bf16(Sf[2 * k2][2], Sf[2 * k2][3]);
                pk.z = cvt_pk_bf16(Sf[2 * k2 + 1][0], Sf[2 * k2 + 1][1]); pk.w = cvt_pk_bf16(Sf[2 * k2 + 1][2], Sf[2 * k2 + 1][3]); Pf[k2] = __builtin_bit_cast(bf16x8, pk); }
            float hv[8][4]; float ssum = 0.f;
#pragma unroll
            for (int me = 0; me < 8; ++me) {
                f32x4 a1 = (f32x4){0.f, 0.f, 0.f, 0.f}, a2 = (f32x4){0.f, 0.f, 0.f, 0.f};
                s16x4 v0, v1, v2, v3;
                tile_tr_read4(tr_addr(vt, lane, 4 * fq, me), tr_addr(vt, lane, 16 + 4 * fq, me), tr_addr(vt, lane, 32 + 4 * fq, me), tr_addr(vt, lane, 48 + 4 * fq, me), v0, v1, v2, v3);
#pragma unroll
                for (int ks = 0; ks < 4; ++ks) a2 = mfma16(tile_row_read(ct, lane, me, ks), qf[ks], a2);
                a1 = mfma16(cat8(v0, v1), Pf[0], a1);
                if (nt >= 2) a1 = mfma16(cat8(v2, v3), Pf[1], a1);
                const u32x2 og = *(const u32x2*)(zb + (size_t)(tok0 + trow) * ZLD_ + 1024 + h * DH_ + 16 * me + 4 * fq);
                hv[me][0] = (a1[0] + inter * a2[0]) * rden * fast_sigmoid(bflo(og.x)); hv[me][1] = (a1[1] + inter * a2[1]) * rden * fast_sigmoid(bfhi(og.x));
                hv[me][2] = (a1[2] + inter * a2[2]) * rden * fast_sigmoid(bflo(og.y)); hv[me][3] = (a1[3] + inter * a2[3]) * rden * fast_sigmoid(bfhi(og.y));
                ssum += (hv[me][0] + hv[me][1]) + (hv[me][2] + hv[me][3]);
            }
            ssum += __shfl_xor(ssum, 16); ssum += __shfl_xor(ssum, 32);
            const float mu = ssum * (1.f / DH_); float qv = 0.f;
#pragma unroll
            for (int me = 0; me < 8; ++me)
#pragma unroll
                for (int r = 0; r < 4; ++r) { const float d0 = hv[me][r] - mu; qv += d0 * d0; }
            qv += __shfl_xor(qv, 16); qv += __shfl_xor(qv, 32);
            const float rstd = rsqrtf(qv * (1.f / DH_) + EPS_);
#pragma unroll
            for (int me = 0; me < 8; ++me) { const int e0 = h * DH_ + 16 * me + 4 * fq; const f32x4 gg = *(const f32x4*)(mh_g + e0);
                u32x2 o; o.x = cvt_pk_bf16((hv[me][0] - mu) * rstd * gg[0], (hv[me][1] - mu) * rstd * gg[1]); o.y = cvt_pk_bf16((hv[me][2] - mu) * rstd * gg[2], (hv[me][3] - mu) * rstd * gg[3]);
                *(u32x2*)(yb + (size_t)(tok0 + trow) * D_ + DM_ + e0) = o; }
        }
    }
}
DI void ph_mix2(PR p, const Ctx& c, int l, LAS unsigned char* lds) {
    for (int unit = c.bid; unit < NB_ * (S_ / 64); unit += c.G) mlstm_out_unit(p, c, l, unit, lds);
    __syncthreads();
    GroupOrder S; S.A = (const char*)WSP<bf16_t>(p, WS_AS5); S.B = (const char*)(WSP<bf16_t>(p, WS_WYT) + (size_t)l * G5_ * 256 * S5K_); S.astride = (size_t)S5R_ * S5K_ * 2; S.bstride = (size_t)256 * S5K_ * 2;
    S.lda = S5K_ * 2; S.nunits = G5_ * 4; S.G = c.G; S.c = (c.bid + c.G / 2) % c.G;
    EpiS5Y E{WSP<bf16_t>(p, WS_GYB)};
    gemm_phase<EpiS5Y, GroupOrder>(lds, Gemm{(unsigned)(S5K_ * 2), (unsigned)(S5K_ * 2), S5K_}, S, E);
}

DI void ph_glu(PR p, const Ctx& c, int l, LAS unsigned char* lds) {
    const int hg = c.G / 2;
    if (c.bid < hg) {
        DenseOrder S; S.init(WSP<bf16_t>(p, WS_GYB), WSP<bf16_t>(p, WS_WGLU) + (size_t)l * DM_ * DM_, DM_ * 2, DM_ * 2, M_, DM_, hg, c.bid);
        EpiGlu E{WSP<bf16_t>(p, WS_GYB), IN(p, 19) + (size_t)l * DM_, WSP<bf16_t>(p, WS_YB), WSP<float>(p, WS_SSQS)};
        gemm_phase<EpiGlu, DenseOrder>(lds, Gemm{(unsigned)(DM_ * 2), (unsigned)(DM_ * 2), DM_}, S, E);
    } else {
        DenseOrder S2; S2.init(WSP<bf16_t>(p, WS_PBF) + (size_t)l * M_ * PLE_, WSP<bf16_t>(p, WS_WPP) + (size_t)l * D_ * PLE_, PLE_ * 2, PLE_ * 2, M_, D_, c.G - hg, c.bid - hg);
        EpiT E2{WSP<bf16_t>(p, WS_TB), WSP<float>(p, WS_SSQT)};
        gemm_phase<EpiT, DenseOrder>(lds, Gemm{(unsigned)(PLE_ * 2), (unsigned)(PLE_ * 2), PLE_}, S2, E2);
    }
}
DI void ph_outproj(PR p, const Ctx& c, int l, LAS unsigned char* lds) {
    DenseOrder S; S.init(WSP<bf16_t>(p, WS_YB), WSP<bf16_t>(p, WS_WOUT) + (size_t)l * D_ * D_, D_ * 2, D_ * 2, M_, D_, c.G, c.bid);
    EpiOutLn E{WSP<bf16_t>(p, WS_XB), WSP<float>(p, WS_SSQS), WSP<bf16_t>(p, WS_GHL) + (size_t)l * 2 * 48 * D_, WSP<float>(p, WS_RTC) + l * 80, IN(p, 22) + (size_t)l * D_, IN(p, 23) + (size_t)l * D_,
               WSP<float>(p, WS_XCH), WSP<unsigned>(p, WS_LNC) + (size_t)l * 64 * 16, WSP<bf16_t>(p, WS_X1B), WSP<unsigned char>(p, WS_X1Q),
               WSP<unsigned>(p, WS_CUR) + (size_t)l * NE_ * 16, WSP<int>(p, WS_BUFT), WSP<float>(p, WS_BUFW), WSP<int>(p, WS_SLOT)};
    gemm_phase<EpiOutLn, DenseOrder>(lds, Gemm{(unsigned)(D_ * 2), (unsigned)(D_ * 2), D_}, S, E);
}
DI void ph_route(PR p, const Ctx& c, int l, LAS unsigned char* lds, bool dry = false) {
    LAS int* cntL = (LAS int*)lds; LAS int* baseL = cntL + 32; LAS int* tokE = baseL + 32; LAS float* tokW = (LAS float*)(tokE + 128);
    const float* logits = WSP<float>(p, WS_LOGIT);
    unsigned* cur = WSP<unsigned>(p, WS_CUR) + (size_t)(l + (dry ? L_ : 0)) * NE_ * 16; int* buf_t = WSP<int>(p, WS_BUFT); float* buf_w = WSP<float>(p, WS_BUFW); int* slot_of = WSP<int>(p, WS_SLOT);
    const int tid = c.tid;
    __syncthreads();
    if (tid < 32) cntL[tid] = 0;
    __syncthreads();
    for (int unit = c.bid; unit < M_ / 64; unit += c.G) {
        if (tid < 64) { const float* lg = logits + (size_t)(unit * 64 + tid) * 40;
            const f32x4 gl = *(const f32x4*)lg; float mx = gl[0]; int gi = 0;
#pragma unroll
            for (int i = 1; i < 4; ++i) if (gl[i] > mx) { mx = gl[i]; gi = i; }
            float se = 0.f;
#pragma unroll
            for (int i = 0; i < 4; ++i) se += expf(gl[i] - mx);
            const float pg = 1.0f / se;
            const f32x4 e0 = *(const f32x4*)(lg + 4 + gi * 8), e1 = *(const f32x4*)(lg + 8 + gi * 8);
            float ev[8];
#pragma unroll
            for (int i = 0; i < 4; ++i) { ev[i] = e0[i]; ev[4 + i] = e1[i]; }
            int i0 = 0;
#pragma unroll
            for (int i = 1; i < 8; ++i) if (ev[i] > ev[i0]) i0 = i;
            int i1 = (i0 == 0) ? 1 : 0;
#pragma unroll
            for (int i = 0; i < 8; ++i) if (i != i0 && ev[i] > ev[i1]) i1 = i;
            const float e1x = expf(ev[i1] - ev[i0]); const float w0 = 1.f / (1.f + e1x), w1 = e1x / (1.f + e1x);
            const int ea = gi * 8 + i0, eb = gi * 8 + i1;
            const int ra = atomicAdd((int*)&cntL[ea], 1), rb = atomicAdd((int*)&cntL[eb], 1);
            tokE[tid * 2] = (ea << 16) | ra; tokE[tid * 2 + 1] = (eb << 16) | rb; tokW[tid * 2] = pg * w0; tokW[tid * 2 + 1] = pg * w1;
        }
        __syncthreads();
        if (tid < 32) baseL[tid] = cntL[tid] ? (int)atomicAdd(&cur[tid * 16], (unsigned)cntL[tid]) : 0;
        __syncthreads();
        if (tid < 128 && !dry) { const int v = tokE[tid]; const int e = v >> 16, r = baseL[e] + (v & 0xffff); const int token = unit * 64 + (tid >> 1);
            buf_t[(size_t)e * ECAP_ + r] = token; buf_w[(size_t)e * ECAP_ + r] = tokW[tid]; slot_of[token * 2 + (tid & 1)] = (e << 16) | r; }
        __syncthreads();
        if (tid < 32) cntL[tid] = 0;
        __syncthreads();
    }
}

DI void treduce16(float (&a)[16], int lane) {
#pragma unroll
    for (int i = 0; i < 8; ++i) { const bool hi = lane & 32; const float send = hi ? a[i] : a[i + 8], keep = hi ? a[i + 8] : a[i]; a[i] = keep + __shfl_xor(send, 32); }
#pragma unroll
    for (int i = 0; i < 4; ++i) { const bool hi = lane & 16; const float send = hi ? a[i] : a[i + 4], keep = hi ? a[i + 4] : a[i]; a[i] = keep + __shfl_xor(send, 16); }
#pragma unroll
    for (int i = 0; i < 2; ++i) { const bool hi = lane & 8; const float send = hi ? a[i] : a[i + 2], keep = hi ? a[i + 2] : a[i]; a[i] = keep + __shfl_xor(send, 8); }
    { const bool hi = lane & 4; const float send = hi ? a[0] : a[1], keep = hi ? a[1] : a[0]; a[0] = keep + __shfl_xor(send, 4); }
    a[0] += __shfl_xor(a[0], 2); a[0] += __shfl_xor(a[0], 1);
}
DI void ph_router(PR p, const Ctx& c, int l, LAS unsigned char* lds, bool dry = false) {
    LAS float* W = (LAS float*)lds;
    LAS float* LG = (LAS float*)(lds + 147456);
    LAS int* cntL = (LAS int*)(lds + 147456 + 9216);
    LAS int* baseL = cntL + 32;
    LAS int* tokE = baseL + 32;
    LAS float* tokW = (LAS float*)(tokE + 128);
    const float* b_grp = IN(p, 25) + l * 4; const float* b_rt = IN(p, 27) + l * 32;
    const float* ln_g = IN(p, 22) + (size_t)l * D_; const float* ln_b = IN(p, 23) + (size_t)l * D_;
    const bf16_t* r1 = WSP<bf16_t>(p, WS_X2B); bf16_t* x1b = WSP<bf16_t>(p, WS_X1B); unsigned char* x1q = WSP<unsigned char>(p, WS_X1Q);
    unsigned* cur = WSP<unsigned>(p, WS_CUR) + (size_t)(l + (dry ? L_ : 0)) * NE_ * 16; int* buf_t = WSP<int>(p, WS_BUFT); float* buf_w = WSP<float>(p, WS_BUFW); int* slot_of = WSP<int>(p, WS_SLOT);
    const int tid = c.tid, lane = c.lane, w = c.w;
    __syncthreads();
    { const f32x4* wsrc = (const f32x4*)(WSP<float>(p, WS_WRT) + (size_t)l * 36 * D_); for (int idx = tid; idx < 36 * D_ / 4; idx += NT_) ((LAS f32x4*)W)[idx] = wsrc[idx]; }
    if (tid < 32) cntL[tid] = 0;
    __syncthreads();
    for (int unit = c.bid; unit < M_ / 64; unit += c.G) {
#pragma unroll 1
        for (int half = 0; half < 2; ++half) {
        const int tokb = unit * 64 + w * 8 + half * 4;
        f32x4 xv[4][4];
#pragma unroll
        for (int tk = 0; tk < 4; ++tk) { const bf16_t* rin = r1 + (size_t)(tokb + tk) * D_; float s = 0.f;
#pragma unroll
            for (int j = 0; j < 4; ++j) { const u32x2 rv = ((const u32x2*)rin)[lane + 64 * j]; xv[tk][j] = (f32x4){bflo(rv.x), bfhi(rv.x), bflo(rv.y), bfhi(rv.y)}; s += (xv[tk][j][0] + xv[tk][j][1]) + (xv[tk][j][2] + xv[tk][j][3]); }
            const float mu = wave_sum(s) * (1.f / D_); float qv = 0.f;
#pragma unroll
            for (int j = 0; j < 4; ++j) { xv[tk][j] = xv[tk][j] - mu; qv += (xv[tk][j][0] * xv[tk][j][0] + xv[tk][j][1] * xv[tk][j][1]) + (xv[tk][j][2] * xv[tk][j][2] + xv[tk][j][3] * xv[tk][j][3]); }
            const float rstd = rsqrtf(wave_sum(qv) * (1.f / D_) + EPS_);
#pragma unroll
            for (int j = 0; j < 4; ++j) { const f32x4 gg = ((const f32x4*)ln_g)[lane + 64 * j], bb = ((const f32x4*)ln_b)[lane + 64 * j];
                xv[tk][j] = xv[tk][j] * rstd * gg + bb;
                u32x2 o; o.x = cvt_pk_bf16(xv[tk][j][0], xv[tk][j][1]); o.y = cvt_pk_bf16(xv[tk][j][2], xv[tk][j][3]); ((u32x2*)(x1b + (size_t)(tokb + tk) * D_))[lane + 64 * j] = o;
                ((unsigned*)(x1q + (size_t)(tokb + tk) * D_))[lane + 64 * j] = pack4_fp8(xv[tk][j][0], xv[tk][j][1], xv[tk][j][2], xv[tk][j][3]); }
        }
        f32x2_ xq[2][4][4];
#pragma unroll
        for (int tp = 0; tp < 2; ++tp)
#pragma unroll
            for (int j = 0; j < 4; ++j)
#pragma unroll
                for (int e = 0; e < 4; ++e) xq[tp][j][e] = (f32x2_){xv[2 * tp][j][e], xv[2 * tp + 1][j][e]};
#pragma unroll 1
        for (int ob = 0; ob < 9; ++ob) {
            f32x2_ a2[2][4];
#pragma unroll
            for (int tp = 0; tp < 2; ++tp)
#pragma unroll
                for (int oo = 0; oo < 4; ++oo) a2[tp][oo] = (f32x2_){0.f, 0.f};
#pragma unroll
            for (int oo = 0; oo < 4; ++oo)
#pragma unroll
                for (int j = 0; j < 4; ++j) { const f32x4 wv = ((const LAS f32x4*)W)[(4 * ob + oo) * 256 + lane + 64 * j];
#pragma unroll
                    for (int e = 0; e < 4; ++e) { const f32x2_ wb = (f32x2_){wv[e], wv[e]};
                        a2[0][oo] = __builtin_elementwise_fma(xq[0][j][e], wb, a2[0][oo]); a2[1][oo] = __builtin_elementwise_fma(xq[1][j][e], wb, a2[1][oo]); } }
            float part[16];
#pragma unroll
            for (int tp = 0; tp < 2; ++tp)
#pragma unroll
                for (int oo = 0; oo < 4; ++oo) { part[(2 * tp) * 4 + oo] = a2[tp][oo][0]; part[(2 * tp + 1) * 4 + oo] = a2[tp][oo][1]; }
            treduce16(part, lane);
            if ((lane & 3) == 0) { const int idx = lane >> 2; LG[(w * 8 + half * 4 + (idx >> 2)) * 36 + 4 * ob + (idx & 3)] = part[0]; }
        }
        }
        __builtin_amdgcn_s_waitcnt(0xC07F); __builtin_amdgcn_wave_barrier();
        if (lane < 8) { const LAS float* lg = LG + (w * 8 + lane) * 36;
            float gl[4]; float mx = -1e30f; int gi = 0;
#pragma unroll
            for (int i = 0; i < 4; ++i) { gl[i] = lg[i] + b_grp[i]; if (gl[i] > mx) { mx = gl[i]; gi = i; } }
            float se = 0.f;
#pragma unroll
            for (int i = 0; i < 4; ++i) se += expf(gl[i] - mx);
            const float pg = 1.0f / se;
            float ev[8];
#pragma unroll
            for (int i = 0; i < 8; ++i) ev[i] = lg[4 + gi * 8 + i] + b_rt[gi * 8 + i];
            int i0 = 0;
#pragma unroll
            for (int i = 1; i < 8; ++i) if (ev[i] > ev[i0]) i0 = i;
            int i1 = (i0 == 0) ? 1 : 0;
#pragma unroll
            for (int i = 0; i < 8; ++i) if (i != i0 && ev[i] > ev[i1]) i1 = i;
            const float e1 = expf(ev[i1] - ev[i0]); const float w0 = 1.f / (1.f + e1), w1 = e1 / (1.f + e1);
            const int ea = gi * 8 + i0, eb = gi * 8 + i1;
            const int ra = atomicAdd((int*)&cntL[ea], 1), rb = atomicAdd((int*)&cntL[eb], 1);
            tokE[(w * 8 + lane) * 2] = (ea << 16) | ra; tokE[(w * 8 + lane) * 2 + 1] = (eb << 16) | rb; tokW[(w * 8 + lane) * 2] = pg * w0; tokW[(w * 8 + lane) * 2 + 1] = pg * w1;
        }
        __syncthreads();
        if (tid < 32) baseL[tid] = cntL[tid] ? (int)atomicAdd(&cur[tid * 16], (unsigned)cntL[tid]) : 0;
        __syncthreads();
        if (tid < 128 && !dry) { const int v = tokE[tid]; const int e = v >> 16, r = baseL[e] + (v & 0xffff); const int token = unit * 64 + (tid >> 1);
            buf_t[(size_t)e * ECAP_ + r] = token; buf_w[(size_t)e * ECAP_ + r] = tokW[tid]; slot_of[token * 2 + (tid & 1)] = (e << 16) | r; }
        __syncthreads();
        if (tid < 32) cntL[tid] = 0;
        __syncthreads();
    }
}

DI void moe_tables(PR p, const Ctx& c, int l, LAS int* cnt, LAS int* tbase) {
    unsigned* cur = WSP<unsigned>(p, WS_CUR) + (size_t)l * NE_ * 16;
    __syncthreads();
    if (c.tid < 32) cnt[c.tid] = (int)xb_ld(&cur[c.tid * 16]);
    __syncthreads();
    if (c.tid == 0) { int run = 0; for (int e = 0; e < 32; ++e) { tbase[e] = run; run += (cnt[e] + 255) >> 8; } tbase[32] = run; }
    __syncthreads();
}
DI void ph_moe(PR p, const Ctx& c, int l, LAS unsigned char* lds, bool dry = false) {
    LAS int* cnt = (LAS int*)(lds + STAGE_BYTES); LAS int* tbase = cnt + 32;
    moe_tables(p, c, l, cnt, tbase);
    unsigned* done = WSP<unsigned>(p, WS_DONE) + (size_t)(l + (dry ? L_ : 0)) * MT_ * 16;
    const int nu = tbase[32] * 4;
    {
        MoeOrder<true> S; S.A = (const char*)WSP<unsigned char>(p, WS_X1Q); S.B = (const char*)WSP<unsigned char>(p, WS_WGU); S.lda = D_; S.ldb = D_; S.bstride = (size_t)D_ * D_;
        S.tbase = tbase; S.cnt = cnt; S.buf_t = WSP<int>(p, WS_BUFT); S.done = done; S.nunits = nu; S.G = c.G; S.c = c.bid; S.n3 = 0; S.nb = 0;
        EpiSiluMul E{WSP<unsigned char>(p, WS_HB), done};
        gemm_phase<EpiSiluMul, MoeOrder<true>>(lds, Gemm{(unsigned)D_, (unsigned)D_, D_ / 2}, S, E);
    }
    __syncthreads();
    {
        MoeOrder<false> S; S.A = (const char*)WSP<unsigned char>(p, WS_HB); S.B = (const char*)WSP<unsigned char>(p, WS_WED); S.lda = DE_; S.ldb = DE_; S.bstride = (size_t)D_ * DE_;
        S.tbase = tbase; S.cnt = cnt; S.buf_t = WSP<int>(p, WS_BUFT); S.done = done; S.nunits = nu; S.G = c.G; S.c = c.bid;
        { const int maxups = (nu + c.G - 1) / c.G; S.n3 = (nu % c.G) ? nu - (maxups - 1) * c.G : c.G; S.nb = (c.G - S.n3) < nu ? (c.G - S.n3) : nu; }
        EpiDown E{WSP<unsigned char>(p, WS_YE), WSP<float>(p, WS_BUFW), cnt};
        gemm_phase<EpiDown, MoeOrder<false>>(lds, Gemm{(unsigned)DE_, (unsigned)DE_, DE_ / 2}, S, E);
    }
}
DI void ph_ln2(PR p, const Ctx& c, int l, LAS unsigned char* lds) {
    LAS int* cnt = (LAS int*)(lds + STAGE_BYTES); LAS int* tbase = cnt + 32;
    moe_tables(p, c, l, cnt, tbase);
    const bf16_t* x1b = WSP<bf16_t>(p, WS_X1B); const unsigned char* ye = WSP<unsigned char>(p, WS_YE); const int* slot_of = WSP<int>(p, WS_SLOT);
    const float* ln_g = IN(p, 31) + (size_t)l * D_; const float* ln_b = IN(p, 32) + (size_t)l * D_; bf16_t* x2b = WSP<bf16_t>(p, WS_X2B);
    const int lane = c.lane;
    const float* ssqT = WSP<float>(p, WS_SSQT); float* rstdT = WSP<float>(p, WS_RSTDT);
    for (int tok = c.bid * 8 + c.w; tok < M_; tok += c.G * 8) {
        { float tq = (lane < 16) ? ssqT[(size_t)tok * 16 + lane] : 0.f; tq += __shfl_xor(tq, 8); tq += __shfl_xor(tq, 4); tq += __shfl_xor(tq, 2); tq += __shfl_xor(tq, 1);
          if (lane == 0) rstdT[tok] = rsqrtf(tq * (1.f / D_) + EPS_); }
        const int s0 = slot_of[tok * 2], s1 = slot_of[tok * 2 + 1];
        const size_t r0 = ((size_t)(tbase[s0 >> 16] + ((s0 & 0xffff) >> 8)) * 256 + (s0 & 255)) * D_, r1 = ((size_t)(tbase[s1 >> 16] + ((s1 & 0xffff) >> 8)) * 256 + (s1 & 255)) * D_;
        f32x4 v[4]; float s = 0.f;
#pragma unroll
        for (int j = 0; j < 4; ++j) { const u32x2 xr = ((const u32x2*)(x1b + (size_t)tok * D_))[lane + 64 * j]; const f32x4 xv = (f32x4){bflo(xr.x), bfhi(xr.x), bflo(xr.y), bfhi(xr.y)};
            const int a = ((const int*)(ye + r0))[lane + 64 * j], bq = ((const int*)(ye + r1))[lane + 64 * j];
            v[j][0] = ALPHA_ * xv[0] + YE_INV * (__builtin_amdgcn_cvt_f32_fp8(a, 0) + __builtin_amdgcn_cvt_f32_fp8(bq, 0)); v[j][1] = ALPHA_ * xv[1] + YE_INV * (__builtin_amdgcn_cvt_f32_fp8(a, 1) + __builtin_amdgcn_cvt_f32_fp8(bq, 1));
            v[j][2] = ALPHA_ * xv[2] + YE_INV * (__builtin_amdgcn_cvt_f32_fp8(a, 2) + __builtin_amdgcn_cvt_f32_fp8(bq, 2)); v[j][3] = ALPHA_ * xv[3] + YE_INV * (__builtin_amdgcn_cvt_f32_fp8(a, 3) + __builtin_amdgcn_cvt_f32_fp8(bq, 3));
            s += (v[j][0] + v[j][1]) + (v[j][2] + v[j][3]); }
        const float mu = wave_sum(s) * (1.f / D_); float qv = 0.f;
#pragma unroll
        for (int j = 0; j < 4; ++j) { v[j] = v[j] - mu; qv += (v[j][0] * v[j][0] + v[j][1] * v[j][1]) + (v[j][2] * v[j][2] + v[j][3] * v[j][3]); }
        const float rstd = rsqrtf(wave_sum(qv) * (1.f / D_) + EPS_);
#pragma unroll
        for (int j = 0; j < 4; ++j) { const f32x4 gg = ((const f32x4*)ln_g)[lane + 64 * j], bb = ((const f32x4*)ln_b)[lane + 64 * j]; const f32x4 o = v[j] * rstd * gg + bb;
            u32x2 ob; ob.x = cvt_pk_bf16(o[0], o[1]); ob.y = cvt_pk_bf16(o[2], o[3]); ((u32x2*)(x2b + (size_t)tok * D_))[lane + 64 * j] = ob; }
    }
}
DI void ph_ple(PR p, const Ctx& c, int l, LAS unsigned char* lds) {
    DenseOrder S; S.init(WSP<bf16_t>(p, WS_X2B), WSP<bf16_t>(p, WS_WPG) + (size_t)l * D_ * D_, D_ * 2, D_ * 2, M_, D_, c.G, c.bid);
    EpiPle E{WSP<bf16_t>(p, WS_X2B), WSP<bf16_t>(p, WS_TB), WSP<float>(p, WS_RSTDT), IN(p, 34) + (size_t)l * D_, IN(p, 36) + (size_t)l * D_, (l == L_ - 1) ? p.out : (float*)nullptr, WSP<bf16_t>(p, WS_XB)};
    gemm_phase<EpiPle, DenseOrder>(lds, Gemm{(unsigned)(D_ * 2), (unsigned)(D_ * 2), D_}, S, E);
}

DI Ctx mk_ctx() { Ctx c; int t = threadIdx.x; asm volatile("" : "+v"(t)); t &= 511; int g = gridDim.x, b = blockIdx.x; asm volatile("" : "+s"(g), "+s"(b)); c.G = g; c.bid = b; c.tid = t; c.lane = t & 63; c.w = __builtin_amdgcn_readfirstlane(t >> 6); return c; }

DI PR getP() { const __attribute__((address_space(4))) P* q = (const __attribute__((address_space(4))) P*)__builtin_amdgcn_kernarg_segment_ptr(); asm volatile("" : "+s"(q)); return *q; }
template <int PH> DI void run_phase(int l, LAS unsigned char* lds0) {
    unsigned la = (unsigned)(size_t)lds0; asm volatile("" : "+s"(la)); LAS unsigned char* lds = (LAS unsigned char*)(size_t)la;
    PR p = getP(); const Ctx c = mk_ctx();
    if constexpr (PH == 0) ph_prologue(p, c, lds);
    if constexpr (PH >= 200 && PH < 216) ph_prologue(p, c, lds, PH - 200);
    if constexpr (PH == 1) ph_inproj(p, c, l, lds);
    if constexpr (PH == 2) ph_mix1(p, c, l, lds);
    if constexpr (PH == 3) ph_scan(p, c, l, lds);
    if constexpr (PH == 4) ph_mix2(p, c, l, lds);
    if constexpr (PH == 5) ph_glu(p, c, l, lds);
    if constexpr (PH == 6) ph_outproj(p, c, l, lds);
    if constexpr (PH == 7) ph_route(p, c, l, lds, false);
    if constexpr (PH == 107) ph_route(p, c, l, lds, true);
    if constexpr (PH == 8) ph_moe(p, c, l, lds, false);
    if constexpr (PH == 108) ph_moe(p, c, l, lds, true);
    if constexpr (PH == 10) ph_ln2(p, c, l, lds);
    if constexpr (PH == 11) ph_ple(p, c, l, lds);
}
DI void grid_bar(LAS unsigned char* lds) {
    PR p = getP();
    XcdBarrier b; b.bar = WSP<unsigned>(p, WS_BAR); b.x = xb_xcc_id(); b.st = (volatile LAS unsigned*)(lds + LDS_BYTES - 16);
    xcd_barrier(b);
}

#if MK_MULTI
template <int PH> __global__ __launch_bounds__(512, 2) void k_phase(P p, int l) {
    extern __shared__ __attribute__((aligned(16))) unsigned char smem[];
    (void)p;
    run_phase<PH>(l, (LAS unsigned char*)smem);
}
#else
__global__ __launch_bounds__(512, 2) void k_fwd(P p) {
    extern __shared__ __attribute__((aligned(16))) unsigned char smem[];
    LAS unsigned char* lds = (LAS unsigned char*)smem;
    volatile LAS unsigned* bst = (volatile LAS unsigned*)(lds + LDS_BYTES - 16);
    if (threadIdx.x < 4) bst[threadIdx.x] = 0u;
    __syncthreads();
    (void)xcd_barrier_post((unsigned*)(p.ws + WS_BAR), bst);
    run_phase<0>(0, lds); grid_bar(lds);
    if (MK_REP == 0) { run_phase<0>(0, lds); grid_bar(lds); }
    if (MK_REP >= 200 && MK_REP < 216) { run_phase<(MK_REP >= 200 && MK_REP < 216) ? MK_REP : 200>(0, lds); grid_bar(lds); }
#define MK_PH(k, l) do { run_phase<k>(l, lds); if (MK_REP == k) { grid_bar(lds); run_phase<(k == 7 ? 107 : k == 8 ? 108 : k)>(l, lds); } } while (0)
#define MK_LAYER(l, lastbar) do { MK_PH(1, l); grid_bar(lds); MK_PH(2, l); grid_bar(lds); MK_PH(3, l); grid_bar(lds); MK_PH(4, l); grid_bar(lds); \
        MK_PH(5, l); grid_bar(lds); MK_PH(6, l); grid_bar(lds); MK_PH(8, l); grid_bar(lds); \
        MK_PH(10, l); grid_bar(lds); MK_PH(11, l); if (lastbar) grid_bar(lds); if (MK_REP == 99) { for (int q_ = 0; q_ < 10; ++q_) grid_bar(lds); } } while (0)
    MK_LAYER(0, true); MK_LAYER(1, true); MK_LAYER(2, true); MK_LAYER(3, false);
#undef MK_LAYER
#undef MK_PH
}
#endif
}

#if MK_MULTI
template <int PH> static void launch_phase(const P& p, int l, int grid, hipStream_t st) {
    static bool attr_set = false;
    if (!attr_set) { (void)hipFuncSetAttribute((const void*)k_phase<PH>, hipFuncAttributeMaxDynamicSharedMemorySize, LDS_BYTES); attr_set = true; }
    hipLaunchKernelGGL(k_phase<PH>, dim3(grid), dim3(NT_), LDS_BYTES, st, p, l);
}
#endif

extern "C" void kernel_launch(void* const* d_in, const int* in_sizes, int n_in, void* d_out, int out_size, void* d_ws, size_t ws_size, hipStream_t stream) {
    (void)in_sizes; (void)n_in; (void)out_size; (void)ws_size;
    static int grid = 0;
    if (grid == 0) { int dev = 0, cus = 0; (void)hipGetDevice(&dev); (void)hipDeviceGetAttribute(&cus, hipDeviceAttributeMultiprocessorCount, dev); grid = cus > 0 ? cus : 256; }
    P p{};
    for (int i = 0; i < 37; ++i) p.in[i] = (const float*)d_in[i];
    p.out = (float*)d_out; p.ws = (unsigned char*)d_ws;
    (void)hipMemsetAsync(d_ws, 0, WS_CTL_END, stream);
#if MK_MULTI
    launch_phase<0>(p, 0, grid, stream);
    for (int l = 0; l < L_; ++l) {
        launch_phase<1>(p, l, grid, stream); launch_phase<2>(p, l, grid, stream); launch_phase<3>(p, l, grid, stream); launch_phase<4>(p, l, grid, stream);
        launch_phase<5>(p, l, grid, stream); launch_phase<6>(p, l, grid, stream); launch_phase<8>(p, l, grid, stream);
        launch_phase<10>(p, l, grid, stream); launch_phase<11>(p, l, grid, stream);
    }
#else
    static bool attr_set = false;
    if (!attr_set) { (void)hipFuncSetAttribute((const void*)k_fwd, hipFuncAttributeMaxDynamicSharedMemorySize, LDS_BYTES); attr_set = true; }
    hipLaunchKernelGGL(k_fwd, dim3(grid), dim3(NT_), LDS_BYTES, stream, p);
#endif
}
```

```cpp
#include <hip/hip_runtime.h>
#include <math.h>
#include <stdint.h>

#ifndef MK_MULTI
#define MK_MULTI 0
#endif

#ifndef MK_REP
#define MK_REP -1
#endif

namespace {
#define LAS __attribute__((address_space(3)))
#define DI __device__ __forceinline__
typedef unsigned short bf16_t;
typedef short bf16x8 __attribute__((ext_vector_type(8)));
typedef short s16x4 __attribute__((ext_vector_type(4)));
typedef float f32x4 __attribute__((ext_vector_type(4)));
typedef unsigned u32x4 __attribute__((ext_vector_type(4)));
typedef unsigned u32x2 __attribute__((ext_vector_type(2)));
typedef int v8i __attribute__((ext_vector_type(8)));
typedef int v4i __attribute__((ext_vector_type(4)));

constexpr int NB_ = 8, S_ = 2048, D_ = 1024, M_ = NB_ * S_, L_ = 4;
constexpr int DM_ = 512, H_ = 4, DH_ = 128, DIN_ = 2056, ZLD_ = 1536;
constexpr int G5_ = 32, P5_ = 64;
constexpr int PLE_ = 256, NE_ = 32, DE_ = 512;
constexpr int MT_ = 160, PS2_ = MT_ * 256, ECAP_ = 32768;
constexpr int S5K_ = 384, S5R_ = M_ / 16;
constexpr float ALPHA_ = 1.681792830507429f, EPS_ = 1e-5f;
constexpr int NT_ = 512;
constexpr int LDS_BYTES = 163840;

constexpr size_t al256(size_t x) { return (x + 255) & ~(size_t)255; }
constexpr int XCD_BAR_WORDS = 3456;
constexpr size_t WS_BAR = 0;
constexpr size_t WS_CUR = al256(WS_BAR + XCD_BAR_WORDS * 4);
constexpr size_t WS_DONE = al256(WS_CUR + (size_t)2 * L_ * NE_ * 64);
constexpr size_t WS_LNC = al256(WS_DONE + (size_t)2 * L_ * MT_ * 64);
constexpr size_t WS_CTL_END = al256(WS_LNC + (size_t)L_ * 64 * 64);
constexpr size_t WS_XB = WS_CTL_END;
constexpr size_t WS_XC = al256(WS_XB + (size_t)M_ * D_ * 2);
constexpr size_t WS_XCH = WS_XC;
constexpr size_t WS_LOGIT = WS_XC + ((size_t)16 << 20);
constexpr size_t WS_GHL = WS_XC + ((size_t)24 << 20);
constexpr size_t WS_RTC = WS_XC + ((size_t)26 << 20);
constexpr size_t WS_ZB = al256(WS_XC + (size_t)M_ * D_ * 4);
constexpr size_t WS_AS5 = al256(WS_ZB + (size_t)M_ * ZLD_ * 2);
constexpr size_t WS_ESUM = al256(WS_AS5 + (size_t)G5_ * S5R_ * S5K_ * 2);
constexpr size_t WS_QB = al256(WS_ESUM + (size_t)G5_ * S5R_ * 128 * 4);
constexpr size_t WS_KB = al256(WS_QB + (size_t)M_ * DM_ * 2);
constexpr size_t WS_CSUM = al256(WS_KB + (size_t)M_ * DM_ * 2);
constexpr size_t WS_CPREV = al256(WS_CSUM + (size_t)1024 * DH_ * DH_ * 4);
constexpr size_t WS_NSUM = al256(WS_CPREV + (size_t)1024 * DH_ * DH_ * 2);
constexpr size_t WS_NPREV = al256(WS_NSUM + (size_t)1024 * DH_ * 4);
constexpr size_t WS_GG = al256(WS_NPREV + (size_t)1024 * DH_ * 4);
constexpr size_t WS_MLG = al256(WS_GG + 4096);
constexpr size_t WS_MPREV = al256(WS_MLG + 4096);
constexpr size_t WS_IGG = al256(WS_MPREV + 4096);
constexpr size_t WS_BCUM = al256(WS_IGG + (size_t)M_ * 16);
constexpr size_t WS_YB = al256(WS_BCUM + (size_t)M_ * 16);
constexpr size_t WS_GYB = al256(WS_YB + (size_t)M_ * D_ * 2);
constexpr size_t WS_SSQS = al256(WS_GYB + (size_t)M_ * DM_ * 2);
constexpr size_t WS_X1 = al256(WS_SSQS + (size_t)M_ * 32);
constexpr size_t WS_X1B = al256(WS_X1 + (size_t)M_ * D_ * 4);
constexpr size_t WS_X1Q = al256(WS_X1B + (size_t)M_ * D_ * 2);
constexpr size_t WS_BUFT = al256(WS_X1Q + (size_t)M_ * D_);
constexpr size_t WS_BUFW = al256(WS_BUFT + (size_t)NE_ * ECAP_ * 4);
constexpr size_t WS_SLOT = al256(WS_BUFW + (size_t)NE_ * ECAP_ * 4);
constexpr size_t WS_HB = al256(WS_SLOT + (size_t)M_ * 8);
constexpr size_t WS_YE = al256(WS_HB + (size_t)PS2_ * DE_ * 2);
constexpr size_t WS_X2 = al256(WS_YE + (size_t)PS2_ * D_ * 2);
constexpr size_t WS_X2B = al256(WS_X2 + (size_t)M_ * D_ * 4);
constexpr size_t WS_TB = al256(WS_X2B + (size_t)M_ * D_ * 2);
constexpr size_t WS_SSQT = al256(WS_TB + (size_t)M_ * D_ * 2);
constexpr size_t WS_RSTDT = al256(WS_SSQT + (size_t)M_ * 64);
constexpr size_t WS_PBF = al256(WS_RSTDT + (size_t)M_ * 4);
constexpr size_t WS_WIN = al256(WS_PBF + (size_t)L_ * M_ * PLE_ * 2);
constexpr size_t WS_WOUT = al256(WS_WIN + (size_t)L_ * 2048 * D_ * 2);
constexpr size_t WS_WPG = al256(WS_WOUT + (size_t)L_ * D_ * D_ * 2);
constexpr size_t WS_WPP = al256(WS_WPG + (size_t)L_ * D_ * D_ * 2);
constexpr size_t WS_WGLU = al256(WS_WPP + (size_t)L_ * D_ * PLE_ * 2);
constexpr size_t WS_WQK = al256(WS_WGLU + (size_t)L_ * DM_ * DM_ * 2);
constexpr size_t WS_WGATE = al256(WS_WQK + (size_t)L_ * H_ * 256 * DH_ * 2);
constexpr size_t WS_WET = al256(WS_WGATE + (size_t)L_ * 16 * D_ * 2);
constexpr size_t WS_WYT = al256(WS_WET + (size_t)L_ * G5_ * 256 * 256 * 2);
constexpr size_t WS_A16 = al256(WS_WYT + (size_t)L_ * G5_ * 256 * S5K_ * 2);
constexpr size_t WS_WGU = al256(WS_A16 + (size_t)L_ * G5_ * 128 * 4);
constexpr size_t WS_WED = al256(WS_WGU + (size_t)NE_ * D_ * D_ * 2);
constexpr size_t WS_WRT = al256(WS_WED + (size_t)NE_ * D_ * DE_ * 2);
constexpr size_t WS_END = al256(WS_WRT + (size_t)L_ * 36 * D_ * 4);
static_assert(WS_END <= (size_t)1073741824, "workspace over 1 GiB");

struct P { const float* in[37]; float* out; unsigned char* ws; };
typedef const __attribute__((address_space(4))) P& PR;

typedef float f32x2_ __attribute__((ext_vector_type(2)));
typedef __bf16 bf16x2_ __attribute__((ext_vector_type(2)));
DI unsigned cvt_pk_bf16(float lo, float hi) { const f32x2_ v = {lo, hi}; return __builtin_bit_cast(unsigned, __builtin_convertvector(v, bf16x2_)); }
DI float bf2f(bf16_t v) { return __uint_as_float(((unsigned)v) << 16); }
DI float bflo(unsigned v) { return __uint_as_float(v << 16); }
DI float bfhi(unsigned v) { return __uint_as_float(v & 0xffff0000u); }
DI unsigned pack4_fp8(float a, float b, float c, float d) { int w = 0; w = __builtin_amdgcn_cvt_pk_fp8_f32(a, b, w, false); w = __builtin_amdgcn_cvt_pk_fp8_f32(c, d, w, true); return (unsigned)w; }
constexpr float W8_SCALE = 64.0f, W8_INV = 1.0f / 64.0f, YE_SCALE = 32.0f, YE_INV = 1.0f / 32.0f;
DI bf16_t f2bf(float f) { unsigned u = __float_as_uint(f); u += 0x7fffu + ((u >> 16) & 1u); return (bf16_t)(u >> 16); }
DI float wave_sum(float v) {
#pragma unroll
    for (int o = 32; o > 0; o >>= 1) v += __shfl_xor(v, o);
    return v;
}
DI float sigmoidf_(float x) { return 1.0f / (1.0f + expf(-x)); }
DI float siluf_(float x) { return x * sigmoidf_(x); }
DI float fast_sigmoid(float x) { return __builtin_amdgcn_rcpf(1.0f + __builtin_amdgcn_exp2f(-1.4426950408889634f * x)); }
DI float fast_silu(float x) { return x * fast_sigmoid(x); }
DI float fast_gelu_tanh(float x) { const float z2 = 1.5957691216057308f * (x + 0.044715f * x * x * x); return x * fast_sigmoid(z2); }
DI float log_sigmoid_(float x) { return (x >= 0.f) ? -log1pf(expf(-x)) : (x - log1pf(expf(x))); }
DI f32x4 mfma16(bf16x8 a, bf16x8 b, f32x4 c) { return __builtin_amdgcn_mfma_f32_16x16x32_bf16(a, b, c, 0, 0, 0); }
DI bf16x8 ld_frag_g(const bf16_t* p) { return *(const bf16x8*)p; }
DI bf16x8 cat8(s16x4 lo, s16x4 hi) { return __builtin_shufflevector(lo, hi, 0, 1, 2, 3, 4, 5, 6, 7); }
DI unsigned off_b(unsigned row, unsigned ch) { return 256u * row + 16u * (ch ^ (((row & 3u) << 2) | ((row >> 2) & 3u))); }
DI bf16x8 tile_row_read(const LAS unsigned char* tile, int lane, int rb, int s) {
    return *(const LAS bf16x8*)(tile + off_b((unsigned)((lane & 15) + 16 * rb), (unsigned)(4 * s + (lane >> 4))));
}
DI s16x4 tile_tr_read(const LAS unsigned char* tile, int lane, int row0, int c) {
    const unsigned q = (unsigned)(lane & 15) >> 2, p = (unsigned)lane & 3u;
    const unsigned addr = (unsigned)(size_t)tile + off_b((unsigned)row0 + q, (unsigned)(2 * c) + (p >> 1)) + 8u * (p & 1u);
    s16x4 r; asm volatile("ds_read_b64_tr_b16 %0, %1\n\ts_waitcnt lgkmcnt(0)" : "=&v"(r) : "v"(addr) : "memory"); return r;
}

DI unsigned tr_addr(const LAS unsigned char* tile, int lane, int row0, int c) {
    const unsigned q = (unsigned)(lane & 15) >> 2, p = (unsigned)lane & 3u;
    return (unsigned)(size_t)tile + off_b((unsigned)row0 + q, (unsigned)(2 * c) + (p >> 1)) + 8u * (p & 1u);
}
DI void tile_tr_read4(unsigned a0, unsigned a1, unsigned a2, unsigned a3, s16x4& r0, s16x4& r1, s16x4& r2, s16x4& r3) {
    asm volatile("ds_read_b64_tr_b16 %0, %4\n\tds_read_b64_tr_b16 %1, %5\n\tds_read_b64_tr_b16 %2, %6\n\tds_read_b64_tr_b16 %3, %7\n\ts_waitcnt lgkmcnt(0)"
                 : "=&v"(r0), "=&v"(r1), "=&v"(r2), "=&v"(r3) : "v"(a0), "v"(a1), "v"(a2), "v"(a3) : "memory");
}

#define XB_TMO      128
#define XB_XCNT(j)  (256  + 64 * (j))
#define XB_XSUB(j)  (1280 + 64 * (j))
#define XB_XGEN(j)  (2304 + 64 * (j))
#define XB_TOP      3328
#define XB_TOPGEN   3392
#define XB_SPIN_CAP (1u << 18)
DI unsigned xb_ld(unsigned* p)              { return __hip_atomic_load(p, __ATOMIC_RELAXED, __HIP_MEMORY_SCOPE_AGENT); }
DI unsigned xb_add(unsigned* p, unsigned v) { return __hip_atomic_fetch_add(p, v, __ATOMIC_RELAXED, __HIP_MEMORY_SCOPE_AGENT); }
DI unsigned xb_xcc_id() { return (unsigned)__builtin_amdgcn_s_getreg((3 << 11) | 20) & 0xFu; }
#define XB_SPIN(cond, bar) do { unsigned _sp = 0; while (cond) { __builtin_amdgcn_s_sleep(1); \
    if ((++_sp & 255u) == 0u) { if (xb_ld(&(bar)[XB_TMO])) break; if (_sp > XB_SPIN_CAP) { atomicAdd(&(bar)[XB_TMO], 1u); break; } } } } while (0)
struct XcdBarrier { unsigned* bar; unsigned x; volatile LAS unsigned* st; };
DI XcdBarrier xcd_barrier_post(unsigned* bar, volatile LAS unsigned* st) {
    XcdBarrier b; b.bar = bar; b.x = xb_xcc_id(); b.st = st;
    if (threadIdx.x == 0) (void)xb_add(&bar[XB_XCNT(b.x)], 1u);
    return b;
}
DI void xcd_barrier_complete(unsigned* bar, unsigned x, unsigned& nloc, unsigned& nx) {
    const unsigned G = gridDim.x * gridDim.y * gridDim.z;
    unsigned sum, cnt, mine, sp = 0u;
    for (;;) {
        sum = 0u; cnt = 0u; mine = 0u;
#pragma unroll
        for (unsigned j = 0; j < 16; ++j) { const unsigned c = xb_ld(&bar[XB_XCNT(j)]); sum += c; cnt += (c > 0u) ? 1u : 0u; mine = (j == x) ? c : mine; }
        if (sum == G) break;
        __builtin_amdgcn_s_sleep(1);
        if ((++sp & 255u) == 0u) { if (xb_ld(&bar[XB_TMO])) break; if (sp > XB_SPIN_CAP) { atomicAdd(&bar[XB_TMO], 1u); break; } }
    }
    nloc = mine > 0u ? mine : 1u; nx = cnt > 0u ? cnt : 1u;
}
DI void xcd_barrier(const XcdBarrier& b) {
    asm volatile("s_waitcnt vmcnt(0)" ::: "memory");
    __syncthreads();
    if (threadIdx.x == 0) {
        unsigned* bar = b.bar;
        __builtin_amdgcn_s_waitcnt(0);
        unsigned nloc = b.st[0], nx = b.st[1];
        if (nloc == 0u) { xcd_barrier_complete(bar, b.x, nloc, nx); b.st[0] = nloc; b.st[1] = nx; }
        const unsigned old = xb_add(&bar[XB_XSUB(b.x)], 1u);
        const unsigned gen = old / nloc;
        if (old + 1u == (gen + 1u) * nloc) {
            __builtin_amdgcn_fence(__ATOMIC_RELEASE, "agent");
            asm volatile("s_waitcnt vmcnt(0)" ::: "memory");
            const unsigned og = xb_add(&bar[XB_TOP], 1u);
            const unsigned tg = og / nx;
            if (og + 1u == (tg + 1u) * nx) xb_add(&bar[XB_TOPGEN], 1u);
            else XB_SPIN(xb_ld(&bar[XB_TOPGEN]) == tg, bar);
            __builtin_amdgcn_fence(__ATOMIC_ACQUIRE, "agent");
            xb_add(&bar[XB_XGEN(b.x)], 1u);
            asm volatile("s_waitcnt vmcnt(0)" ::: "memory");
        } else {
            XB_SPIN(xb_ld(&bar[XB_XGEN(b.x)]) == gen, bar);
            __builtin_amdgcn_fence(__ATOMIC_ACQUIRE, "agent");
            asm volatile("s_waitcnt vmcnt(0)" ::: "memory");
        }
    }
    __syncthreads();
}

constexpr int BM = 256, BK = 64, HALF = 128, HTB = HALF * BK * 2, STAGE_BYTES = 8 * HTB, NXCD = 8, WGM = 8;
DI int lds_byte(int r, int c) { const int st = (r >> 4) * 2 + (c >> 5), rr = r & 15, cc = c & 31, ob = rr * 64 + cc * 2; return st * 1024 + (ob ^ (((ob >> 9) & 1) << 5)); }
DI void stage_rc(int b, int& R, int& C) { const int st = b / 1024, sb = b % 1024, swz = sb ^ (((sb >> 9) & 1) << 5); R = (st >> 1) * 16 + swz / 64; C = (st & 1) * 32 + (swz % 64) / 2; }
DI int perm32(int rho) { const int n = rho >> 4, i = rho & 15; return 8 * (i >> 2) + 4 * n + (i & 3); }

struct Unit { const char* A; const char* B; int pm, pn, aux; };
struct Gemm { unsigned lda, ldb; int K; };

struct DenseOrder {
    static constexpr bool GATHER = false;
    const char* A; const char* B; unsigned lda, ldb; int nM, nN, nwg, G, c;
    DI void init(const void* A_, const void* B_, unsigned lda_, unsigned ldb_, int M, int N, int G_, int c_) { A = (const char*)A_; B = (const char*)B_; lda = lda_; ldb = ldb_; nM = M / BM; nN = N / BM; nwg = nM * nN; G = G_; c = c_; }
    DI bool next(int i, Unit& u) const {
        const long Lx = (long)i * G + c; if (Lx >= nwg) return false;
        int wgid = (int)Lx; { const int q = nwg / NXCD, r = nwg % NXCD, xcd = wgid % NXCD, off = wgid / NXCD; wgid = (xcd < r ? xcd * (q + 1) : r * (q + 1) + (xcd - r) * q) + off; }
        const int nig = WGM * nN, gid = wgid / nig, fm = gid * WGM, gsz = (nM - fm) < WGM ? (nM - fm) : WGM;
        u.pm = fm + ((wgid % nig) % gsz); u.pn = (wgid % nig) / gsz; u.aux = 0;
        u.A = A + (size_t)u.pm * BM * lda; u.B = B + (size_t)u.pn * BM * ldb; return true;
    }
    DI unsigned voff(const Unit&, int, int) const { return 0u; }
    DI void a_ready(const Unit&) const {}
};
struct GroupOrder {
    static constexpr bool GATHER = false;
    const char* A; const char* B; size_t astride, bstride; unsigned lda; int nunits, G, c;
    DI bool next(int i, Unit& u) const {
        const int Lx = i * G + c; if (Lx >= nunits) return false;
        const int g = Lx >> 2, pm = Lx & 3; u.pm = pm; u.pn = 0; u.aux = g; u.A = A + (size_t)g * astride + (size_t)pm * BM * lda; u.B = B + (size_t)g * bstride; return true;
    }
    DI unsigned voff(const Unit&, int, int) const { return 0u; }
    DI void a_ready(const Unit&) const {}
};
template <bool GATHER_>
struct MoeOrder {
    static constexpr bool GATHER = GATHER_;
    const char* A; const char* B; unsigned lda, ldb; size_t bstride; const LAS int* tbase; const LAS int* cnt; const int* buf_t; unsigned* done; int nunits, G, c, n3, nb;
    DI bool next(int i, Unit& u) const {
        int Lx;
        if constexpr (GATHER_) { Lx = i * G + c; }
        else { const int cr = (c - n3 + G) % G; const bool bonus = (c >= n3) && (c - n3 < nb); if (bonus && i == 0) Lx = c - n3; else Lx = nb + cr + (bonus ? i - 1 : i) * G; }
        if (Lx >= nunits) return false;
        const int T = Lx >> 2, pn = Lx & 3; int e = 0; while (e < NE_ - 1 && tbase[e + 1] <= T) ++e;
        const int k = T - tbase[e]; u.pm = T; u.pn = pn; u.aux = e * 128 + k;
        u.B = B + (size_t)e * bstride + (size_t)pn * BM * ldb; u.A = GATHER_ ? A : A + (size_t)T * BM * lda; return true;
    }
    DI unsigned voff(const Unit& u, int R, int C) const {
        const int e = u.aux >> 7, idx = (u.aux & 127) * 256 + R; const int tok = (idx < cnt[e]) ? buf_t[(size_t)e * ECAP_ + idx] : 0;
        return (unsigned)tok * lda + (unsigned)C * 2u;
    }
    DI void a_ready(const Unit& u) const {
        if constexpr (!GATHER_) {
            if (threadIdx.x < 64) {
                unsigned spins = 0;
                while ((unsigned)__builtin_amdgcn_readfirstlane(__hip_atomic_load(done + 16 * u.pm, __ATOMIC_RELAXED, __HIP_MEMORY_SCOPE_AGENT)) < 32u) { __builtin_amdgcn_s_sleep(2); if (++spins > (1u << 22)) break; }
                __builtin_amdgcn_fence(__ATOMIC_ACQUIRE, "agent");
                asm volatile("s_waitcnt vmcnt(0)" ::: "memory");
            }
            asm volatile("" ::: "memory"); __builtin_amdgcn_s_barrier(); asm volatile("" ::: "memory");
        }
    }
};

template <class Epi, class Sched>
DI void gemm_phase(LAS unsigned char* lds, const Gemm g, const Sched& S, const Epi& E) {
    int tid = threadIdx.x; asm volatile("" : "+v"(tid)); tid &= 511;
    const int wid = __builtin_amdgcn_readfirstlane(tid >> 6), lane = tid & 63, wr = wid >> 2, wc = wid & 3, fr = lane & 15, fq = lane >> 4;
    const int nt = g.K / BK;
    unsigned voffA[2][2], nvoffA[2][2], voffB[2];
#pragma unroll
    for (int i = 0; i < 2; ++i) { int R, C; stage_rc(tid * 16 + i * 8192, R, C); const int Rb = Epi::PERM ? ((R & ~31) + perm32(R & 31)) : R;
        voffB[i] = (unsigned)Rb * g.ldb + (unsigned)C * 2u;
        voffA[0][i] = (unsigned)R * g.lda + (unsigned)C * 2u; voffA[1][i] = (unsigned)(R + HALF) * g.lda + (unsigned)C * 2u;
        nvoffA[0][i] = voffA[0][i]; nvoffA[1][i] = voffA[1][i]; }
    const size_t kstep = (size_t)(BK * 2);
    const size_t hstepB = (size_t)HALF * g.ldb;
    const unsigned ldsw = (unsigned)wid * 1024u;
    const int aoff = lds_byte(wr * 64 + fr, fq * 8), boff = lds_byte(wc * 32 + fr, fq * 8);
#define PG8_SA(b, h) (((b) * 2 + (h)) * HTB)
#define PG8_SB(b, h) ((4 + (b) * 2 + (h)) * HTB)
#define PG8_STAGE(bufoff, gbase, voff) do { _Pragma("unroll") for (int _i = 0; _i < 2; ++_i) \
        __builtin_amdgcn_global_load_lds((const unsigned*)((const char*)(gbase) + (voff)[_i]), (LAS unsigned*)(lds + (bufoff) + ldsw + _i * 8192), 16, 0, 0); } while (0)
#define PG8_LDA(dst, b, h) do { if constexpr (Epi::FP8) { _Pragma("unroll") for (int m = 0; m < 4; ++m) dst##8[m] = __builtin_shufflevector(*(const LAS v4i*)(lds + PG8_SA(b, h) + aoff + m * 2048), *(const LAS v4i*)(lds + PG8_SA(b, h) + aoff + m * 2048 + 1024), 0, 1, 2, 3, 4, 5, 6, 7); } \
        else { _Pragma("unroll") for (int m = 0; m < 4; ++m) _Pragma("unroll") for (int k = 0; k < 2; ++k) dst[m][k] = *(const LAS bf16x8*)(lds + PG8_SA(b, h) + aoff + m * 2048 + k * 1024); } } while (0)
#define PG8_LDB(dst, b, h) do { if constexpr (Epi::FP8) { _Pragma("unroll") for (int n = 0; n < 2; ++n) dst##8[n] = __builtin_shufflevector(*(const LAS v4i*)(lds + PG8_SB(b, h) + boff + n * 2048), *(const LAS v4i*)(lds + PG8_SB(b, h) + boff + n * 2048 + 1024), 0, 1, 2, 3, 4, 5, 6, 7); } \
        else { _Pragma("unroll") for (int n = 0; n < 2; ++n) _Pragma("unroll") for (int k = 0; k < 2; ++k) dst[n][k] = *(const LAS bf16x8*)(lds + PG8_SB(b, h) + boff + n * 2048 + k * 1024); } } while (0)
#define PG8_MMA(ai, bj, At, Bt) do { __builtin_amdgcn_s_setprio(1); _Pragma("unroll") for (int m = 0; m < 4; ++m) _Pragma("unroll") for (int n = 0; n < 2; ++n) { \
        if constexpr (Epi::FP8)   \
            asm volatile("v_mfma_scale_f32_16x16x128_f8f6f4 %0, %1, %2, %0, %3, %3 op_sel_hi:[0,0,0]" : "+v"(acc[ai][bj][m][n]) : "v"(Bt##8[n]), "v"(At##8[m]), "v"(sc8));   \
        else { _Pragma("unroll") for (int k = 0; k < 2; ++k) acc[ai][bj][m][n] = __builtin_amdgcn_mfma_f32_16x16x32_bf16(Bt[n][k], At[m][k], acc[ai][bj][m][n], 0, 0, 0); } } \
        __builtin_amdgcn_s_setprio(0); } while (0)
#define PG8_WAIT_V(n) asm volatile("s_waitcnt vmcnt(" #n ")" ::: "memory")
#define PG8_WAIT_L(n) asm volatile("s_waitcnt lgkmcnt(" #n ")" ::: "memory")
#define PG8_BAR __builtin_amdgcn_s_barrier()
#define PG8_SCHED __builtin_amdgcn_sched_barrier(0)
    Unit cur, nxt; int ui = 0;
    if (!S.next(0, cur)) return;
    if constexpr (Sched::GATHER) {
#pragma unroll
        for (int i = 0; i < 2; ++i) { int R, C; stage_rc(tid * 16 + i * 8192, R, C); voffA[0][i] = S.voff(cur, R, C); voffA[1][i] = S.voff(cur, R + HALF, C); }
    }
    f32x4 acc[2][2][4][2];
#pragma unroll
    for (int a = 0; a < 2; ++a)
#pragma unroll
        for (int b = 0; b < 2; ++b)
#pragma unroll
            for (int m = 0; m < 4; ++m)
#pragma unroll
                for (int n = 0; n < 2; ++n) acc[a][b][m][n] = (f32x4){0.f, 0.f, 0.f, 0.f};
    const int sc8 = 0x7f7f7f7f;
    bf16x8 At[4][2], B0[2][2], B1[2][2]; v8i At8[4], B08[2], B18[2];
    const char* cA = cur.A; const char* cB = cur.B;
    S.a_ready(cur);
    PG8_STAGE(PG8_SB(0, 0), cB, voffB); PG8_STAGE(PG8_SB(0, 1), cB + hstepB, voffB); PG8_STAGE(PG8_SA(0, 0), cA, voffA[0]); PG8_STAGE(PG8_SA(0, 1), cA, voffA[1]);
    if (wr == 1) PG8_BAR;
    PG8_WAIT_V(2); PG8_BAR;
    PG8_STAGE(PG8_SB(1, 0), cB + kstep, voffB); PG8_STAGE(PG8_SA(1, 0), cA + kstep, voffA[0]); PG8_STAGE(PG8_SB(1, 1), cB + hstepB + kstep, voffB);
    PG8_WAIT_V(6); PG8_BAR;
    for (;;) {
        const bool has_next = S.next(ui + 1, nxt);
        const char* nA = has_next ? nxt.A : cA; const char* nB = has_next ? nxt.B : cB;
        if constexpr (Sched::GATHER) {
            if (has_next) {
#pragma unroll
                for (int i = 0; i < 2; ++i) { int R, C; stage_rc(tid * 16 + i * 8192, R, C); nvoffA[0][i] = S.voff(nxt, R, C); nvoffA[1][i] = S.voff(nxt, R + HALF, C); }
            } else {
#pragma unroll
                for (int i = 0; i < 2; ++i) { nvoffA[0][i] = voffA[0][i]; nvoffA[1][i] = voffA[1][i]; }
            }
        }
        for (int t = 0; t < nt; t += 2) {
            const bool last = (t == nt - 2);
            if constexpr (Epi::MIDSCALE) { if (t == nt / 2) E.mid(acc, cur, wr, fr); }
            if (last && has_next) S.a_ready(nxt);
            const char* a1 = cA + (size_t)(t + 1) * kstep;
            const char* a2 = last ? nA : cA + (size_t)(t + 2) * kstep; const char* b2 = last ? nB : cB + (size_t)(t + 2) * kstep;
            const char* a3 = a2 + kstep; const char* b3 = b2 + kstep;
            unsigned va0[2], va1[2];
#pragma unroll
            for (int i = 0; i < 2; ++i) { va0[i] = (Sched::GATHER && last) ? nvoffA[0][i] : voffA[0][i]; va1[i] = (Sched::GATHER && last) ? nvoffA[1][i] : voffA[1][i]; }
            PG8_LDB(B0, 0, 0); PG8_LDB(B1, 0, 1); PG8_SCHED; PG8_LDA(At, 0, 0); PG8_STAGE(PG8_SA(1, 1), a1, voffA[1]);
            PG8_WAIT_V(8); PG8_WAIT_L(0); PG8_BAR; PG8_MMA(0, 0, At, B0); PG8_MMA(0, 1, At, B1); PG8_BAR; PG8_SCHED;
            PG8_LDA(At, 0, 1); PG8_STAGE(PG8_SB(0, 0), b2, voffB); PG8_STAGE(PG8_SB(0, 1), b2 + hstepB, voffB); PG8_STAGE(PG8_SA(0, 0), a2, va0);
            PG8_WAIT_V(8); PG8_WAIT_L(0); PG8_BAR; PG8_MMA(1, 0, At, B0); PG8_MMA(1, 1, At, B1); PG8_BAR; PG8_SCHED;
            PG8_LDB(B0, 1, 0); PG8_LDB(B1, 1, 1); PG8_SCHED; PG8_LDA(At, 1, 0); PG8_STAGE(PG8_SA(0, 1), a2, va1);
            PG8_WAIT_V(8); PG8_WAIT_L(0); PG8_BAR; PG8_MMA(0, 0, At, B0); PG8_MMA(0, 1, At, B1); PG8_BAR; PG8_SCHED;
            PG8_LDA(At, 1, 1); PG8_STAGE(PG8_SB(1, 0), b3, voffB); PG8_STAGE(PG8_SB(1, 1), b3 + hstepB, voffB); PG8_STAGE(PG8_SA(1, 0), a3, va0);
            PG8_WAIT_V(8); PG8_WAIT_L(0); PG8_BAR; PG8_MMA(1, 0, At, B0); PG8_MMA(1, 1, At, B1); PG8_BAR; PG8_SCHED;
        }
        if (wr == 0) PG8_BAR;
        if constexpr (Epi::FP8) {
#define PG8_PIN8(a, b) asm volatile("s_nop 15\n\ts_nop 15" : "+v"(acc[a][b][0][0]), "+v"(acc[a][b][0][1]), "+v"(acc[a][b][1][0]), "+v"(acc[a][b][1][1]), "+v"(acc[a][b][2][0]), "+v"(acc[a][b][2][1]), "+v"(acc[a][b][3][0]), "+v"(acc[a][b][3][1]))
            PG8_PIN8(0, 0); PG8_PIN8(0, 1); PG8_PIN8(1, 0); PG8_PIN8(1, 1);
#undef PG8_PIN8
        }
        { int tz = tid; asm volatile("" : "+v"(tz)); tz &= 511;
          const int wz = __builtin_amdgcn_readfirstlane(tz >> 6), lz = tz & 63; if constexpr (!Epi::AFTER_DRAIN) E(acc, cur, wz >> 2, wz & 3, lz & 15, lz >> 4); }
        if (!has_next) break;
#pragma unroll
        for (int a = 0; a < 2; ++a)
#pragma unroll
            for (int b = 0; b < 2; ++b)
#pragma unroll
                for (int m = 0; m < 4; ++m)
#pragma unroll
                    for (int n = 0; n < 2; ++n) acc[a][b][m][n] = (f32x4){0.f, 0.f, 0.f, 0.f};
        cur = nxt; cA = nA; cB = nB; ++ui;
        if constexpr (Sched::GATHER) {
#pragma unroll
            for (int i = 0; i < 2; ++i) { voffA[0][i] = nvoffA[0][i]; voffA[1][i] = nvoffA[1][i]; }
        }
        if (wr == 1) PG8_BAR;
    }
    PG8_WAIT_V(0);
    PG8_BAR;
    if constexpr (Epi::AFTER_DRAIN) {
        int tz = tid; asm volatile("" : "+v"(tz)); tz &= 511;
        const int wz = __builtin_amdgcn_readfirstlane(tz >> 6), lz = tz & 63; E.fused(acc, cur, wz >> 2, wz & 3, lz & 15, lz >> 4, lds, tz);
    }
#undef PG8_SA
#undef PG8_SB
#undef PG8_STAGE
#undef PG8_LDA
#undef PG8_LDB
#undef PG8_MMA
#undef PG8_WAIT_V
#undef PG8_WAIT_L
#undef PG8_BAR
#undef PG8_SCHED
}


struct EpiInProj {
    static constexpr bool PERM = true, MIDSCALE = false, FP8 = false, AFTER_DRAIN = false;
    bf16_t* zb; bf16_t* AS5;
    DI void operator()(const f32x4 (&acc)[2][2][4][2], const Unit& u, int wr, int wc, int fr, int fq) const {
        const int row0 = u.pm * BM + wr * 64 + fr, col0 = u.pn * BM + wc * 32 + 8 * fq;
#pragma unroll
        for (int ai = 0; ai < 2; ++ai)
#pragma unroll
            for (int m = 0; m < 4; ++m) { const int row = row0 + ai * HALF + m * 16;
#pragma unroll
                for (int bj = 0; bj < 2; ++bj) { const f32x4 v0 = acc[ai][bj][m][0], v1 = acc[ai][bj][m][1]; const int col = col0 + bj * HALF;
                    u32x4 o; o.x = cvt_pk_bf16(v0[0], v0[1]); o.y = cvt_pk_bf16(v0[2], v0[3]); o.z = cvt_pk_bf16(v1[0], v1[1]); o.w = cvt_pk_bf16(v1[2], v1[3]);
                    if (u.pn < 6) *(u32x4*)(zb + (size_t)row * ZLD_ + col) = o;
                    else { const int cs = col - 1536; *(u32x4*)(AS5 + ((size_t)(cs >> 4) * S5R_ + (row >> 4)) * S5K_ + (row & 15) * 16 + (cs & 15)) = o; } } }
    }
};
struct EpiS5E {
    static constexpr bool PERM = false, MIDSCALE = false, FP8 = false, AFTER_DRAIN = false;
    bf16_t* E;
    DI void operator()(const f32x4 (&acc)[2][2][4][2], const Unit& u, int wr, int wc, int fr, int fq) const {
        const int row0 = u.pm * BM + wr * 64 + fr, col0 = wc * 32 + 4 * fq;
#pragma unroll
        for (int ai = 0; ai < 2; ++ai)
#pragma unroll
            for (int m = 0; m < 4; ++m) { bf16_t* rowp = E + ((size_t)u.aux * S5R_ + row0 + ai * HALF + m * 16) * 128 + col0;
#pragma unroll
                for (int n = 0; n < 2; ++n) { const f32x4 v = acc[ai][0][m][n]; u32x2 o; o.x = cvt_pk_bf16(v[0], v[1]); o.y = cvt_pk_bf16(v[2], v[3]); *(u32x2*)(rowp + n * 16) = o; } }
    }
};
struct EpiS5Y {
    static constexpr bool PERM = false, MIDSCALE = false, FP8 = false, AFTER_DRAIN = false;
    bf16_t* gy;
    DI void operator()(const f32x4 (&acc)[2][2][4][2], const Unit& u, int wr, int wc, int fr, int fq) const {
        const int row0 = u.pm * BM + wr * 64 + fr;
#pragma unroll
        for (int ai = 0; ai < 2; ++ai)
#pragma unroll
            for (int m = 0; m < 4; ++m) { const int row = row0 + ai * HALF + m * 16;
#pragma unroll
                for (int bj = 0; bj < 2; ++bj)
#pragma unroll
                    for (int n = 0; n < 2; ++n) { const int j = 8 * bj + 2 * wc + n; const f32x4 v = acc[ai][bj][m][n];
                        u32x2 o; o.x = cvt_pk_bf16(fast_gelu_tanh(v[0]), fast_gelu_tanh(v[1])); o.y = cvt_pk_bf16(fast_gelu_tanh(v[2]), fast_gelu_tanh(v[3]));
                        *(u32x2*)(gy + (size_t)(16 * row + j) * DM_ + 16 * u.aux + 4 * fq) = o; } }
    }
};
struct EpiGlu {
    static constexpr bool PERM = false, MIDSCALE = false, FP8 = false, AFTER_DRAIN = false;
    const bf16_t* gy; const float* b_glu; bf16_t* yb; float* ssqS;
    DI void operator()(const f32x4 (&acc)[2][2][4][2], const Unit& u, int wr, int wc, int fr, int fq) const {
        const int row0 = u.pm * BM + wr * 64 + fr, col0 = u.pn * BM + wc * 32 + 4 * fq;
#pragma unroll
        for (int ai = 0; ai < 2; ++ai)
#pragma unroll
            for (int m = 0; m < 4; ++m) { const int row = row0 + ai * HALF + m * 16; float ss = 0.f;
#pragma unroll
                for (int bj = 0; bj < 2; ++bj)
#pragma unroll
                    for (int n = 0; n < 2; ++n) { const int col = col0 + bj * HALF + n * 16; const f32x4 a = acc[ai][bj][m][n]; const f32x4 bb = *(const f32x4*)(b_glu + col);
                        const u32x2 gv = *(const u32x2*)(gy + (size_t)row * DM_ + col);
                        const float y0 = bflo(gv.x) * fast_sigmoid(a[0] + bb[0]), y1 = bfhi(gv.x) * fast_sigmoid(a[1] + bb[1]), y2 = bflo(gv.y) * fast_sigmoid(a[2] + bb[2]), y3 = bfhi(gv.y) * fast_sigmoid(a[3] + bb[3]);
                        ss += (y0 * y0 + y1 * y1) + (y2 * y2 + y3 * y3);
                        u32x2 o; o.x = cvt_pk_bf16(y0, y1); o.y = cvt_pk_bf16(y2, y3); *(u32x2*)(yb + (size_t)row * D_ + col) = o; }
                ss += __shfl_xor(ss, 16); ss += __shfl_xor(ss, 32);
                if (fq == 0) ssqS[(size_t)row * 8 + u.pn * 4 + wc] = ss; }
    }
};
struct EpiOutProj {
    static constexpr bool PERM = true, MIDSCALE = true, FP8 = false, AFTER_DRAIN = false;
    const bf16_t* xres; const float* ssqS; bf16_t* r1;
    DI void mid(f32x4 (&acc)[2][2][4][2], const Unit& u, int wr, int fr) const {
        const int row0 = u.pm * BM + wr * 64 + fr;
#pragma unroll
        for (int ai = 0; ai < 2; ++ai)
#pragma unroll
            for (int m = 0; m < 4; ++m) { const int row = row0 + ai * HALF + m * 16; const f32x4 s0 = *(const f32x4*)(ssqS + (size_t)row * 8), s1 = *(const f32x4*)(ssqS + (size_t)row * 8 + 4);
                const float rstd = rsqrtf(((s0[0] + s0[1]) + (s0[2] + s0[3]) + (s1[0] + s1[1]) + (s1[2] + s1[3])) * (1.f / DM_) + EPS_);
#pragma unroll
                for (int bj = 0; bj < 2; ++bj)
#pragma unroll
                    for (int n = 0; n < 2; ++n) acc[ai][bj][m][n] = acc[ai][bj][m][n] * rstd; }
    }
    DI void operator()(const f32x4 (&acc)[2][2][4][2], const Unit& u, int wr, int wc, int fr, int fq) const {
        const int row0 = u.pm * BM + wr * 64 + fr, col0 = u.pn * BM + wc * 32 + 8 * fq;
#pragma unroll
        for (int ai = 0; ai < 2; ++ai)
#pragma unroll
            for (int m = 0; m < 4; ++m) { const size_t rb = (size_t)(row0 + ai * HALF + m * 16) * D_ + col0;
#pragma unroll
                for (int bj = 0; bj < 2; ++bj) { const u32x4 xv = *(const u32x4*)(xres + rb + bj * HALF); const f32x4 v0 = acc[ai][bj][m][0], v1 = acc[ai][bj][m][1];
                    u32x4 o; o.x = cvt_pk_bf16(ALPHA_ * bflo(xv.x) + v0[0], ALPHA_ * bfhi(xv.x) + v0[1]); o.y = cvt_pk_bf16(ALPHA_ * bflo(xv.y) + v0[2], ALPHA_ * bfhi(xv.y) + v0[3]);
                    o.z = cvt_pk_bf16(ALPHA_ * bflo(xv.z) + v1[0], ALPHA_ * bfhi(xv.z) + v1[1]); o.w = cvt_pk_bf16(ALPHA_ * bflo(xv.w) + v1[2], ALPHA_ * bfhi(xv.w) + v1[3]);
                    *(u32x4*)(r1 + rb + bj * HALF) = o; } }
    }
};
struct EpiOutLn {
    static constexpr bool PERM = true, MIDSCALE = true, FP8 = false, AFTER_DRAIN = true;
    const bf16_t* xres; const float* ssqS; const bf16_t* ghl; const float* rtc; const float* ln_g; const float* ln_b;
    float* xch; unsigned* cnt; bf16_t* x1b; unsigned char* x1q; unsigned* cur; int* buf_t; float* buf_w; int* slot_of;
    DI void mid(f32x4 (&acc)[2][2][4][2], const Unit& u, int wr, int fr) const {
        const int row0 = u.pm * BM + wr * 64 + fr;
#pragma unroll
        for (int ai = 0; ai < 2; ++ai)
#pragma unroll
            for (int m = 0; m < 4; ++m) { const int row = row0 + ai * HALF + m * 16; const f32x4 s0 = *(const f32x4*)(ssqS + (size_t)row * 8), s1 = *(const f32x4*)(ssqS + (size_t)row * 8 + 4);
                const float rstd = rsqrtf(((s0[0] + s0[1]) + (s0[2] + s0[3]) + (s1[0] + s1[1]) + (s1[2] + s1[3])) * (1.f / DM_) + EPS_);
#pragma unroll
                for (int bj = 0; bj < 2; ++bj)
#pragma unroll
                    for (int n = 0; n < 2; ++n) acc[ai][bj][m][n] = acc[ai][bj][m][n] * rstd; }
    }
    DI void operator()(const f32x4 (&)[2][2][4][2], const Unit&, int, int, int, int) const {}
    DI void fused(f32x4 (&acc)[2][2][4][2], const Unit& u, int wr, int wc, int fr, int fq, LAS unsigned char* lds, int tid) const {
        LAS float* PT4 = (LAS float*)lds;
        LAS float* MS = (LAS float*)(lds + 81920);
        const int row0 = u.pm * BM + wr * 64 + fr, col0 = u.pn * BM + wc * 32 + 8 * fq;
        u32x4 gtv[6];
#pragma unroll
        for (int i = 0; i < 6; ++i) { const int idx = tid + i * NT_; gtv[i] = *(const u32x4*)(ghl + (size_t)(idx >> 5) * D_ + u.pn * BM + (idx & 31) * 8); }
#pragma unroll
        for (int ai = 0; ai < 2; ++ai) {
#pragma unroll
            for (int m = 0; m < 4; ++m) { const size_t rb = (size_t)(row0 + ai * HALF + m * 16) * D_ + col0;
#pragma unroll
                for (int bj = 0; bj < 2; ++bj) { const u32x4 xv = *(const u32x4*)(xres + rb + bj * HALF); f32x4 v0 = acc[ai][bj][m][0], v1 = acc[ai][bj][m][1];
                    v0[0] += ALPHA_ * bflo(xv.x); v0[1] += ALPHA_ * bfhi(xv.x); v0[2] += ALPHA_ * bflo(xv.y); v0[3] += ALPHA_ * bfhi(xv.y);
                    v1[0] += ALPHA_ * bflo(xv.z); v1[1] += ALPHA_ * bfhi(xv.z); v1[2] += ALPHA_ * bflo(xv.w); v1[3] += ALPHA_ * bfhi(xv.w);
                    acc[ai][bj][m][0] = v0; acc[ai][bj][m][1] = v1; } } }
        asm volatile("" ::: "memory");
        LAS unsigned char* GT = lds + 83968;
        LAS float* LG = (LAS float*)(lds + 134656);
        LAS int* cntL = (LAS int*)(lds + 144896); LAS int* baseL = cntL + 32; LAS int* tokE = baseL + 32; LAS float* tokW = (LAS float*)(tokE + 128);
        if (tid < 32) cntL[tid] = 0;
#pragma unroll
        for (int i = 0; i < 6; ++i) { const int idx = tid + i * NT_; *(LAS u32x4*)(GT + (idx >> 5) * 528 + (idx & 31) * 16) = gtv[i]; }
        __syncthreads();
        const LAS unsigned char* gfrag = GT + fr * 528 + (wc * 32 + 8 * fq) * 2;
        float* xq = xch + (size_t)(u.pm * 4 + u.pn) * 256 * 40;
#pragma unroll
        for (int ai = 0; ai < 2; ++ai) {
#pragma unroll
            for (int m = 0; m < 4; ++m) {
                f32x4 d[3]; d[0] = (f32x4){0.f, 0.f, 0.f, 0.f}; d[1] = d[0]; d[2] = d[0]; float s2 = 0.f;
#pragma unroll
                for (int bj = 0; bj < 2; ++bj) { const f32x4 v0 = acc[ai][bj][m][0], v1 = acc[ai][bj][m][1];
                    u32x4 h, lo; h.x = cvt_pk_bf16(v0[0], v0[1]); h.y = cvt_pk_bf16(v0[2], v0[3]); h.z = cvt_pk_bf16(v1[0], v1[1]); h.w = cvt_pk_bf16(v1[2], v1[3]);
                    lo.x = cvt_pk_bf16(v0[0] - bflo(h.x), v0[1] - bfhi(h.x)); lo.y = cvt_pk_bf16(v0[2] - bflo(h.y), v0[3] - bfhi(h.y));
                    lo.z = cvt_pk_bf16(v1[0] - bflo(h.z), v1[1] - bfhi(h.z)); lo.w = cvt_pk_bf16(v1[2] - bflo(h.w), v1[3] - bfhi(h.w));
                    const bf16x8 ah = __builtin_bit_cast(bf16x8, h), al = __builtin_bit_cast(bf16x8, lo);
#pragma unroll
                    for (int ob = 0; ob < 3; ++ob) { const bf16x8 gh = *(const LAS bf16x8*)(gfrag + ob * 16 * 528 + bj * 256), gl = *(const LAS bf16x8*)(gfrag + (48 + ob * 16) * 528 + bj * 256);
                        d[ob] = mfma16(gh, ah, d[ob]); d[ob] = mfma16(gl, ah, d[ob]); d[ob] = mfma16(gh, al, d[ob]); }
                    s2 += ((v0[0] * v0[0] + v0[1] * v0[1]) + (v0[2] * v0[2] + v0[3] * v0[3])) + ((v1[0] * v1[0] + v1[1] * v1[1]) + (v1[2] * v1[2] + v1[3] * v1[3])); }
                s2 += __shfl_xor(s2, 16); s2 += __shfl_xor(s2, 32);
                if (fq == 1) d[2][1] = s2;
                LAS float* rp = PT4 + (wc * 128 + wr * 64 + m * 16 + fr) * 40;
                *(LAS f32x4*)(rp + 4 * fq) = d[0]; *(LAS f32x4*)(rp + 16 + 4 * fq) = d[1]; if (fq < 2) *(LAS f32x4*)(rp + 32 + 4 * fq) = d[2];
            }
            __syncthreads();
            for (int idx = tid; idx < 1280; idx += NT_) { const LAS f32x4* q4 = (const LAS f32x4*)PT4 + idx; const f32x4 s = ((q4[0] + q4[1280]) + q4[2560]) + q4[3840];
                unsigned long long* dst = (unsigned long long*)(xq + (size_t)ai * 5120 + (size_t)idx * 4);
                __hip_atomic_store(dst, ((unsigned long long)__float_as_uint(s[1]) << 32) | __float_as_uint(s[0]), __ATOMIC_RELAXED, __HIP_MEMORY_SCOPE_AGENT);
                __hip_atomic_store(dst + 1, ((unsigned long long)__float_as_uint(s[3]) << 32) | __float_as_uint(s[2]), __ATOMIC_RELAXED, __HIP_MEMORY_SCOPE_AGENT); }
            __syncthreads();
        }
        f32x4 gg[2][2], bb[2][2];
#pragma unroll
        for (int bj = 0; bj < 2; ++bj)
#pragma unroll
            for (int n = 0; n < 2; ++n) { gg[bj][n] = *(const f32x4*)(ln_g + col0 + bj * HALF + 4 * n); bb[bj][n] = *(const f32x4*)(ln_b + col0 + bj * HALF + 4 * n); }
        asm volatile("s_waitcnt vmcnt(0)" ::: "memory");
        if (fr == 0 && fq == 0) __hip_atomic_fetch_add(cnt + 16 * u.pm, 1u, __ATOMIC_RELAXED, __HIP_MEMORY_SCOPE_AGENT);
        if (tid < 64) {
            unsigned spins = 0;
            while ((unsigned)__builtin_amdgcn_readfirstlane(__hip_atomic_load(cnt + 16 * u.pm, __ATOMIC_RELAXED, __HIP_MEMORY_SCOPE_AGENT)) < 32u) { __builtin_amdgcn_s_sleep(2); if (++spins > (1u << 22)) break; }
            __builtin_amdgcn_fence(__ATOMIC_ACQUIRE, "agent");
            asm volatile("s_waitcnt vmcnt(0)" ::: "memory");
        }
        __syncthreads();
        const float* xp = xch + (size_t)u.pm * 4 * 256 * 40;
        {
            const int rl = tid >> 3, rr = u.pn * 64 + rl, q = tid & 7;
            f32x4 pa[4], pb[4]; f32x2_ st[4], sm[4];
#pragma unroll
            for (int t = 0; t < 4; ++t) { const float* rec = xp + ((size_t)t * 256 + rr) * 40; pa[t] = *(const f32x4*)(rec + 4 * q); st[t] = *(const f32x2_*)(rec + 36);
                pb[t] = (f32x4){0.f, 0.f, 0.f, 0.f}; if (q == 0) pb[t] = *(const f32x4*)(rec + 32);
                sm[t] = (f32x2_){0.f, 0.f}; if (tid < 256) sm[t] = *(const f32x2_*)(xp + ((size_t)t * 256 + tid) * 40 + 36); }
            const f32x4 cs = *(const f32x4*)(rtc + 4 * q), bw = *(const f32x4*)(rtc + 40 + 4 * q), cs8 = *(const f32x4*)(rtc + 32), bw8 = *(const f32x4*)(rtc + 72);
            const f32x2_ sr = ((st[0] + st[1]) + st[2]) + st[3], sq = ((sm[0] + sm[1]) + sm[2]) + sm[3];
            const float mean = sr[0] * (1.f / D_), rstd = rsqrtf(fmaxf(sr[1] * (1.f / D_) - mean * mean, 0.f) + EPS_);
            const f32x4 sa = ((pa[0] + pa[1]) + pa[2]) + pa[3], sb = ((pb[0] + pb[1]) + pb[2]) + pb[3];
            *(LAS f32x4*)(LG + rl * 40 + 4 * q) = (sa - cs * mean) * rstd + bw;
            if (q == 0) *(LAS f32x4*)(LG + rl * 40 + 32) = (sb - cs8 * mean) * rstd + bw8;
            if (tid < 256) { const float mq = sq[0] * (1.f / D_); MS[2 * tid] = mq; MS[2 * tid + 1] = rsqrtf(fmaxf(sq[1] * (1.f / D_) - mq * mq, 0.f) + EPS_); }
        }
        __syncthreads();
        if (tid < 64) { const LAS float* lg = LG + tid * 40;
            const f32x4 gl = *(const LAS f32x4*)lg; float mx = gl[0]; int gi = 0;
#pragma unroll
            for (int i = 1; i < 4; ++i) if (gl[i] > mx) { mx = gl[i]; gi = i; }
            float se = 0.f;
#pragma unroll
            for (int i = 0; i < 4; ++i) se += expf(gl[i] - mx);
            const float pg = 1.0f / se;
            const f32x4 e0 = *(const LAS f32x4*)(lg + 4 + gi * 8), e1 = *(const LAS f32x4*)(lg + 8 + gi * 8);
            float ev[8];
#pragma unroll
            for (int i = 0; i < 4; ++i) { ev[i] = e0[i]; ev[4 + i] = e1[i]; }
            int i0 = 0;
#pragma unroll
            for (int i = 1; i < 8; ++i) if (ev[i] > ev[i0]) i0 = i;
            int i1 = (i0 == 0) ? 1 : 0;
#pragma unroll
            for (int i = 0; i < 8; ++i) if (i != i0 && ev[i] > ev[i1]) i1 = i;
            const float e1x = expf(ev[i1] - ev[i0]); const float w0 = 1.f / (1.f + e1x), w1 = e1x / (1.f + e1x);
            const int ea = gi * 8 + i0, eb = gi * 8 + i1;
            const int ra = atomicAdd((int*)&cntL[ea], 1), rb = atomicAdd((int*)&cntL[eb], 1);
            tokE[tid * 2] = (ea << 16) | ra; tokE[tid * 2 + 1] = (eb << 16) | rb; tokW[tid * 2] = pg * w0; tokW[tid * 2 + 1] = pg * w1;
        }
        __syncthreads();
        int basev = 0;
        if (tid < 32) { const int cl = cntL[tid]; basev = cl ? (int)atomicAdd(&cur[tid * 16], (unsigned)cl) : 0; }
#pragma unroll
        for (int ai = 0; ai < 2; ++ai)
#pragma unroll
            for (int m = 0; m < 4; ++m) { const int rl = ai * HALF + wr * 64 + m * 16 + fr; const float mean = MS[2 * rl], rstd = MS[2 * rl + 1]; const size_t rb = (size_t)(u.pm * BM + rl) * D_ + col0;
#pragma unroll
                for (int bj = 0; bj < 2; ++bj) { const f32x4 y0 = (acc[ai][bj][m][0] - mean) * rstd * gg[bj][0] + bb[bj][0], y1 = (acc[ai][bj][m][1] - mean) * rstd * gg[bj][1] + bb[bj][1];
                    u32x4 o; o.x = cvt_pk_bf16(y0[0], y0[1]); o.y = cvt_pk_bf16(y0[2], y0[3]); o.z = cvt_pk_bf16(y1[0], y1[1]); o.w = cvt_pk_bf16(y1[2], y1[3]);
                    *(u32x4*)(x1b + rb + bj * HALF) = o;
                    u32x2 q8; q8.x = pack4_fp8(y0[0], y0[1], y0[2], y0[3]); q8.y = pack4_fp8(y1[0], y1[1], y1[2], y1[3]); *(u32x2*)(x1q + rb + bj * HALF) = q8; } }
        if (tid < 32) baseL[tid] = basev;
        __syncthreads();
        if (tid < 128) { const int v = tokE[tid]; const int e = v >> 16, r = baseL[e] + (v & 0xffff); const int token = u.pm * BM + u.pn * 64 + (tid >> 1);
            buf_t[(size_t)e * ECAP_ + r] = token; buf_w[(size_t)e * ECAP_ + r] = tokW[tid]; slot_of[token * 2 + (tid & 1)] = (e << 16) | r; }
    }
};
struct EpiSiluMul {
    static constexpr bool PERM = true, MIDSCALE = false, FP8 = true, AFTER_DRAIN = false;
    unsigned char* Hb; unsigned* done;
    DI void operator()(const f32x4 (&acc)[2][2][4][2], const Unit& u, int wr, int wc, int fr, int fq) const {
        const int row0 = u.pm * BM + wr * 64 + fr, hu0 = u.pn * 128 + wc * 32 + 8 * fq;
#pragma unroll
        for (int ai = 0; ai < 2; ++ai)
#pragma unroll
            for (int m = 0; m < 4; ++m) { unsigned char* rowp = Hb + (size_t)(row0 + ai * HALF + m * 16) * DE_ + hu0;
                const f32x4 g0 = acc[ai][0][m][0] * W8_INV, g1 = acc[ai][0][m][1] * W8_INV, u0 = acc[ai][1][m][0] * W8_INV, u1 = acc[ai][1][m][1] * W8_INV;
                const unsigned lo = pack4_fp8(fast_silu(g0[0]) * u0[0], fast_silu(g0[1]) * u0[1], fast_silu(g0[2]) * u0[2], fast_silu(g0[3]) * u0[3]);
                const unsigned hi = pack4_fp8(fast_silu(g1[0]) * u1[0], fast_silu(g1[1]) * u1[1], fast_silu(g1[2]) * u1[2], fast_silu(g1[3]) * u1[3]);
                __hip_atomic_store((unsigned long long*)rowp, ((unsigned long long)hi << 32) | lo, __ATOMIC_RELAXED, __HIP_MEMORY_SCOPE_AGENT); }
        asm volatile("s_waitcnt vmcnt(0)" ::: "memory");
        if (fr == 0 && fq == 0) __hip_atomic_fetch_add(done + 16 * u.pm, 1u, __ATOMIC_RELAXED, __HIP_MEMORY_SCOPE_AGENT);
    }
};
struct EpiDown {
    static constexpr bool PERM = true, MIDSCALE = false, FP8 = true, AFTER_DRAIN = false;
    unsigned char* O; const float* buf_w; const LAS int* cnt;
    DI void operator()(const f32x4 (&acc)[2][2][4][2], const Unit& u, int wr, int wc, int fr, int fq) const {
        const int e = u.aux >> 7, kb = (u.aux & 127) * 256, ce = cnt[e];
        const int rl0 = wr * 64 + fr, col0 = u.pn * BM + wc * 32 + 8 * fq;
#pragma unroll
        for (int ai = 0; ai < 2; ++ai)
#pragma unroll
            for (int m = 0; m < 4; ++m) { const int rl = rl0 + ai * HALF + m * 16; const float sc = (kb + rl < ce) ? buf_w[(size_t)e * ECAP_ + kb + rl] * (W8_INV * YE_SCALE) : 0.f;
                unsigned char* rowp = O + (size_t)(u.pm * BM + rl) * D_ + col0;
#pragma unroll
                for (int bj = 0; bj < 2; ++bj) { const f32x4 v0 = acc[ai][bj][m][0] * sc, v1 = acc[ai][bj][m][1] * sc;
                    u32x2 o; o.x = pack4_fp8(v0[0], v0[1], v0[2], v0[3]); o.y = pack4_fp8(v1[0], v1[1], v1[2], v1[3]);
                    *(u32x2*)(rowp + bj * HALF) = o; } }
    }
};
struct EpiT {
    static constexpr bool PERM = false, MIDSCALE = false, FP8 = false, AFTER_DRAIN = false;
    bf16_t* Tb; float* ssqT;
    DI void operator()(const f32x4 (&acc)[2][2][4][2], const Unit& u, int wr, int wc, int fr, int fq) const {
        const int row0 = u.pm * BM + wr * 64 + fr, col0 = u.pn * BM + wc * 32 + 4 * fq;
#pragma unroll
        for (int ai = 0; ai < 2; ++ai)
#pragma unroll
            for (int m = 0; m < 4; ++m) { const int row = row0 + ai * HALF + m * 16; float ss = 0.f;
#pragma unroll
                for (int bj = 0; bj < 2; ++bj)
#pragma unroll
                    for (int n = 0; n < 2; ++n) { const f32x4 a = acc[ai][bj][m][n]; ss += (a[0] * a[0] + a[1] * a[1]) + (a[2] * a[2] + a[3] * a[3]);
                        u32x2 o; o.x = cvt_pk_bf16(a[0], a[1]); o.y = cvt_pk_bf16(a[2], a[3]); *(u32x2*)(Tb + (size_t)row * D_ + col0 + bj * HALF + n * 16) = o; }
                ss += __shfl_xor(ss, 16); ss += __shfl_xor(ss, 32);
                if (fq == 0) ssqT[(size_t)row * 16 + u.pn * 4 + wc] = ss; }
    }
};
struct EpiPle {
    static constexpr bool PERM = true, MIDSCALE = false, FP8 = false, AFTER_DRAIN = false;
    const bf16_t* x2b; const bf16_t* Tb; const float* rstdT; const float* b_pg; const float* ple_g; float* xout; bf16_t* xb;
    DI void operator()(const f32x4 (&acc)[2][2][4][2], const Unit& u, int wr, int wc, int fr, int fq) const {
        const int row0 = u.pm * BM + wr * 64 + fr, col0 = u.pn * BM + wc * 32 + 8 * fq;
        f32x4 bp[2][2], pg[2][2];
#pragma unroll
        for (int bj = 0; bj < 2; ++bj)
#pragma unroll
            for (int n = 0; n < 2; ++n) { bp[bj][n] = *(const f32x4*)(b_pg + col0 + bj * HALF + 4 * n); pg[bj][n] = *(const f32x4*)(ple_g + col0 + bj * HALF + 4 * n); }
#pragma unroll
        for (int ai = 0; ai < 2; ++ai)
#pragma unroll
            for (int m = 0; m < 4; ++m) { const int row = row0 + ai * HALF + m * 16; const float rstd = rstdT[row];
#pragma unroll
                for (int bj = 0; bj < 2; ++bj) { const size_t o = (size_t)row * D_ + col0 + bj * HALF;
                    const u32x4 xv = *(const u32x4*)(x2b + o), tv = *(const u32x4*)(Tb + o);
                    const f32x4 a0 = acc[ai][bj][m][0], a1 = acc[ai][bj][m][1];
                    f32x4 r0, r1;
                    r0[0] = bflo(xv.x) + fast_sigmoid(a0[0] + bp[bj][0][0]) * bflo(tv.x) * rstd * pg[bj][0][0]; r0[1] = bfhi(xv.x) + fast_sigmoid(a0[1] + bp[bj][0][1]) * bfhi(tv.x) * rstd * pg[bj][0][1];
                    r0[2] = bflo(xv.y) + fast_sigmoid(a0[2] + bp[bj][0][2]) * bflo(tv.y) * rstd * pg[bj][0][2]; r0[3] = bfhi(xv.y) + fast_sigmoid(a0[3] + bp[bj][0][3]) * bfhi(tv.y) * rstd * pg[bj][0][3];
                    r1[0] = bflo(xv.z) + fast_sigmoid(a1[0] + bp[bj][1][0]) * bflo(tv.z) * rstd * pg[bj][1][0]; r1[1] = bfhi(xv.z) + fast_sigmoid(a1[1] + bp[bj][1][1]) * bfhi(tv.z) * rstd * pg[bj][1][1];
                    r1[2] = bflo(xv.w) + fast_sigmoid(a1[2] + bp[bj][1][2]) * bflo(tv.w) * rstd * pg[bj][1][2]; r1[3] = bfhi(xv.w) + fast_sigmoid(a1[3] + bp[bj][1][3]) * bfhi(tv.w) * rstd * pg[bj][1][3];
                    if (xout) { *(f32x4*)(xout + o) = r0; *(f32x4*)(xout + o + 4) = r1; }
                    else { u32x4 ob; ob.x = cvt_pk_bf16(r0[0], r0[1]); ob.y = cvt_pk_bf16(r0[2], r0[3]); ob.z = cvt_pk_bf16(r1[0], r1[1]); ob.w = cvt_pk_bf16(r1[2], r1[3]); *(u32x4*)(xb + o) = ob; } } }
    }
};

struct Ctx { int G, bid, tid, lane, w; };
DI const float* IN(PR p, int i) { return p.in[i]; }
template <class T> DI T* WSP(PR p, size_t off) { return (T*)(p.ws + off); }

struct TJob { const float* src0; const float* src1; bf16_t* dst; int ldw, K, N, mode, nmat, krot, kscale_n, fp8; size_t sstr, dstr, kstr; float scale; const float* kscale; };
DI void transpose_job(const TJob& j, int gwave, int nwaves, LAS float* scr, int lane) {
    const int nkb = j.K / 64, nnb = j.N / 32; const long per = (long)nkb * nnb, total = per * j.nmat;
    for (long it = gwave; it < total; it += nwaves) {
        const int mat = (int)(it / per); const int r = (int)(it % per); const int kb = r / nnb, nb = r % nnb, k0 = kb * 64, n0 = nb * 32;
        const int n = n0 + (lane & 31);
        const float* sp; int col;
        if (j.mode == 2) { const int blk = n >> 7; sp = (const float*)((const char*)j.src0 + (ptrdiff_t)(blk & 1) * ((const char*)j.src1 - (const char*)j.src0)); col = 128 * (blk >> 1) + (n & 127); }
        else { sp = j.src0; col = n + ((j.mode == 1 && n >= 1536) ? 8 : 0); }
        sp += (size_t)mat * j.sstr + col;
#pragma unroll
        for (int i = 0; i < 32; ++i) { const int kk = 2 * i + (lane >> 5); const int kd = k0 + kk; const int ksrc = (kd + j.krot) & (j.K - 1);
            float v = sp[(size_t)ksrc * j.ldw] * j.scale; if (j.kscale && kd < j.kscale_n) v *= j.kscale[(size_t)mat * j.kstr + kd];
            scr[kk * 33 + (lane & 31)] = v; }
        __builtin_amdgcn_s_waitcnt(0xC07F); __builtin_amdgcn_wave_barrier();
        const int c = lane & 7;
        bf16_t* d = j.dst + (size_t)mat * j.dstr;
#pragma unroll
        for (int jj = 0; jj < 4; ++jj) { const int nn = (lane >> 3) + 8 * jj; const LAS float* s = scr + (8 * c) * 33 + nn;
            if (j.fp8) { u32x2 o8; o8.x = pack4_fp8(s[0 * 33], s[1 * 33], s[2 * 33], s[3 * 33]); o8.y = pack4_fp8(s[4 * 33], s[5 * 33], s[6 * 33], s[7 * 33]);
                *(u32x2*)((unsigned char*)j.dst + (size_t)mat * j.dstr + (size_t)(n0 + nn) * j.K + k0 + 8 * c) = o8; }
            else { u32x4 o; o.x = cvt_pk_bf16(s[0 * 33], s[1 * 33]); o.y = cvt_pk_bf16(s[2 * 33], s[3 * 33]); o.z = cvt_pk_bf16(s[4 * 33], s[5 * 33]); o.w = cvt_pk_bf16(s[6 * 33], s[7 * 33]);
                *(u32x4*)(d + (size_t)(n0 + nn) * j.K + k0 + 8 * c) = o; } }
        __builtin_amdgcn_s_waitcnt(0xC07F); __builtin_amdgcn_wave_barrier();
    }
}
DI TJob mk_job(const float* s0, const float* s1, int ldw, int K, int N, bf16_t* dst, int mode, int nmat, size_t sstr, size_t dstr, float scale = 1.f) {
    TJob j; j.src0 = s0; j.src1 = s1; j.dst = dst; j.ldw = ldw; j.K = K; j.N = N; j.mode = mode; j.nmat = nmat; j.krot = 0; j.kscale_n = 0; j.fp8 = 0; j.sstr = sstr; j.dstr = dstr; j.kstr = 0; j.scale = scale; j.kscale = nullptr; return j;
}
DI void cvt_rows(const float* __restrict__ src, bf16_t* __restrict__ dst, size_t n8, size_t gt, size_t nthreads) {
    for (size_t i = gt; i < n8; i += nthreads) { const f32x4 a = ((const f32x4*)src)[2 * i], b = ((const f32x4*)src)[2 * i + 1];
        u32x4 o; o.x = cvt_pk_bf16(a[0], a[1]); o.y = cvt_pk_bf16(a[2], a[3]); o.z = cvt_pk_bf16(b[0], b[1]); o.w = cvt_pk_bf16(b[2], b[3]); ((u32x4*)dst)[i] = o; }
}
DI void moe_weight_jobs(PR p, const Ctx& c, int l, LAS unsigned char* lds, bool probe_dummy = false) {
    LAS float* scr = (LAS float*)(lds + c.w * 8448);
    const int gwave = c.bid * 4 + (c.w - 4), nwaves = c.G * 4;
    { TJob j = mk_job(IN(p, 28) + (size_t)l * NE_ * D_ * DE_, IN(p, 29) + (size_t)l * NE_ * D_ * DE_, DE_, D_, D_, probe_dummy ? WSP<bf16_t>(p, WS_YE) : WSP<bf16_t>(p, WS_WGU), 2, NE_, (size_t)D_ * DE_, (size_t)D_ * D_, W8_SCALE); j.fp8 = 1;
      transpose_job(j, gwave, nwaves, scr, c.lane); }
    { TJob j = mk_job(IN(p, 30) + (size_t)l * NE_ * DE_ * D_, nullptr, D_, DE_, D_, probe_dummy ? WSP<bf16_t>(p, WS_YE) + (size_t)NE_ * D_ * D_ / 2 : WSP<bf16_t>(p, WS_WED), 0, NE_, (size_t)DE_ * D_, (size_t)D_ * DE_, W8_SCALE); j.fp8 = 1;
      transpose_job(j, gwave, nwaves, scr, c.lane); }
}

DI void s5_prep_job(PR p, int lg, LAS unsigned char* lds, int tid) {
    LAS float* apr = (LAS float*)lds;
    LAS float* api = apr + 17 * 64;
    LAS float* bbr = api + 17 * 64;
    LAS float* bbi = bbr + 1024;
    LAS float* ccr = bbi + 1024;
    LAS float* cci = ccr + 16 * 68;
    LAS float* kd = cci + 16 * 68;
    const float* lam_re = IN(p, 10); const float* lam_im = IN(p, 11); const float* b_re = IN(p, 13); const float* b_im = IN(p, 14); const float* c_re = IN(p, 15); const float* c_im = IN(p, 16);
    const float dt = expf(IN(p, 12)[lg]);
    __syncthreads();
    for (int idx = tid; idx < 17 * 64; idx += NT_) { const int pp = idx & 63, d = idx >> 6; const float lr = lam_re[lg * 64 + pp], li = lam_im[lg * 64 + pp];
        const float er = expf((float)d * lr * dt), ang = (float)d * li * dt; apr[d * 64 + pp] = er * cosf(ang); api[d * 64 + pp] = er * sinf(ang); }
    for (int idx = tid; idx < 1024; idx += NT_) { const int pp = idx >> 4, ci = idx & 15; const float lr = lam_re[lg * 64 + pp], li = lam_im[lg * 64 + pp];
        const float er = expf(lr * dt), ar = er * cosf(li * dt), ai = er * sinf(li * dt); const float mag2 = lr * lr + li * li, xr0 = ar - 1.f, xi0 = ai;
        const float cr = (xr0 * lr + xi0 * li) / mag2, cim = (xi0 * lr - xr0 * li) / mag2; const float br = b_re[(size_t)(lg * 64 + pp) * 16 + ci], bi = b_im[(size_t)(lg * 64 + pp) * 16 + ci];
        bbr[pp * 16 + ci] = cr * br - cim * bi; bbi[pp * 16 + ci] = cr * bi + cim * br; }
    for (int idx = tid; idx < 1024; idx += NT_) { ccr[(idx >> 6) * 68 + (idx & 63)] = c_re[(size_t)lg * 1024 + idx]; cci[(idx >> 6) * 68 + (idx & 63)] = c_im[(size_t)lg * 1024 + idx]; }
    __syncthreads();
    {
        const int d = tid >> 5, co = (tid >> 1) & 15, hf = tid & 1; f32x4 v0 = (f32x4){0.f, 0.f, 0.f, 0.f}, v1 = v0;
        for (int pp = 0; pp < 64; ++pp) { const float ar = apr[d * 64 + pp], ai = api[d * 64 + pp], cr = ccr[co * 68 + pp], ci_ = cci[co * 68 + pp];
            const float wr_ = cr * ar - ci_ * ai, wi_ = cr * ai + ci_ * ar;
            const f32x4 r0 = *(const LAS f32x4*)(bbr + pp * 16 + hf * 8), r1 = *(const LAS f32x4*)(bbr + pp * 16 + hf * 8 + 4), i0 = *(const LAS f32x4*)(bbi + pp * 16 + hf * 8), i1 = *(const LAS f32x4*)(bbi + pp * 16 + hf * 8 + 4);
            v0 = v0 + r0 * wr_ - i0 * wi_; v1 = v1 + r1 * wr_ - i1 * wi_; }
        if (d == 0) { const float dsk = IN(p, 17)[lg * 16 + co];
#pragma unroll
            for (int e = 0; e < 4; ++e) { if (co == hf * 8 + e) v0[e] += dsk; if (co == hf * 8 + 4 + e) v1[e] += dsk; } }
        *(LAS f32x4*)(kd + (d * 16 + co) * 16 + hf * 8) = v0; *(LAS f32x4*)(kd + (d * 16 + co) * 16 + hf * 8 + 4) = v1; }
    __syncthreads();
    bf16_t* wy = WSP<bf16_t>(p, WS_WYT) + (size_t)lg * 256 * S5K_;
    for (int idx = tid; idx < 256 * 48; idx += NT_) { const int n = idx / 48, kc = idx % 48, j = n >> 4, co = n & 15; f32x4 v0 = (f32x4){0.f, 0.f, 0.f, 0.f}, v1 = v0;
        if (kc < 32) { const int i = kc >> 1, ci0 = (kc & 1) * 8; if (i <= j) { v0 = *(const LAS f32x4*)(kd + ((j - i) * 16 + co) * 16 + ci0); v1 = *(const LAS f32x4*)(kd + ((j - i) * 16 + co) * 16 + ci0 + 4); } }
        else { const int kk0 = (kc - 32) * 8, pp0 = kk0 & 63;
            const f32x4 c0r = *(const LAS f32x4*)(ccr + co * 68 + pp0), c1r = *(const LAS f32x4*)(ccr + co * 68 + pp0 + 4), c0i = *(const LAS f32x4*)(cci + co * 68 + pp0), c1i = *(const LAS f32x4*)(cci + co * 68 + pp0 + 4);
            const f32x4 a0r = *(const LAS f32x4*)(apr + (j + 1) * 64 + pp0), a1r = *(const LAS f32x4*)(apr + (j + 1) * 64 + pp0 + 4), a0i = *(const LAS f32x4*)(api + (j + 1) * 64 + pp0), a1i = *(const LAS f32x4*)(api + (j + 1) * 64 + pp0 + 4);
            if (kk0 < 64) { v0 = c0r * a0r - c0i * a0i; v1 = c1r * a1r - c1i * a1i; } else { v0 = -(c0r * a0i + c0i * a0r); v1 = -(c1r * a1i + c1i * a1r); } }
        u32x4 o; o.x = cvt_pk_bf16(v0[0], v0[1]); o.y = cvt_pk_bf16(v0[2], v0[3]); o.z = cvt_pk_bf16(v1[0], v1[1]); o.w = cvt_pk_bf16(v1[2], v1[3]);
        *(u32x4*)(wy + (size_t)n * S5K_ + kc * 8) = o; }
    bf16_t* we = WSP<bf16_t>(p, WS_WET) + (size_t)lg * 256 * 256;
    for (int idx = tid; idx < 256 * 32; idx += NT_) { const int n = idx >> 5, kc = idx & 31; f32x4 v0 = (f32x4){0.f, 0.f, 0.f, 0.f}, v1 = v0;
        if (n < 128) { const int pp = n & 63, i = kc >> 1, ci0 = (kc & 1) * 8; const float ar = apr[(15 - i) * 64 + pp], ai = api[(15 - i) * 64 + pp];
            const f32x4 r0 = *(const LAS f32x4*)(bbr + pp * 16 + ci0), r1 = *(const LAS f32x4*)(bbr + pp * 16 + ci0 + 4), i0 = *(const LAS f32x4*)(bbi + pp * 16 + ci0), i1 = *(const LAS f32x4*)(bbi + pp * 16 + ci0 + 4);
            if (n < 64) { v0 = r0 * ar - i0 * ai; v1 = r1 * ar - i1 * ai; } else { v0 = i0 * ar + r0 * ai; v1 = i1 * ar + r1 * ai; } }
        u32x4 o; o.x = cvt_pk_bf16(v0[0], v0[1]); o.y = cvt_pk_bf16(v0[2], v0[3]); o.z = cvt_pk_bf16(v1[0], v1[1]); o.w = cvt_pk_bf16(v1[2], v1[3]);
        *(u32x4*)(we + (size_t)n * 256 + kc * 8) = o; }
    if (tid < 64) { float* A16 = WSP<float>(p, WS_A16); A16[(size_t)lg * 128 + tid] = apr[16 * 64 + tid]; A16[(size_t)lg * 128 + 64 + tid] = api[16 * 64 + tid]; }
}

DI void ph_prologue(PR p, const Ctx& c, LAS unsigned char* lds, int sel = 15) {
    const size_t gt = (size_t)c.bid * NT_ + c.tid, nth = (size_t)c.G * NT_;
    if (sel & 1) {
    cvt_rows(IN(p, 0), WSP<bf16_t>(p, WS_XB), (size_t)M_ * D_ / 8, gt, nth);
    cvt_rows(IN(p, 1), WSP<bf16_t>(p, WS_PBF), (size_t)L_ * M_ * PLE_ / 8, gt, nth);
    }
    if (sel & 2) {
    { bf16_t* wg = WSP<bf16_t>(p, WS_WGATE); const float* w_in = IN(p, 2);
      for (size_t i = gt; i < (size_t)L_ * 16 * D_; i += nth) { const int k = (int)(i % D_), n = (int)((i / D_) % 16), l = (int)(i / (16 * D_));
          wg[i] = (n < 8) ? f2bf(w_in[((size_t)l * D_ + k) * DIN_ + 1536 + n]) : (bf16_t)0; } }
    { bf16_t* ghl = WSP<bf16_t>(p, WS_GHL); const float* w_grp = IN(p, 24); const float* w_rt = IN(p, 26); const float* lng = IN(p, 22);
      for (size_t i = gt; i < (size_t)L_ * 48 * D_; i += nth) { const int k = (int)(i % D_), o = (int)((i / D_) % 48), l = (int)(i / (48 * D_));
          const float gk = lng[(size_t)l * D_ + k];
          const float v = (o < 4) ? w_grp[((size_t)l * D_ + k) * 4 + o] * gk : (o < 36) ? w_rt[((size_t)l * D_ + k) * 32 + (o - 4)] * gk : (o == 36 ? 1.f : 0.f);
          const bf16_t h = f2bf(v); ghl[((size_t)(l * 2) * 48 + o) * D_ + k] = h; ghl[((size_t)(l * 2 + 1) * 48 + o) * D_ + k] = f2bf(v - bf2f(h)); } }
    { float* rtc = WSP<float>(p, WS_RTC); const float* w_grp = IN(p, 24); const float* w_rt = IN(p, 26); const float* lng = IN(p, 22); const float* lnb = IN(p, 23);
      for (int job = c.bid * 8 + c.w; job < L_ * 40; job += c.G * 8) { const int l = job / 40, o = job % 40; float cs = 0.f, bw = 0.f;
          if (o < 36) { for (int k = c.lane; k < D_; k += 64) { const float wv = (o < 4) ? w_grp[((size_t)l * D_ + k) * 4 + o] : w_rt[((size_t)l * D_ + k) * 32 + (o - 4)];
                  cs += wv * lng[(size_t)l * D_ + k]; bw += wv * lnb[(size_t)l * D_ + k]; }
              cs = wave_sum(cs); bw = wave_sum(bw) + ((o < 4) ? IN(p, 25)[l * 4 + o] : IN(p, 27)[l * 32 + o - 4]); }
          if (c.lane == 0) { rtc[(l * 2) * 40 + o] = cs; rtc[(l * 2 + 1) * 40 + o] = bw; } } }
    }
    LAS float* scr = (LAS float*)(lds + c.w * 8448);
    const int gwave = c.bid * 8 + c.w, nwaves = c.G * 8;
    const bool split = (sel == 15) && (c.G >= 2 * L_ * G5_);
    if (split) {
        if (c.bid < L_ * G5_) { s5_prep_job(p, c.bid, lds, c.tid); __syncthreads(); }
        else transpose_job(mk_job(IN(p, 2), nullptr, DIN_, D_, 2048, WSP<bf16_t>(p, WS_WIN), 1, L_, (size_t)D_ * DIN_, (size_t)2048 * D_), (c.bid - L_ * G5_) * 8 + c.w, (c.G - L_ * G5_) * 8, scr, c.lane);
    }
    if (sel & 4) {
    if (!split) transpose_job(mk_job(IN(p, 2), nullptr, DIN_, D_, 2048, WSP<bf16_t>(p, WS_WIN), 1, L_, (size_t)D_ * DIN_, (size_t)2048 * D_), gwave, nwaves, scr, c.lane);
    { TJob j = mk_job(IN(p, 21), nullptr, D_, D_, D_, WSP<bf16_t>(p, WS_WOUT), 0, L_, (size_t)D_ * D_, (size_t)D_ * D_); j.krot = 512; j.kscale = IN(p, 20); j.kscale_n = 512; j.kstr = DM_;
      transpose_job(j, gwave, nwaves, scr, c.lane); }
    transpose_job(mk_job(IN(p, 33), nullptr, D_, D_, D_, WSP<bf16_t>(p, WS_WPG), 0, L_, (size_t)D_ * D_, (size_t)D_ * D_), gwave, nwaves, scr, c.lane);
    transpose_job(mk_job(IN(p, 35), nullptr, D_, PLE_, D_, WSP<bf16_t>(p, WS_WPP), 0, L_, (size_t)PLE_ * D_, (size_t)D_ * PLE_), gwave, nwaves, scr, c.lane);
    transpose_job(mk_job(IN(p, 18), nullptr, DM_, DM_, DM_, WSP<bf16_t>(p, WS_WGLU), 0, L_, (size_t)DM_ * DM_, (size_t)DM_ * DM_), gwave, nwaves, scr, c.lane);
    transpose_job(mk_job(IN(p, 5), nullptr, DH_, DH_, DH_, WSP<bf16_t>(p, WS_WQK), 0, L_ * H_, (size_t)DH_ * DH_, (size_t)256 * DH_), gwave, nwaves, scr, c.lane);
    transpose_job(mk_job(IN(p, 6), nullptr, DH_, DH_, DH_, WSP<bf16_t>(p, WS_WQK) + (size_t)DH_ * DH_, 0, L_ * H_, (size_t)DH_ * DH_, (size_t)256 * DH_, 0.08838834764831845f), gwave, nwaves, scr, c.lane);
    }
    if ((sel & 8) && !split) { for (int job = c.bid; job < L_ * G5_; job += c.G) { s5_prep_job(p, job, lds, c.tid); __syncthreads(); } }
}

DI void ph_inproj(PR p, const Ctx& c, int l, LAS unsigned char* lds) {
    DenseOrder S; S.init(WSP<bf16_t>(p, WS_XB), WSP<bf16_t>(p, WS_WIN) + (size_t)l * 2048 * D_, D_ * 2, D_ * 2, M_, 2048, c.G, c.bid);
    EpiInProj E{WSP<bf16_t>(p, WS_ZB), WSP<bf16_t>(p, WS_AS5)};
    gemm_phase<EpiInProj, DenseOrder>(lds, Gemm{(unsigned)(D_ * 2), (unsigned)(D_ * 2), D_}, S, E);
}

DI void mlstm_sum_unit(PR p, const Ctx& c, int l, int unit, LAS unsigned char* lds) {
    LAS unsigned char* ctile = lds;
    LAS unsigned char* ktile = lds + 32768;
    LAS unsigned char* vtile = lds + 65536;
    LAS float* wsS = (LAS float*)(lds + 98304);
    LAS float* gred = wsS + 256;
    const bf16_t* zb = WSP<bf16_t>(p, WS_ZB); const bf16_t* xb = WSP<bf16_t>(p, WS_XB); const bf16_t* wgate = WSP<bf16_t>(p, WS_WGATE) + (size_t)l * 16 * D_;
    const bf16_t* wqkT = WSP<bf16_t>(p, WS_WQK) + (size_t)l * H_ * 256 * DH_;
    const float* cw = IN(p, 3) + (size_t)l * 4 * DM_; const float* cb = IN(p, 4) + (size_t)l * DM_; const float* b_i = IN(p, 7) + l * H_; const float* b_f = IN(p, 8) + l * H_;
    bf16_t* qb = WSP<bf16_t>(p, WS_QB); bf16_t* kb = WSP<bf16_t>(p, WS_KB); bf16_t* Csum = WSP<bf16_t>(p, WS_CSUM); float* nsum = WSP<float>(p, WS_NSUM);
    float* gG = WSP<float>(p, WS_GG); float* mlG = WSP<float>(p, WS_MLG); float* igG = WSP<float>(p, WS_IGG); float* bcumG = WSP<float>(p, WS_BCUM);
    const int tid = c.tid, lane = c.lane, w = c.w, fr = lane & 15, fq = lane >> 4, hh = w >> 2, wq = w & 3;
    const int b = unit / (S_ / 64), cc = unit % (S_ / 64); const int tok0 = b * S_ + cc * 64;
    __syncthreads();
    {
        f32x4 ga[4];
#pragma unroll
        for (int ms = 0; ms < 4; ++ms) ga[ms] = (f32x4){0.f, 0.f, 0.f, 0.f};
#pragma unroll
        for (int kk = 0; kk < 4; ++kk) { const int ks = 4 * w + kk; const bf16x8 bw = ld_frag_g(wgate + (size_t)fr * D_ + 32 * ks + 8 * fq);
#pragma unroll
            for (int ms = 0; ms < 4; ++ms) { const bf16x8 af = ld_frag_g(xb + (size_t)(tok0 + 16 * ms + fr) * D_ + 32 * ks + 8 * fq); ga[ms] = mfma16(af, bw, ga[ms]); } }
#pragma unroll
        for (int ms = 0; ms < 4; ++ms)
#pragma unroll
            for (int r = 0; r < 4; ++r) gred[(w * 64 + 16 * ms + 4 * fq + r) * 16 + fr] = ga[ms][r];
    }
    __syncthreads();
    if (w < 4) {
        const int h = w; const int tok = tok0 + lane; float ip = 0.f, fp = 0.f;
#pragma unroll
        for (int ww = 0; ww < 8; ++ww) { ip += gred[(ww * 64 + lane) * 16 + h]; fp += gred[(ww * 64 + lane) * 16 + 4 + h]; }
        const float ig = ip + b_i[h]; const float lf = log_sigmoid_(fp + b_f[h]);
        float cum = lf;
#pragma unroll
        for (int o = 1; o < 64; o <<= 1) { const float t = __shfl_up(cum, o); if (lane >= o) cum += t; }
        const float g = __shfl(cum, 63); const float a = g - cum + ig;
        float mx = a;
#pragma unroll
        for (int o = 32; o > 0; o >>= 1) mx = fmaxf(mx, __shfl_xor(mx, o));
        wsS[h * 64 + lane] = __expf(a - mx);
        igG[(size_t)tok * 4 + h] = ig; bcumG[(size_t)tok * 4 + h] = cum;
        if (lane == 0) { gG[(b * H_ + h) * 32 + cc] = g; mlG[(b * H_ + h) * 32 + cc] = mx; }
    }
    for (int rd = 0; rd < 2; ++rd) {
        for (int it = tid; it < 2048; it += NT_) { const int hq = it >> 10, sr = (it >> 4) & 63, cg = it & 15; const int t = cc * 64 + sr; const int ch0 = (2 * rd + hq) * DH_ + cg * 8;
            float a[8];
#pragma unroll
            for (int e = 0; e < 8; ++e) a[e] = cb[ch0 + e];
#pragma unroll
            for (int j = 0; j < 4; ++j) { if (t - 3 + j >= 0) { const u32x4 uv = *(const u32x4*)(zb + (size_t)(tok0 + sr - 3 + j) * ZLD_ + ch0);
                    const float* wj = cw + j * DM_ + ch0;
                    a[0] += wj[0] * bflo(uv.x); a[1] += wj[1] * bfhi(uv.x); a[2] += wj[2] * bflo(uv.y); a[3] += wj[3] * bfhi(uv.y);
                    a[4] += wj[4] * bflo(uv.z); a[5] += wj[5] * bfhi(uv.z); a[6] += wj[6] * bflo(uv.w); a[7] += wj[7] * bfhi(uv.w); } }
            u32x4 o; o.x = cvt_pk_bf16(fast_silu(a[0]), fast_silu(a[1])); o.y = cvt_pk_bf16(fast_silu(a[2]), fast_silu(a[3])); o.z = cvt_pk_bf16(fast_silu(a[4]), fast_silu(a[5])); o.w = cvt_pk_bf16(fast_silu(a[6]), fast_silu(a[7]));
            *(LAS u32x4*)(ctile + hq * 16384 + off_b(sr, cg)) = o;
            *(LAS u32x4*)(vtile + hq * 16384 + off_b(sr, cg)) = *(const u32x4*)(zb + (size_t)(tok0 + sr) * ZLD_ + 512 + ch0);
        }
        __syncthreads();
        const int h = 2 * rd + hh;
        const LAS unsigned char* ct = ctile + hh * 16384; LAS unsigned char* kt = ktile + hh * 16384; const LAS unsigned char* vt = vtile + hh * 16384;
        {
            f32x4 acc[4][4];
#pragma unroll
            for (int ms = 0; ms < 4; ++ms)
#pragma unroll
                for (int i = 0; i < 4; ++i) acc[ms][i] = (f32x4){0.f, 0.f, 0.f, 0.f};
#pragma unroll
            for (int ks = 0; ks < 4; ++ks) {
                bf16x8 wf[4];
#pragma unroll
                for (int i = 0; i < 4; ++i) wf[i] = ld_frag_g(wqkT + ((size_t)(h * 256 + 16 * (4 * wq + i) + fr)) * DH_ + 32 * ks + 8 * fq);
#pragma unroll
                for (int ms = 0; ms < 4; ++ms) { const bf16x8 cf = tile_row_read(ct, lane, ms, ks);
#pragma unroll
                    for (int i = 0; i < 4; ++i) acc[ms][i] = mfma16(wf[i], cf, acc[ms][i]); }
            }
#pragma unroll
            for (int ms = 0; ms < 4; ++ms) { const int sr = 16 * ms + fr; const float wsv = wsS[h * 64 + sr];
#pragma unroll
                for (int i = 0; i < 4; ++i) { const int nf = 4 * wq + i; const f32x4 v = acc[ms][i];
                    u32x2 o; o.x = cvt_pk_bf16(v[0], v[1]); o.y = cvt_pk_bf16(v[2], v[3]);
                    if (nf < 8) *(u32x2*)(qb + (size_t)(tok0 + sr) * DM_ + h * DH_ + 16 * nf + 4 * fq) = o;
                    else { const int col = 16 * (nf - 8) + 4 * fq; *(u32x2*)(kb + (size_t)(tok0 + sr) * DM_ + h * DH_ + col) = o;
                        u32x2 o2; o2.x = cvt_pk_bf16(v[0] * wsv, v[1] * wsv); o2.y = cvt_pk_bf16(v[2] * wsv, v[3] * wsv);
                        *(LAS u32x2*)(kt + off_b(sr, col >> 3) + 2 * (col & 7)) = o2; } } }
        }
        __syncthreads();
        {
            f32x4 acc[2][8];
#pragma unroll
            for (int i = 0; i < 2; ++i)
#pragma unroll
                for (int nd = 0; nd < 8; ++nd) acc[i][nd] = (f32x4){0.f, 0.f, 0.f, 0.f};
#pragma unroll
            for (int ks = 0; ks < 2; ++ks) {
                s16x4 va[2][2], kbq[8][2];
                tile_tr_read4(tr_addr(vt, lane, 32 * ks + 8 * fq, 2 * wq), tr_addr(vt, lane, 32 * ks + 8 * fq + 4, 2 * wq), tr_addr(vt, lane, 32 * ks + 8 * fq, 2 * wq + 1), tr_addr(vt, lane, 32 * ks + 8 * fq + 4, 2 * wq + 1),
                              va[0][0], va[0][1], va[1][0], va[1][1]);
#pragma unroll
                for (int nd = 0; nd < 8; nd += 2)
                    tile_tr_read4(tr_addr(kt, lane, 32 * ks + 8 * fq, nd), tr_addr(kt, lane, 32 * ks + 8 * fq + 4, nd), tr_addr(kt, lane, 32 * ks + 8 * fq, nd + 1), tr_addr(kt, lane, 32 * ks + 8 * fq + 4, nd + 1),
                                  kbq[nd][0], kbq[nd][1], kbq[nd + 1][0], kbq[nd + 1][1]);
#pragma unroll
                for (int nd = 0; nd < 8; ++nd) { const bf16x8 kf = cat8(kbq[nd][0], kbq[nd][1]);
#pragma unroll
                    for (int i = 0; i < 2; ++i) acc[i][nd] = mfma16(kf, cat8(va[i][0], va[i][1]), acc[i][nd]); }
            }
            bf16_t* Cp = Csum + ((size_t)((b * H_ + h) * 32 + cc)) * DH_ * DH_;
#pragma unroll
            for (int i = 0; i < 2; ++i)
#pragma unroll
                for (int nd = 0; nd < 8; ++nd) { u32x2 o; o.x = cvt_pk_bf16(acc[i][nd][0], acc[i][nd][1]); o.y = cvt_pk_bf16(acc[i][nd][2], acc[i][nd][3]); *(u32x2*)(Cp + (size_t)(16 * (2 * wq + i) + fr) * DH_ + 16 * nd + 4 * fq) = o; }
            if ((tid & 255) < DH_) { float sacc = 0.f; const int d = tid & 255;
                for (int sr = 0; sr < 64; ++sr) sacc += bf2f(*(const LAS bf16_t*)(kt + off_b(sr, d >> 3) + 2 * (d & 7)));
                nsum[((size_t)((b * H_ + h) * 32 + cc)) * DH_ + d] = sacc; }
        }
        __syncthreads();
    }
}
DI void ph_mix1(PR p, const Ctx& c, int l, LAS unsigned char* lds) {
    for (int unit = c.bid; unit < NB_ * (S_ / 64); unit += c.G) mlstm_sum_unit(p, c, l, unit, lds);
    __syncthreads();
    GroupOrder S; S.A = (const char*)WSP<bf16_t>(p, WS_AS5); S.B = (const char*)(WSP<bf16_t>(p, WS_WET) + (size_t)l * G5_ * 256 * 256); S.astride = (size_t)S5R_ * S5K_ * 2; S.bstride = (size_t)256 * 256 * 2;
    S.lda = S5K_ * 2; S.nunits = G5_ * 4; S.G = c.G; S.c = (c.bid + c.G / 2) % c.G;
    EpiS5E E{WSP<bf16_t>(p, WS_ESUM)};
    gemm_phase<EpiS5E, GroupOrder>(lds, Gemm{(unsigned)(S5K_ * 2), 512u, 256}, S, E);
}

DI void ph_scan(PR p, const Ctx& c, int l, LAS unsigned char* lds) {
    const bf16_t* Csum = WSP<bf16_t>(p, WS_CSUM); const float* nsum = WSP<float>(p, WS_NSUM); const float* gG = WSP<float>(p, WS_GG); const float* mlG = WSP<float>(p, WS_MLG);
    bf16_t* CprevT = WSP<bf16_t>(p, WS_CPREV); float* nprev = WSP<float>(p, WS_NPREV); float* mprev = WSP<float>(p, WS_MPREV);
    const bf16_t* Esum = WSP<bf16_t>(p, WS_ESUM); const float* A16 = WSP<float>(p, WS_A16) + (size_t)l * G5_ * 128; bf16_t* AS5 = WSP<bf16_t>(p, WS_AS5);
    constexpr int NC1 = NB_ * H_ * DH_ * (DH_ / 4), NC2 = NC1 + NB_ * H_ * DH_, NC3 = NC2 + NB_ * G5_ * P5_;
    if (c.w < 4) for (int gid = c.bid * 256 + c.tid; gid < NC3; gid += c.G * 256) {
        if (gid < NC1) {
            const int bh = gid / (DH_ * DH_ / 4), r = gid % (DH_ * DH_ / 4);
            f32x4 C = (f32x4){0.f, 0.f, 0.f, 0.f}; float m = 0.f;
            const size_t base0 = ((size_t)bh * 32) * DH_ * DH_ + (size_t)r * 4;
#pragma unroll 1
            for (int c8 = 0; c8 < 32; c8 += 8) {
                f32x4 cv[8]; float gv[8], mv[8];
#pragma unroll
                for (int k = 0; k < 8; ++k) { const u32x2 cq = *(const u32x2*)(Csum + base0 + (size_t)(c8 + k) * DH_ * DH_); cv[k] = (f32x4){bflo(cq.x), bfhi(cq.x), bflo(cq.y), bfhi(cq.y)}; gv[k] = gG[bh * 32 + c8 + k]; mv[k] = mlG[bh * 32 + c8 + k]; }
#pragma unroll
                for (int k = 0; k < 8; ++k) {
                    u32x2 o; o.x = cvt_pk_bf16(C[0], C[1]); o.y = cvt_pk_bf16(C[2], C[3]); *(u32x2*)(CprevT + base0 + (size_t)(c8 + k) * DH_ * DH_) = o;
                    if (r == 0) mprev[bh * 32 + c8 + k] = m;
                    const float mn = fmaxf(gv[k] + m, mv[k]), so = __expf(gv[k] + m - mn), sn = __expf(mv[k] - mn);
                    C = C * so + cv[k] * sn; m = mn;
                }
            }
        } else if (gid < NC2) {
            const int i = gid - NC1; const int bh = i / DH_, d = i % DH_;
            float n = 0.f, m = 0.f;
#pragma unroll 1
            for (int c8 = 0; c8 < 32; c8 += 8) {
                float nv[8], gv[8], mv[8];
#pragma unroll
                for (int k = 0; k < 8; ++k) { nv[k] = nsum[(size_t)(bh * 32 + c8 + k) * DH_ + d]; gv[k] = gG[bh * 32 + c8 + k]; mv[k] = mlG[bh * 32 + c8 + k]; }
#pragma unroll
                for (int k = 0; k < 8; ++k) {
                    nprev[(size_t)(bh * 32 + c8 + k) * DH_ + d] = n;
                    const float mn = fmaxf(gv[k] + m, mv[k]), so = __expf(gv[k] + m - mn), sn = __expf(mv[k] - mn);
                    n = so * n + sn * nv[k]; m = mn;
                }
            }
        } else {
            const int i = gid - NC2; const int pp = i & 63, g = (i >> 6) & 31, b = i >> 11;
            const float ar = A16[(size_t)g * 128 + pp], ai = A16[(size_t)g * 128 + 64 + pp];
            float xr = 0.f, xi = 0.f;
            const size_t row0 = (size_t)g * S5R_ + b * (S_ / 16);
#pragma unroll 1
            for (int c16 = 0; c16 < S_ / 16; c16 += 16) {
                float er[16], ei[16];
#pragma unroll
                for (int k = 0; k < 16; ++k) { er[k] = bf2f(Esum[(row0 + c16 + k) * 128 + pp]); ei[k] = bf2f(Esum[(row0 + c16 + k) * 128 + 64 + pp]); }
#pragma unroll
                for (int k = 0; k < 16; ++k) { const size_t row = row0 + c16 + k;
                    AS5[row * S5K_ + 256 + pp] = f2bf(xr); AS5[row * S5K_ + 320 + pp] = f2bf(xi);
                    const float nr = ar * xr - ai * xi + er[k], ni = ar * xi + ai * xr + ei[k]; xr = nr; xi = ni; }
            }
        }
    }
    else { moe_weight_jobs(p, c, l, lds); if (MK_REP == 97) moe_weight_jobs(p, c, (l + 2) & 3, lds, true); }
    if (MK_REP == 98) { const size_t gt = (size_t)c.bid * NT_ + c.tid, nth = (size_t)c.G * NT_; bf16_t* dmy = WSP<bf16_t>(p, WS_HB);
        cvt_rows(IN(p, 28) + (size_t)l * NE_ * D_ * DE_, dmy, (size_t)NE_ * D_ * DE_ / 8, gt, nth); cvt_rows(IN(p, 29) + (size_t)l * NE_ * D_ * DE_, dmy + (size_t)NE_ * D_ * DE_, (size_t)NE_ * D_ * DE_ / 8, gt, nth);
        cvt_rows(IN(p, 30) + (size_t)l * NE_ * DE_ * D_, dmy + (size_t)2 * NE_ * D_ * DE_, (size_t)NE_ * DE_ * D_ / 8, gt, nth); }
}

DI void mlstm_out_unit(PR p, const Ctx& c, int l, int unit, LAS unsigned char* lds) {
    LAS unsigned char* vt0 = lds;
    LAS unsigned char* kt0 = lds + 32768;
    LAS unsigned char* ct0 = lds + 65536;
    LAS float* RT = (LAS float*)(lds + 131072);
    LAS float* CT = RT + 128;
    LAS float* INr = CT + 128;
    LAS float* EM = INr + 128;
    LAS float* NP = EM + 128;
    const bf16_t* zb = WSP<bf16_t>(p, WS_ZB); const bf16_t* qb = WSP<bf16_t>(p, WS_QB); const bf16_t* kb = WSP<bf16_t>(p, WS_KB); const bf16_t* CprevT = WSP<bf16_t>(p, WS_CPREV);
    const float* nprev = WSP<float>(p, WS_NPREV); const float* mprev = WSP<float>(p, WS_MPREV); const float* igG = WSP<float>(p, WS_IGG); const float* bcumG = WSP<float>(p, WS_BCUM);
    const float* mh_g = IN(p, 9) + (size_t)l * DM_; bf16_t* yb = WSP<bf16_t>(p, WS_YB);
    const int tid = c.tid, lane = c.lane, w = c.w, fr = lane & 15, fq = lane >> 4, hh = w >> 2, nt = w & 3;
    const int b = unit / (S_ / 64), cc = unit % (S_ / 64); const int tok0 = b * S_ + cc * 64;
    for (int rd = 0; rd < 2; ++rd) {
        __syncthreads();
        for (int it = tid; it < 2048; it += NT_) { const int hq = it >> 10, sr = (it >> 4) & 63, cg = it & 15; const int h = 2 * rd + hq;
            *(LAS u32x4*)(vt0 + hq * 16384 + off_b(sr, cg)) = *(const u32x4*)(zb + (size_t)(tok0 + sr) * ZLD_ + 512 + h * DH_ + cg * 8);
            *(LAS u32x4*)(kt0 + hq * 16384 + off_b(sr, cg)) = *(const u32x4*)(kb + (size_t)(tok0 + sr) * DM_ + h * DH_ + cg * 8); }
        for (int it = tid; it < 4096; it += NT_) { const int hq = it >> 11, er = (it >> 4) & 127, cg = it & 15; const int bh = b * H_ + 2 * rd + hq;
            *(LAS u32x4*)(ct0 + hq * 32768 + off_b(er, cg)) = *(const u32x4*)(CprevT + ((size_t)(bh * 32 + cc) * DH_ + er) * DH_ + cg * 8); }
        if (w < 2) { const int h = 2 * rd + w; const int tok = tok0 + lane; const int bh = b * H_ + h;
            const float ig = igG[(size_t)tok * 4 + h], bc = bcumG[(size_t)tok * 4 + h]; const float rt = ig - bc;
            float pm = rt;
#pragma unroll
            for (int o = 1; o < 64; o <<= 1) { const float t = __shfl_up(pm, o); if (lane >= o) pm = fmaxf(pm, t); }
            const float mp = mprev[bh * 32 + cc]; const float li = bc + mp; const float mt = fmaxf(li, bc + pm);
            RT[w * 64 + lane] = rt; CT[w * 64 + lane] = bc - mt; INr[w * 64 + lane] = __expf(li - mt); EM[w * 64 + lane] = __expf(-mt);
            NP[w * 128 + lane] = nprev[(size_t)(bh * 32 + cc) * DH_ + lane]; NP[w * 128 + 64 + lane] = nprev[(size_t)(bh * 32 + cc) * DH_ + 64 + lane];
        }
        __syncthreads();
        {
            const int h = 2 * rd + hh; const LAS unsigned char* vt = vt0 + hh * 16384; const LAS unsigned char* kt = kt0 + hh * 16384; const LAS unsigned char* ct = ct0 + hh * 32768;
            const int trow = 16 * nt + fr;
            bf16x8 qf[4];
#pragma unroll
            for (int ks = 0; ks < 4; ++ks) qf[ks] = ld_frag_g(qb + (size_t)(tok0 + trow) * DM_ + h * DH_ + 32 * ks + 8 * fq);
            f32x4 Sf[4];
#pragma unroll
            for (int ms = 0; ms < 4; ++ms) { Sf[ms] = (f32x4){0.f, 0.f, 0.f, 0.f};
                if (ms <= nt) {
#pragma unroll
                    for (int ks = 0; ks < 4; ++ks) Sf[ms] = mfma16(tile_row_read(kt, lane, ms, ks), qf[ks], Sf[ms]);
                } }
            const float ct_ = CT[hh * 64 + trow];
            float dsum = 0.f;
#pragma unroll
            for (int ms = 0; ms < 4; ++ms)
#pragma unroll
                for (int r = 0; r < 4; ++r) { const int sr = 16 * ms + 4 * fq + r; float v = 0.f;
                    if (ms <= nt && sr <= trow) v = Sf[ms][r] * __expf(RT[hh * 64 + sr] + ct_);
                    Sf[ms][r] = v; dsum += v; }
            dsum += __shfl_xor(dsum, 16); dsum += __shfl_xor(dsum, 32);
            float qn = 0.f;
#pragma unroll
            for (int ks = 0; ks < 4; ++ks)
#pragma unroll
                for (int j = 0; j < 8; ++j) qn += bf2f((bf16_t)qf[ks][j]) * NP[hh * 128 + 32 * ks + 8 * fq + j];
            qn += __shfl_xor(qn, 16); qn += __shfl_xor(qn, 32);
            const float inter = INr[hh * 64 + trow];
            float den = dsum + inter * qn; den = fmaxf(fabsf(den), EM[hh * 64 + trow]); const float rden = __builtin_amdgcn_rcpf(den);
            bf16x8 Pf[2];
#pragma unroll
            for (int k2 = 0; k2 < 2; ++k2) { u32x4 pk; pk.x = cvt_pk_bf16(Sf[2 * k2][0], Sf[2 * k2][1]); pk.y = cvt_pk_bf16(Sf[2 * k2][2], Sf[2 * k2][3]);
                pk.z = cvt_pk_bf16(Sf[2 * k2 + 1][0], Sf[2 * k2 + 1][1]); pk.w = cvt_pk_bf16(Sf[2 * k2 + 1][2], Sf[2 * k2 + 1][3]); Pf[k2] = __builtin_bit_cast(bf16x8, pk); }
            float hv[8][4]; float ssum = 0.f;
#pragma unroll
            for (int me = 0; me < 8; ++me) {
                f32x4 a1 = (f32x4){0.f, 0.f, 0.f, 0.f}, a2 = (f32x4){0.f, 0.f, 0.f, 0.f};
                s16x4 v0, v1, v2, v3;
                tile_tr_read4(tr_addr(vt, lane, 4 * fq, me), tr_addr(vt, lane, 16 + 4 * fq, me), tr_addr(vt, lane, 32 + 4 * fq, me), tr_addr(vt, lane, 48 + 4 * fq, me), v0, v1, v2, v3);
#pragma unroll
                for (int ks = 0; ks < 4; ++ks) a2 = mfma16(tile_row_read(ct, lane, me, ks), qf[ks], a2);
                a1 = mfma16(cat8(v0, v1), Pf[0], a1);
                if (nt >= 2) a1 = mfma16(cat8(v2, v3), Pf[1], a1);
                const u32x2 og = *(const u32x2*)(zb + (size_t)(tok0 + trow) * ZLD_ + 1024 + h * DH_ + 16 * me + 4 * fq);
                hv[me][0] = (a1[0] + inter * a2[0]) * rden * fast_sigmoid(bflo(og.x)); hv[me][1] = (a1[1] + inter * a2[1]) * rden * fast_sigmoid(bfhi(og.x));
                hv[me][2] = (a1[2] + inter * a2[2]) * rden * fast_sigmoid(bflo(og.y)); hv[me][3] = (a1[3] + inter * a2[3]) * rden * fast_sigmoid(bfhi(og.y));
                ssum += (hv[me][0] + hv[me][1]) + (hv[me][2] + hv[me][3]);
            }
            ssum += __shfl_xor(ssum, 16); ssum += __shfl_xor(ssum, 32);
            const float mu = ssum * (1.f / DH_); float qv = 0.f;
#pragma unroll
            for (int me = 0; me < 8; ++me)
#pragma unroll
                for (int r = 0; r < 4; ++r) { const float d0 = hv[me][r] - mu; qv += d0 * d0; }
            qv += __shfl_xor(qv, 16); qv += __shfl_xor(qv, 32);
            const float rstd = rsqrtf(qv * (1.f / DH_) + EPS_);
#pragma unroll
            for (int me = 0; me < 8; ++me) { const int e0 = h * DH_ + 16 * me + 4 * fq; const f32x4 gg = *(const f32x4*)(mh_g + e0);
                u32x2 o; o.x = cvt_pk_bf16((hv[me][0] - mu) * rstd * gg[0], (hv[me][1] - mu) * rstd * gg[1]); o.y = cvt_pk_bf16((hv[me][2] - mu) * rstd * gg[2], (hv[me][3] - mu) * rstd * gg[3]);
                *(u32x2*)(yb + (size_t)(tok0 + trow) * D_ + DM_ + e0) = o; }
        }
    }
}
DI void ph_mix2(PR p, const Ctx& c, int l, LAS unsigned char* lds) {
    for (int unit = c.bid; unit < NB_ * (S_ / 64); unit += c.G) mlstm_out_unit(p, c, l, unit, lds);
    __syncthreads();
    GroupOrder S; S.A = (const char*)WSP<bf16_t>(p, WS_AS5); S.B = (const char*)(WSP<bf16_t>(p, WS_WYT) + (size_t)l * G5_ * 256 * S5K_); S.astride = (size_t)S5R_ * S5K_ * 2; S.bstride = (size_t)256 * S5K_ * 2;
    S.lda = S5K_ * 2; S.nunits = G5_ * 4; S.G = c.G; S.c = (c.bid + c.G / 2) % c.G;
    EpiS5Y E{WSP<bf16_t>(p, WS_GYB)};
    gemm_phase<EpiS5Y, GroupOrder>(lds, Gemm{(unsigned)(S5K_ * 2), (unsigned)(S5K_ * 2), S5K_}, S, E);
}

DI void ph_glu(PR p, const Ctx& c, int l, LAS unsigned char* lds) {
    const int hg = c.G / 2;
    if (c.bid < hg) {
        DenseOrder S; S.init(WSP<bf16_t>(p, WS_GYB), WSP<bf16_t>(p, WS_WGLU) + (size_t)l * DM_ * DM_, DM_ * 2, DM_ * 2, M_, DM_, hg, c.bid);
        EpiGlu E{WSP<bf16_t>(p, WS_GYB), IN(p, 19) + (size_t)l * DM_, WSP<bf16_t>(p, WS_YB), WSP<float>(p, WS_SSQS)};
        gemm_phase<EpiGlu, DenseOrder>(lds, Gemm{(unsigned)(DM_ * 2), (unsigned)(DM_ * 2), DM_}, S, E);
    } else {
        DenseOrder S2; S2.init(WSP<bf16_t>(p, WS_PBF) + (size_t)l * M_ * PLE_, WSP<bf16_t>(p, WS_WPP) + (size_t)l * D_ * PLE_, PLE_ * 2, PLE_ * 2, M_, D_, c.G - hg, c.bid - hg);
        EpiT E2{WSP<bf16_t>(p, WS_TB), WSP<float>(p, WS_SSQT)};
        gemm_phase<EpiT, DenseOrder>(lds, Gemm{(unsigned)(PLE_ * 2), (unsigned)(PLE_ * 2), PLE_}, S2, E2);
    }
}
DI void ph_outproj(PR p, const Ctx& c, int l, LAS unsigned char* lds) {
    DenseOrder S; S.init(WSP<bf16_t>(p, WS_YB), WSP<bf16_t>(p, WS_WOUT) + (size_t)l * D_ * D_, D_ * 2, D_ * 2, M_, D_, c.G, c.bid);
    EpiOutLn E{WSP<bf16_t>(p, WS_XB), WSP<float>(p, WS_SSQS), WSP<bf16_t>(p, WS_GHL) + (size_t)l * 2 * 48 * D_, WSP<float>(p, WS_RTC) + l * 80, IN(p, 22) + (size_t)l * D_, IN(p, 23) + (size_t)l * D_,
               WSP<float>(p, WS_XCH), WSP<unsigned>(p, WS_LNC) + (size_t)l * 64 * 16, WSP<bf16_t>(p, WS_X1B), WSP<unsigned char>(p, WS_X1Q),
               WSP<unsigned>(p, WS_CUR) + (size_t)l * NE_ * 16, WSP<int>(p, WS_BUFT), WSP<float>(p, WS_BUFW), WSP<int>(p, WS_SLOT)};
    gemm_phase<EpiOutLn, DenseOrder>(lds, Gemm{(unsigned)(D_ * 2), (unsigned)(D_ * 2), D_}, S, E);
}
DI void ph_route(PR p, const Ctx& c, int l, LAS unsigned char* lds, bool dry = false) {
    LAS int* cntL = (LAS int*)lds; LAS int* baseL = cntL + 32; LAS int* tokE = baseL + 32; LAS float* tokW = (LAS float*)(tokE + 128);
    const float* logits = WSP<float>(p, WS_LOGIT);
    unsigned* cur = WSP<unsigned>(p, WS_CUR) + (size_t)(l + (dry ? L_ : 0)) * NE_ * 16; int* buf_t = WSP<int>(p, WS_BUFT); float* buf_w = WSP<float>(p, WS_BUFW); int* slot_of = WSP<int>(p, WS_SLOT);
    const int tid = c.tid;
    __syncthreads();
    if (tid < 32) cntL[tid] = 0;
    __syncthreads();
    for (int unit = c.bid; unit < M_ / 64; unit += c.G) {
        if (tid < 64) { const float* lg = logits + (size_t)(unit * 64 + tid) * 40;
            const f32x4 gl = *(const f32x4*)lg; float mx = gl[0]; int gi = 0;
#pragma unroll
            for (int i = 1; i < 4; ++i) if (gl[i] > mx) { mx = gl[i]; gi = i; }
            float se = 0.f;
#pragma unroll
            for (int i = 0; i < 4; ++i) se += expf(gl[i] - mx);
            const float pg = 1.0f / se;
            const f32x4 e0 = *(const f32x4*)(lg + 4 + gi * 8), e1 = *(const f32x4*)(lg + 8 + gi * 8);
            float ev[8];
#pragma unroll
            for (int i = 0; i < 4; ++i) { ev[i] = e0[i]; ev[4 + i] = e1[i]; }
            int i0 = 0;
#pragma unroll
            for (int i = 1; i < 8; ++i) if (ev[i] > ev[i0]) i0 = i;
            int i1 = (i0 == 0) ? 1 : 0;
#pragma unroll
            for (int i = 0; i < 8; ++i) if (i != i0 && ev[i] > ev[i1]) i1 = i;
            const float e1x = expf(ev[i1] - ev[i0]); const float w0 = 1.f / (1.f + e1x), w1 = e1x / (1.f + e1x);
            const int ea = gi * 8 + i0, eb = gi * 8 + i1;
            const int ra = atomicAdd((int*)&cntL[ea], 1), rb = atomicAdd((int*)&cntL[eb], 1);
            tokE[tid * 2] = (ea << 16) | ra; tokE[tid * 2 + 1] = (eb << 16) | rb; tokW[tid * 2] = pg * w0; tokW[tid * 2 + 1] = pg * w1;
        }
        __syncthreads();
        if (tid < 32) baseL[tid] = cntL[tid] ? (int)atomicAdd(&cur[tid * 16], (unsigned)cntL[tid]) : 0;
        __syncthreads();
        if (tid < 128 && !dry) { const int v = tokE[tid]; const int e = v >> 16, r = baseL[e] + (v & 0xffff); const int token = unit * 64 + (tid >> 1);
            buf_t[(size_t)e * ECAP_ + r] = token; buf_w[(size_t)e * ECAP_ + r] = tokW[tid]; slot_of[token * 2 + (tid & 1)] = (e << 16) | r; }
        __syncthreads();
        if (tid < 32) cntL[tid] = 0;
        __syncthreads();
    }
}

DI void treduce16(float (&a)[16], int lane) {
#pragma unroll
    for (int i = 0; i < 8; ++i) { const bool hi = lane & 32; const float send = hi ? a[i] : a[i + 8], keep = hi ? a[i + 8] : a[i]; a[i] = keep + __shfl_xor(send, 32); }
#pragma unroll
    for (int i = 0; i < 4; ++i) { const bool hi = lane & 16; const float send = hi ? a[i] : a[i + 4], keep = hi ? a[i + 4] : a[i]; a[i] = keep + __shfl_xor(send, 16); }
#pragma unroll
    for (int i = 0; i < 2; ++i) { const bool hi = lane & 8; const float send = hi ? a[i] : a[i + 2], keep = hi ? a[i + 2] : a[i]; a[i] = keep + __shfl_xor(send, 8); }
    { const bool hi = lane & 4; const float send = hi ? a[0] : a[1], keep = hi ? a[1] : a[0]; a[0] = keep + __shfl_xor(send, 4); }
    a[0] += __shfl_xor(a[0], 2); a[0] += __shfl_xor(a[0], 1);
}
DI void ph_router(PR p, const Ctx& c, int l, LAS unsigned char* lds, bool dry = false) {
    LAS float* W = (LAS float*)lds;
    LAS float* LG = (LAS float*)(lds + 147456);
    LAS int* cntL = (LAS int*)(lds + 147456 + 9216);
    LAS int* baseL = cntL + 32;
    LAS int* tokE = baseL + 32;
    LAS float* tokW = (LAS float*)(tokE + 128);
    const float* b_grp = IN(p, 25) + l * 4; const float* b_rt = IN(p, 27) + l * 32;
    const float* ln_g = IN(p, 22) + (size_t)l * D_; const float* ln_b = IN(p, 23) + (size_t)l * D_;
    const bf16_t* r1 = WSP<bf16_t>(p, WS_X2B); bf16_t* x1b = WSP<bf16_t>(p, WS_X1B); unsigned char* x1q = WSP<unsigned char>(p, WS_X1Q);
    unsigned* cur = WSP<unsigned>(p, WS_CUR) + (size_t)(l + (dry ? L_ : 0)) * NE_ * 16; int* buf_t = WSP<int>(p, WS_BUFT); float* buf_w = WSP<float>(p, WS_BUFW); int* slot_of = WSP<int>(p, WS_SLOT);
    const int tid = c.tid, lane = c.lane, w = c.w;
    __syncthreads();
    { const f32x4* wsrc = (const f32x4*)(WSP<float>(p, WS_WRT) + (size_t)l * 36 * D_); for (int idx = tid; idx < 36 * D_ / 4; idx += NT_) ((LAS f32x4*)W)[idx] = wsrc[idx]; }
    if (tid < 32) cntL[tid] = 0;
    __syncthreads();
    for (int unit = c.bid; unit < M_ / 64; unit += c.G) {
#pragma unroll 1
        for (int half = 0; half < 2; ++half) {
        const int tokb = unit * 64 + w * 8 + half * 4;
        f32x4 xv[4][4];
#pragma unroll
        for (int tk = 0; tk < 4; ++tk) { const bf16_t* rin = r1 + (size_t)(tokb + tk) * D_; float s = 0.f;
#pragma unroll
            for (int j = 0; j < 4; ++j) { const u32x2 rv = ((const u32x2*)rin)[lane + 64 * j]; xv[tk][j] = (f32x4){bflo(rv.x), bfhi(rv.x), bflo(rv.y), bfhi(rv.y)}; s += (xv[tk][j][0] + xv[tk][j][1]) + (xv[tk][j][2] + xv[tk][j][3]); }
            const float mu = wave_sum(s) * (1.f / D_); float qv = 0.f;
#pragma unroll
            for (int j = 0; j < 4; ++j) { xv[tk][j] = xv[tk][j] - mu; qv += (xv[tk][j][0] * xv[tk][j][0] + xv[tk][j][1] * xv[tk][j][1]) + (xv[tk][j][2] * xv[tk][j][2] + xv[tk][j][3] * xv[tk][j][3]); }
            const float rstd = rsqrtf(wave_sum(qv) * (1.f / D_) + EPS_);
#pragma unroll
            for (int j = 0; j < 4; ++j) { const f32x4 gg = ((const f32x4*)ln_g)[lane + 64 * j], bb = ((const f32x4*)ln_b)[lane + 64 * j];
                xv[tk][j] = xv[tk][j] * rstd * gg + bb;
                u32x2 o; o.x = cvt_pk_bf16(xv[tk][j][0], xv[tk][j][1]); o.y = cvt_pk_bf16(xv[tk][j][2], xv[tk][j][3]); ((u32x2*)(x1b + (size_t)(tokb + tk) * D_))[lane + 64 * j] = o;
                ((unsigned*)(x1q + (size_t)(tokb + tk) * D_))[lane + 64 * j] = pack4_fp8(xv[tk][j][0], xv[tk][j][1], xv[tk][j][2], xv[tk][j][3]); }
        }
        f32x2_ xq[2][4][4];
#pragma unroll
        for (int tp = 0; tp < 2; ++tp)
#pragma unroll
            for (int j = 0; j < 4; ++j)
#pragma unroll
                for (int e = 0; e < 4; ++e) xq[tp][j][e] = (f32x2_){xv[2 * tp][j][e], xv[2 * tp + 1][j][e]};
#pragma unroll 1
        for (int ob = 0; ob < 9; ++ob) {
            f32x2_ a2[2][4];
#pragma unroll
            for (int tp = 0; tp < 2; ++tp)
#pragma unroll
                for (int oo = 0; oo < 4; ++oo) a2[tp][oo] = (f32x2_){0.f, 0.f};
#pragma unroll
            for (int oo = 0; oo < 4; ++oo)
#pragma unroll
                for (int j = 0; j < 4; ++j) { const f32x4 wv = ((const LAS f32x4*)W)[(4 * ob + oo) * 256 + lane + 64 * j];
#pragma unroll
                    for (int e = 0; e < 4; ++e) { const f32x2_ wb = (f32x2_){wv[e], wv[e]};
                        a2[0][oo] = __builtin_elementwise_fma(xq[0][j][e], wb, a2[0][oo]); a2[1][oo] = __builtin_elementwise_fma(xq[1][j][e], wb, a2[1][oo]); } }
            float part[16];
#pragma unroll
            for (int tp = 0; tp < 2; ++tp)
#pragma unroll
                for (int oo = 0; oo < 4; ++oo) { part[(2 * tp) * 4 + oo] = a2[tp][oo][0]; part[(2 * tp + 1) * 4 + oo] = a2[tp][oo][1]; }
            treduce16(part, lane);
            if ((lane & 3) == 0) { const int idx = lane >> 2; LG[(w * 8 + half * 4 + (idx >> 2)) * 36 + 4 * ob + (idx & 3)] = part[0]; }
        }
        }
        __builtin_amdgcn_s_waitcnt(0xC07F); __builtin_amdgcn_wave_barrier();
        if (lane < 8) { const LAS float* lg = LG + (w * 8 + lane) * 36;
            float gl[4]; float mx = -1e30f; int gi = 0;
#pragma unroll
            for (int i = 0; i < 4; ++i) { gl[i] = lg[i] + b_grp[i]; if (gl[i] > mx) { mx = gl[i]; gi = i; } }
            float se = 0.f;
#pragma unroll
            for (int i = 0; i < 4; ++i) se += expf(gl[i] - mx);
            const float pg = 1.0f / se;
            float ev[8];
#pragma unroll
            for (int i = 0; i < 8; ++i) ev[i] = lg[4 + gi * 8 + i] + b_rt[gi * 8 + i];
            int i0 = 0;
#pragma unroll
            for (int i = 1; i < 8; ++i) if (ev[i] > ev[i0]) i0 = i;
            int i1 = (i0 == 0) ? 1 : 0;
#pragma unroll
            for (int i = 0; i < 8; ++i) if (i != i0 && ev[i] > ev[i1]) i1 = i;
            const float e1 = expf(ev[i1] - ev[i0]); const float w0 = 1.f / (1.f + e1), w1 = e1 / (1.f + e1);
            const int ea = gi * 8 + i0, eb = gi * 8 + i1;
            const int ra = atomicAdd((int*)&cntL[ea], 1), rb = atomicAdd((int*)&cntL[eb], 1);
            tokE[(w * 8 + lane) * 2] = (ea << 16) | ra; tokE[(w * 8 + lane) * 2 + 1] = (eb << 16) | rb; tokW[(w * 8 + lane) * 2] = pg * w0; tokW[(w * 8 + lane) * 2 + 1] = pg * w1;
        }
        __syncthreads();
        if (tid < 32) baseL[tid] = cntL[tid] ? (int)atomicAdd(&cur[tid * 16], (unsigned)cntL[tid]) : 0;
        __syncthreads();
        if (tid < 128 && !dry) { const int v = tokE[tid]; const int e = v >> 16, r = baseL[e] + (v & 0xffff); const int token = unit * 64 + (tid >> 1);
            buf_t[(size_t)e * ECAP_ + r] = token; buf_w[(size_t)e * ECAP_ + r] = tokW[tid]; slot_of[token * 2 + (tid & 1)] = (e << 16) | r; }
        __syncthreads();
        if (tid < 32) cntL[tid] = 0;
        __syncthreads();
    }
}

DI void moe_tables(PR p, const Ctx& c, int l, LAS int* cnt, LAS int* tbase) {
    unsigned* cur = WSP<unsigned>(p, WS_CUR) + (size_t)l * NE_ * 16;
    __syncthreads();
    if (c.tid < 32) cnt[c.tid] = (int)xb_ld(&cur[c.tid * 16]);
    __syncthreads();
    if (c.tid == 0) { int run = 0; for (int e = 0; e < 32; ++e) { tbase[e] = run; run += (cnt[e] + 255) >> 8; } tbase[32] = run; }
    __syncthreads();
}
DI void ph_moe(PR p, const Ctx& c, int l, LAS unsigned char* lds, bool dry = false) {
    LAS int* cnt = (LAS int*)(lds + STAGE_BYTES); LAS int* tbase = cnt + 32;
    moe_tables(p, c, l, cnt, tbase);
    unsigned* done = WSP<unsigned>(p, WS_DONE) + (size_t)(l + (dry ? L_ : 0)) * MT_ * 16;
    const int nu = tbase[32] * 4;
    {
        MoeOrder<true> S; S.A = (const char*)WSP<unsigned char>(p, WS_X1Q); S.B = (const char*)WSP<unsigned char>(p, WS_WGU); S.lda = D_; S.ldb = D_; S.bstride = (size_t)D_ * D_;
        S.tbase = tbase; S.cnt = cnt; S.buf_t = WSP<int>(p, WS_BUFT); S.done = done; S.nunits = nu; S.G = c.G; S.c = c.bid; S.n3 = 0; S.nb = 0;
        EpiSiluMul E{WSP<unsigned char>(p, WS_HB), done};
        gemm_phase<EpiSiluMul, MoeOrder<true>>(lds, Gemm{(unsigned)D_, (unsigned)D_, D_ / 2}, S, E);
    }
    __syncthreads();
    {
        MoeOrder<false> S; S.A = (const char*)WSP<unsigned char>(p, WS_HB); S.B = (const char*)WSP<unsigned char>(p, WS_WED); S.lda = DE_; S.ldb = DE_; S.bstride = (size_t)D_ * DE_;
        S.tbase = tbase; S.cnt = cnt; S.buf_t = WSP<int>(p, WS_BUFT); S.done = done; S.nunits = nu; S.G = c.G; S.c = c.bid;
        { const int maxups = (nu + c.G - 1) / c.G; S.n3 = (nu % c.G) ? nu - (maxups - 1) * c.G : c.G; S.nb = (c.G - S.n3) < nu ? (c.G - S.n3) : nu; }
        EpiDown E{WSP<unsigned char>(p, WS_YE), WSP<float>(p, WS_BUFW), cnt};
        gemm_phase<EpiDown, MoeOrder<false>>(lds, Gemm{(unsigned)DE_, (unsigned)DE_, DE_ / 2}, S, E);
    }
}
DI void ph_ln2(PR p, const Ctx& c, int l, LAS unsigned char* lds) {
    LAS int* cnt = (LAS int*)(lds + STAGE_BYTES); LAS int* tbase = cnt + 32;
    moe_tables(p, c, l, cnt, tbase);
    const bf16_t* x1b = WSP<bf16_t>(p, WS_X1B); const unsigned char* ye = WSP<unsigned char>(p, WS_YE); const int* slot_of = WSP<int>(p, WS_SLOT);
    const float* ln_g = IN(p, 31) + (size_t)l * D_; const float* ln_b = IN(p, 32) + (size_t)l * D_; bf16_t* x2b = WSP<bf16_t>(p, WS_X2B);
    const int lane = c.lane;
    const float* ssqT = WSP<float>(p, WS_SSQT); float* rstdT = WSP<float>(p, WS_RSTDT);
    for (int tok = c.bid * 8 + c.w; tok < M_; tok += c.G * 8) {
        { float tq = (lane < 16) ? ssqT[(size_t)tok * 16 + lane] : 0.f; tq += __shfl_xor(tq, 8); tq += __shfl_xor(tq, 4); tq += __shfl_xor(tq, 2); tq += __shfl_xor(tq, 1);
          if (lane == 0) rstdT[tok] = rsqrtf(tq * (1.f / D_) + EPS_); }
        const int s0 = slot_of[tok * 2], s1 = slot_of[tok * 2 + 1];
        const size_t r0 = ((size_t)(tbase[s0 >> 16] + ((s0 & 0xffff) >> 8)) * 256 + (s0 & 255)) * D_, r1 = ((size_t)(tbase[s1 >> 16] + ((s1 & 0xffff) >> 8)) * 256 + (s1 & 255)) * D_;
        f32x4 v[4]; float s = 0.f;
#pragma unroll
        for (int j = 0; j < 4; ++j) { const u32x2 xr = ((const u32x2*)(x1b + (size_t)tok * D_))[lane + 64 * j]; const f32x4 xv = (f32x4){bflo(xr.x), bfhi(xr.x), bflo(xr.y), bfhi(xr.y)};
            const int a = ((const int*)(ye + r0))[lane + 64 * j], bq = ((const int*)(ye + r1))[lane + 64 * j];
            v[j][0] = ALPHA_ * xv[0] + YE_INV * (__builtin_amdgcn_cvt_f32_fp8(a, 0) + __builtin_amdgcn_cvt_f32_fp8(bq, 0)); v[j][1] = ALPHA_ * xv[1] + YE_INV * (__builtin_amdgcn_cvt_f32_fp8(a, 1) + __builtin_amdgcn_cvt_f32_fp8(bq, 1));
            v[j][2] = ALPHA_ * xv[2] + YE_INV * (__builtin_amdgcn_cvt_f32_fp8(a, 2) + __builtin_amdgcn_cvt_f32_fp8(bq, 2)); v[j][3] = ALPHA_ * xv[3] + YE_INV * (__builtin_amdgcn_cvt_f32_fp8(a, 3) + __builtin_amdgcn_cvt_f32_fp8(bq, 3));
            s += (v[j][0] + v[j][1]) + (v[j][2] + v[j][3]); }
        const float mu = wave_sum(s) * (1.f / D_); float qv = 0.f;
#pragma unroll
        for (int j = 0; j < 4; ++j) { v[j] = v[j] - mu; qv += (v[j][0] * v[j][0] + v[j][1] * v[j][1]) + (v[j][2] * v[j][2] + v[j][3] * v[j][3]); }
        const float rstd = rsqrtf(wave_sum(qv) * (1.f / D_) + EPS_);
#pragma unroll
        for (int j = 0; j < 4; ++j) { const f32x4 gg = ((const f32x4*)ln_g)[lane + 64 * j], bb = ((const f32x4*)ln_b)[lane + 64 * j]; const f32x4 o = v[j] * rstd * gg + bb;
            u32x2 ob; ob.x = cvt_pk_bf16(o[0], o[1]); ob.y = cvt_pk_bf16(o[2], o[3]); ((u32x2*)(x2b + (size_t)tok * D_))[lane + 64 * j] = ob; }
    }
}
DI void ph_ple(PR p, const Ctx& c, int l, LAS unsigned char* lds) {
    DenseOrder S; S.init(WSP<bf16_t>(p, WS_X2B), WSP<bf16_t>(p, WS_WPG) + (size_t)l * D_ * D_, D_ * 2, D_ * 2, M_, D_, c.G, c.bid);
    EpiPle E{WSP<bf16_t>(p, WS_X2B), WSP<bf16_t>(p, WS_TB), WSP<float>(p, WS_RSTDT), IN(p, 34) + (size_t)l * D_, IN(p, 36) + (size_t)l * D_, (l == L_ - 1) ? p.out : (float*)nullptr, WSP<bf16_t>(p, WS_XB)};
    gemm_phase<EpiPle, DenseOrder>(lds, Gemm{(unsigned)(D_ * 2), (unsigned)(D_ * 2), D_}, S, E);
}

DI Ctx mk_ctx() { Ctx c; int t = threadIdx.x; asm volatile("" : "+v"(t)); t &= 511; int g = gridDim.x, b = blockIdx.x; asm volatile("" : "+s"(g), "+s"(b)); c.G = g; c.bid = b; c.tid = t; c.lane = t & 63; c.w = __builtin_amdgcn_readfirstlane(t >> 6); return c; }

DI PR getP() { const __attribute__((address_space(4))) P* q = (const __attribute__((address_space(4))) P*)__builtin_amdgcn_kernarg_segment_ptr(); asm volatile("" : "+s"(q)); return *q; }
template <int PH> DI void run_phase(int l, LAS unsigned char* lds0) {
    unsigned la = (unsigned)(size_t)lds0; asm volatile("" : "+s"(la)); LAS unsigned char* lds = (LAS unsigned char*)(size_t)la;
    PR p = getP(); const Ctx c = mk_ctx();
    if constexpr (PH == 0) ph_prologue(p, c, lds);
    if constexpr (PH >= 200 && PH < 216) ph_prologue(p, c, lds, PH - 200);
    if constexpr (PH == 1) ph_inproj(p, c, l, lds);
    if constexpr (PH == 2) ph_mix1(p, c, l, lds);
    if constexpr (PH == 3) ph_scan(p, c, l, lds);
    if constexpr (PH == 4) ph_mix2(p, c, l, lds);
    if constexpr (PH == 5) ph_glu(p, c, l, lds);
    if constexpr (PH == 6) ph_outproj(p, c, l, lds);
    if constexpr (PH == 7) ph_route(p, c, l, lds, false);
    if constexpr (PH == 107) ph_route(p, c, l, lds, true);
    if constexpr (PH == 8) ph_moe(p, c, l, lds, false);
    if constexpr (PH == 108) ph_moe(p, c, l, lds, true);
    if constexpr (PH == 10) ph_ln2(p, c, l, lds);
    if constexpr (PH == 11) ph_ple(p, c, l, lds);
}
DI void grid_bar(LAS unsigned char* lds) {
    PR p = getP();
    XcdBarrier b; b.bar = WSP<unsigned>(p, WS_BAR); b.x = xb_xcc_id(); b.st = (volatile LAS unsigned*)(lds + LDS_BYTES - 16);
    xcd_barrier(b);
}

#if MK_MULTI
template <int PH> __global__ __launch_bounds__(512, 2) void k_phase(P p, int l) {
    extern __shared__ __attribute__((aligned(16))) unsigned char smem[];
    (void)p;
    run_phase<PH>(l, (LAS unsigned char*)smem);
}
#else
__global__ __launch_bounds__(512, 2) void k_fwd(P p) {
    extern __shared__ __attribute__((aligned(16))) unsigned char smem[];
    LAS unsigned char* lds = (LAS unsigned char*)smem;
    volatile LAS unsigned* bst = (volatile LAS unsigned*)(lds + LDS_BYTES - 16);
    if (threadIdx.x < 4) bst[threadIdx.x] = 0u;
    __syncthreads();
    (void)xcd_barrier_post((unsigned*)(p.ws + WS_BAR), bst);
    run_phase<0>(0, lds); grid_bar(lds);
    if (MK_REP == 0) { run_phase<0>(0, lds); grid_bar(lds); }
    if (MK_REP >= 200 && MK_REP < 216) { run_phase<(MK_REP >= 200 && MK_REP < 216) ? MK_REP : 200>(0, lds); grid_bar(lds); }
#define MK_PH(k, l) do { run_phase<k>(l, lds); if (MK_REP == k) { grid_bar(lds); run_phase<(k == 7 ? 107 : k == 8 ? 108 : k)>(l, lds); } } while (0)
#define MK_LAYER(l, lastbar) do { MK_PH(1, l); grid_bar(lds); MK_PH(2, l); grid_bar(lds); MK_PH(3, l); grid_bar(lds); MK_PH(4, l); grid_bar(lds); \
        MK_PH(5, l); grid_bar(lds); MK_PH(6, l); grid_bar(lds); MK_PH(8, l); grid_bar(lds); \
        MK_PH(10, l); grid_bar(lds); MK_PH(11, l); if (lastbar) grid_bar(lds); if (MK_REP == 99) { for (int q_ = 0; q_ < 10; ++q_) grid_bar(lds); } } while (0)
    MK_LAYER(0, true); MK_LAYER(1, true); MK_LAYER(2, true); MK_LAYER(3, false);
#undef MK_LAYER
#undef MK_PH
}
#endif
}

#if MK_MULTI
template <int PH> static void launch_phase(const P& p, int l, int grid, hipStream_t st) {
    static bool attr_set = false;
    if (!attr_set) { (void)hipFuncSetAttribute((const void*)k_phase<PH>, hipFuncAttributeMaxDynamicSharedMemorySize, LDS_BYTES); attr_set = true; }
    hipLaunchKernelGGL(k_phase<PH>, dim3(grid), dim3(NT_), LDS_BYTES, st, p, l);
}
#endif

extern "C" void kernel_launch(void* const* d_in, const int* in_sizes, int n_in, void* d_out, int out_size, void* d_ws, size_t ws_size, hipStream_t stream) {
    (void)in_sizes; (void)n_in; (void)out_size; (void)ws_size;
    static int grid = 0;
    if (grid == 0) { int dev = 0, cus = 0; (void)hipGetDevice(&dev); (void)hipDeviceGetAttribute(&cus, hipDeviceAttributeMultiprocessorCount, dev); grid = cus > 0 ? cus : 256; }
    P p{};
    for (int i = 0; i < 37; ++i) p.in[i] = (const float*)d_in[i];
    p.out = (float*)d_out; p.ws = (unsigned char*)d_ws;
    (void)hipMemsetAsync(d_ws, 0, WS_CTL_END, stream);
#if MK_MULTI
    launch_phase<0>(p, 0, grid, stream);
    for (int l = 0; l < L_; ++l) {
        launch_phase<1>(p, l, grid, stream); launch_phase<2>(p, l, grid, stream); launch_phase<3>(p, l, grid, stream); launch_phase<4>(p, l, grid, stream);
        launch_phase<5>(p, l, grid, stream); launch_phase<6>(p, l, grid, stream); launch_phase<8>(p, l, grid, stream);
        launch_phase<10>(p, l, grid, stream); launch_phase<11>(p, l, grid, stream);
    }
#else
    static bool attr_set = false;
    if (!attr_set) { (void)hipFuncSetAttribute((const void*)k_fwd, hipFuncAttributeMaxDynamicSharedMemorySize, LDS_BYTES); attr_set = true; }
    hipLaunchKernelGGL(k_fwd, dim3(grid), dim3(NT_), LDS_BYTES, stream, p);
#endif
}
```

```cpp
#include <hip/hip_runtime.h>
#include <math.h>
#include <stdint.h>

#ifndef MK_MULTI
#define MK_MULTI 0
#endif

#ifndef MK_REP
#define MK_REP -1
#endif

namespace {
#define LAS __attribute__((address_space(3)))
#define DI __device__ __forceinline__
typedef unsigned short bf16_t;
typedef short bf16x8 __attribute__((ext_vector_type(8)));
typedef short s16x4 __attribute__((ext_vector_type(4)));
typedef float f32x4 __attribute__((ext_vector_type(4)));
typedef unsigned u32x4 __attribute__((ext_vector_type(4)));
typedef unsigned u32x2 __attribute__((ext_vector_type(2)));
typedef int v8i __attribute__((ext_vector_type(8)));
typedef int v4i __attribute__((ext_vector_type(4)));

constexpr int NB_ = 8, S_ = 2048, D_ = 1024, M_ = NB_ * S_, L_ = 4;
constexpr int DM_ = 512, H_ = 4, DH_ = 128, DIN_ = 2056, ZLD_ = 1536;
constexpr int G5_ = 32, P5_ = 64;
constexpr int PLE_ = 256, NE_ = 32, DE_ = 512;
constexpr int MT_ = 160, PS2_ = MT_ * 256, ECAP_ = 32768;
constexpr int S5K_ = 384, S5R_ = M_ / 16;
constexpr float ALPHA_ = 1.681792830507429f, EPS_ = 1e-5f;
constexpr int NT_ = 512;
constexpr int LDS_BYTES = 163840;

constexpr size_t al256(size_t x) { return (x + 255) & ~(size_t)255; }
constexpr int XCD_BAR_WORDS = 3456;
constexpr size_t WS_BAR = 0;
constexpr size_t WS_CUR = al256(WS_BAR + XCD_BAR_WORDS * 4);
constexpr size_t WS_DONE = al256(WS_CUR + (size_t)2 * L_ * NE_ * 64);
constexpr size_t WS_LNC = al256(WS_DONE + (size_t)2 * L_ * MT_ * 64);
constexpr size_t WS_CTL_END = al256(WS_LNC + (size_t)L_ * 64 * 64);
constexpr size_t WS_XB = WS_CTL_END;
constexpr size_t WS_XC = al256(WS_XB + (size_t)M_ * D_ * 2);
constexpr size_t WS_XCH = WS_XC;
constexpr size_t WS_LOGIT = WS_XC + ((size_t)16 << 20);
constexpr size_t WS_GHL = WS_XC + ((size_t)24 << 20);
constexpr size_t WS_RTC = WS_XC + ((size_t)26 << 20);
constexpr size_t WS_ZB = al256(WS_XC + (size_t)M_ * D_ * 4);
constexpr size_t WS_AS5 = al256(WS_ZB + (size_t)M_ * ZLD_ * 2);
constexpr size_t WS_ESUM = al256(WS_AS5 + (size_t)G5_ * S5R_ * S5K_ * 2);
constexpr size_t WS_QB = al256(WS_ESUM + (size_t)G5_ * S5R_ * 128 * 4);
constexpr size_t WS_KB = al256(WS_QB + (size_t)M_ * DM_ * 2);
constexpr size_t WS_CSUM = al256(WS_KB + (size_t)M_ * DM_ * 2);
constexpr size_t WS_CPREV = al256(WS_CSUM + (size_t)1024 * DH_ * DH_ * 4);
constexpr size_t WS_NSUM = al256(WS_CPREV + (size_t)1024 * DH_ * DH_ * 2);
constexpr size_t WS_NPREV = al256(WS_NSUM + (size_t)1024 * DH_ * 4);
constexpr size_t WS_GG = al256(WS_NPREV + (size_t)1024 * DH_ * 4);
constexpr size_t WS_MLG = al256(WS_GG + 4096);
constexpr size_t WS_MPREV = al256(WS_MLG + 4096);
constexpr size_t WS_IGG = al256(WS_MPREV + 4096);
constexpr size_t WS_BCUM = al256(WS_IGG + (size_t)M_ * 16);
constexpr size_t WS_YB = al256(WS_BCUM + (size_t)M_ * 16);
constexpr size_t WS_GYB = al256(WS_YB + (size_t)M_ * D_ * 2);
constexpr size_t WS_SSQS = al256(WS_GYB + (size_t)M_ * DM_ * 2);
constexpr size_t WS_X1 = al256(WS_SSQS + (size_t)M_ * 32);
constexpr size_t WS_X1B = al256(WS_X1 + (size_t)M_ * D_ * 4);
constexpr size_t WS_X1Q = al256(WS_X1B + (size_t)M_ * D_ * 2);
constexpr size_t WS_BUFT = al256(WS_X1Q + (size_t)M_ * D_);
constexpr size_t WS_BUFW = al256(WS_BUFT + (size_t)NE_ * ECAP_ * 4);
constexpr size_t WS_SLOT = al256(WS_BUFW + (size_t)NE_ * ECAP_ * 4);
constexpr size_t WS_HB = al256(WS_SLOT + (size_t)M_ * 8);
constexpr size_t WS_YE = al256(WS_HB + (size_t)PS2_ * DE_ * 2);
constexpr size_t WS_X2 = al256(WS_YE + (size_t)PS2_ * D_ * 2);
constexpr size_t WS_X2B = al256(WS_X2 + (size_t)M_ * D_ * 4);
constexpr size_t WS_TB = al256(WS_X2B + (size_t)M_ * D_ * 2);
constexpr size_t WS_SSQT = al256(WS_TB + (size_t)M_ * D_ * 2);
constexpr size_t WS_RSTDT = al256(WS_SSQT + (size_t)M_ * 64);
constexpr size_t WS_PBF = al256(WS_RSTDT + (size_t)M_ * 4);
constexpr size_t WS_WIN = al256(WS_PBF + (size_t)L_ * M_ * PLE_ * 2);
constexpr size_t WS_WOUT = al256(WS_WIN + (size_t)L_ * 2048 * D_ * 2);
constexpr size_t WS_WPG = al256(WS_WOUT + (size_t)L_ * D_ * D_ * 2);
constexpr size_t WS_WPP = al256(WS_WPG + (size_t)L_ * D_ * D_ * 2);
constexpr size_t WS_WGLU = al256(WS_WPP + (size_t)L_ * D_ * PLE_ * 2);
constexpr size_t WS_WQK = al256(WS_WGLU + (size_t)L_ * DM_ * DM_ * 2);
constexpr size_t WS_WGATE = al256(WS_WQK + (size_t)L_ * H_ * 256 * DH_ * 2);
constexpr size_t WS_WET = al256(WS_WGATE + (size_t)L_ * 16 * D_ * 2);
constexpr size_t WS_WYT = al256(WS_WET + (size_t)L_ * G5_ * 256 * 256 * 2);
constexpr size_t WS_A16 = al256(WS_WYT + (size_t)L_ * G5_ * 256 * S5K_ * 2);
constexpr size_t WS_WGU = al256(WS_A16 + (size_t)L_ * G5_ * 128 * 4);
constexpr size_t WS_WED = al256(WS_WGU + (size_t)NE_ * D_ * D_ * 2);
constexpr size_t WS_WRT = al256(WS_WED + (size_t)NE_ * D_ * DE_ * 2);
constexpr size_t WS_END = al256(WS_WRT + (size_t)L_ * 36 * D_ * 4);
static_assert(WS_END <= (size_t)1073741824, "workspace over 1 GiB");

struct P { const float* in[37]; float* out; unsigned char* ws; };
typedef const __attribute__((address_space(4))) P& PR;

typedef float f32x2_ __attribute__((ext_vector_type(2)));
typedef __bf16 bf16x2_ __attribute__((ext_vector_type(2)));
DI unsigned cvt_pk_bf16(float lo, float hi) { const f32x2_ v = {lo, hi}; return __builtin_bit_cast(unsigned, __builtin_convertvector(v, bf16x2_)); }
DI float bf2f(bf16_t v) { return __uint_as_float(((unsigned)v) << 16); }
DI float bflo(unsigned v) { return __uint_as_float(v << 16); }
DI float bfhi(unsigned v) { return __uint_as_float(v & 0xffff0000u); }
DI unsigned pack4_fp8(float a, float b, float c, float d) { int w = 0; w = __builtin_amdgcn_cvt_pk_fp8_f32(a, b, w, false); w = __builtin_amdgcn_cvt_pk_fp8_f32(c, d, w, true); return (unsigned)w; }
constexpr float W8_SCALE = 64.0f, W8_INV = 1.0f / 64.0f, YE_SCALE = 32.0f, YE_INV = 1.0f / 32.0f;
DI bf16_t f2bf(float f) { unsigned u = __float_as_uint(f); u += 0x7fffu + ((u >> 16) & 1u); return (bf16_t)(u >> 16); }
DI float wave_sum(float v) {
#pragma unroll
    for (int o = 32; o > 0; o >>= 1) v += __shfl_xor(v, o);
    return v;
}
DI float sigmoidf_(float x) { return 1.0f / (1.0f + expf(-x)); }
DI float siluf_(float x) { return x * sigmoidf_(x); }
DI float fast_sigmoid(float x) { return __builtin_amdgcn_rcpf(1.0f + __builtin_amdgcn_exp2f(-1.4426950408889634f * x)); }
DI float fast_silu(float x) { return x * fast_sigmoid(x); }
DI float fast_gelu_tanh(float x) { const float z2 = 1.5957691216057308f * (x + 0.044715f * x * x * x); return x * fast_sigmoid(z2); }
DI float log_sigmoid_(float x) { return (x >= 0.f) ? -log1pf(expf(-x)) : (x - log1pf(expf(x))); }
DI f32x4 mfma16(bf16x8 a, bf16x8 b, f32x4 c) { return __builtin_amdgcn_mfma_f32_16x16x32_bf16(a, b, c, 0, 0, 0); }
DI bf16x8 ld_frag_g(const bf16_t* p) { return *(const bf16x8*)p; }
DI bf16x8 cat8(s16x4 lo, s16x4 hi) { return __builtin_shufflevector(lo, hi, 0, 1, 2, 3, 4, 5, 6, 7); }
DI unsigned off_b(unsigned row, unsigned ch) { return 256u * row + 16u * (ch ^ (((row & 3u) << 2) | ((row >> 2) & 3u))); }
DI bf16x8 tile_row_read(const LAS unsigned char* tile, int lane, int rb, int s) {
    return *(const LAS bf16x8*)(tile + off_b((unsigned)((lane & 15) + 16 * rb), (unsigned)(4 * s + (lane >> 4))));
}
DI s16x4 tile_tr_read(const LAS unsigned char* tile, int lane, int row0, int c) {
    const unsigned q = (unsigned)(lane & 15) >> 2, p = (unsigned)lane & 3u;
    const unsigned addr = (unsigned)(size_t)tile + off_b((unsigned)row0 + q, (unsigned)(2 * c) + (p >> 1)) + 8u * (p & 1u);
    s16x4 r; asm volatile("ds_read_b64_tr_b16 %0, %1\n\ts_waitcnt lgkmcnt(0)" : "=&v"(r) : "v"(addr) : "memory"); return r;
}

DI unsigned tr_addr(const LAS unsigned char* tile, int lane, int row0, int c) {
    const unsigned q = (unsigned)(lane & 15) >> 2, p = (unsigned)lane & 3u;
    return (unsigned)(size_t)tile + off_b((unsigned)row0 + q, (unsigned)(2 * c) + (p >> 1)) + 8u * (p & 1u);
}
DI void tile_tr_read4(unsigned a0, unsigned a1, unsigned a2, unsigned a3, s16x4& r0, s16x4& r1, s16x4& r2, s16x4& r3) {
    asm volatile("ds_read_b64_tr_b16 %0, %4\n\tds_read_b64_tr_b16 %1, %5\n\tds_read_b64_tr_b16 %2, %6\n\tds_read_b64_tr_b16 %3, %7\n\ts_waitcnt lgkmcnt(0)"
                 : "=&v"(r0), "=&v"(r1), "=&v"(r2), "=&v"(r3) : "v"(a0), "v"(a1), "v"(a2), "v"(a3) : "memory");
}

#define XB_TMO      128
#define XB_XCNT(j)  (256  + 64 * (j))
#define XB_XSUB(j)  (1280 + 64 * (j))
#define XB_XGEN(j)  (2304 + 64 * (j))
#define XB_TOP      3328
#define XB_TOPGEN   3392
#define XB_SPIN_CAP (1u << 18)
DI unsigned xb_ld(unsigned* p)              { return __hip_atomic_load(p, __ATOMIC_RELAXED, __HIP_MEMORY_SCOPE_AGENT); }
DI unsigned xb_add(unsigned* p, unsigned v) { return __hip_atomic_fetch_add(p, v, __ATOMIC_RELAXED, __HIP_MEMORY_SCOPE_AGENT); }
DI unsigned xb_xcc_id() { return (unsigned)__builtin_amdgcn_s_getreg((3 << 11) | 20) & 0xFu; }
#define XB_SPIN(cond, bar) do { unsigned _sp = 0; while (cond) { __builtin_amdgcn_s_sleep(1); \
    if ((++_sp & 255u) == 0u) { if (xb_ld(&(bar)[XB_TMO])) break; if (_sp > XB_SPIN_CAP) { atomicAdd(&(bar)[XB_TMO], 1u); break; } } } } while (0)
struct XcdBarrier { unsigned* bar; unsigned x; volatile LAS unsigned* st; };
DI XcdBarrier xcd_barrier_post(unsigned* bar, volatile LAS unsigned* st) {
    XcdBarrier b; b.bar = bar; b.x = xb_xcc_id(); b.st = st;
    if (threadIdx.x == 0) (void)xb_add(&bar[XB_XCNT(b.x)], 1u);
    return b;
}
DI void xcd_barrier_complete(unsigned* bar, unsigned x, unsigned& nloc, unsigned& nx) {
    const unsigned G = gridDim.x * gridDim.y * gridDim.z;
    unsigned sum, cnt, mine, sp = 0u;
    for (;;) {
        sum = 0u; cnt = 0u; mine = 0u;
#pragma unroll
        for (unsigned j = 0; j < 16; ++j) { const unsigned c = xb_ld(&bar[XB_XCNT(j)]); sum += c; cnt += (c > 0u) ? 1u : 0u; mine = (j == x) ? c : mine; }
        if (sum == G) break;
        __builtin_amdgcn_s_sleep(1);
        if ((++sp & 255u) == 0u) { if (xb_ld(&bar[XB_TMO])) break; if (sp > XB_SPIN_CAP) { atomicAdd(&bar[XB_TMO], 1u); break; } }
    }
    nloc = mine > 0u ? mine : 1u; nx = cnt > 0u ? cnt : 1u;
}
DI void xcd_barrier(const XcdBarrier& b) {
    asm volatile("s_waitcnt vmcnt(0)" ::: "memory");
    __syncthreads();
    if (threadIdx.x == 0) {
        unsigned* bar = b.bar;
        __builtin_amdgcn_s_waitcnt(0);
        unsigned nloc = b.st[0], nx = b.st[1];
        if (nloc == 0u) { xcd_barrier_complete(bar, b.x, nloc, nx); b.st[0] = nloc; b.st[1] = nx; }
        const unsigned old = xb_add(&bar[XB_XSUB(b.x)], 1u);
        const unsigned gen = old / nloc;
        if (old + 1u == (gen + 1u) * nloc) {
            __builtin_amdgcn_fence(__ATOMIC_RELEASE, "agent");
            asm volatile("s_waitcnt vmcnt(0)" ::: "memory");
            const unsigned og = xb_add(&bar[XB_TOP], 1u);
            const unsigned tg = og / nx;
            if (og + 1u == (tg + 1u) * nx) xb_add(&bar[XB_TOPGEN], 1u);
            else XB_SPIN(xb_ld(&bar[XB_TOPGEN]) == tg, bar);
            __builtin_amdgcn_fence(__ATOMIC_ACQUIRE, "agent");
            xb_add(&bar[XB_XGEN(b.x)], 1u);
            asm volatile("s_waitcnt vmcnt(0)" ::: "memory");
        } else {
            XB_SPIN(xb_ld(&bar[XB_XGEN(b.x)]) == gen, bar);
            __builtin_amdgcn_fence(__ATOMIC_ACQUIRE, "agent");
            asm volatile("s_waitcnt vmcnt(0)" ::: "memory");
        }
    }
    __syncthreads();
}

constexpr int BM = 256, BK = 64, HALF = 128, HTB = HALF * BK * 2, STAGE_BYTES = 8 * HTB, NXCD = 8, WGM = 8;
DI int lds_byte(int r, int c) { const int st = (r >> 4) * 2 + (c >> 5), rr = r & 15, cc = c & 31, ob = rr * 64 + cc * 2; return st * 1024 + (ob ^ (((ob >> 9) & 1) << 5)); }
DI void stage_rc(int b, int& R, int& C) { const int st = b / 1024, sb = b % 1024, swz = sb ^ (((sb >> 9) & 1) << 5); R = (st >> 1) * 16 + swz / 64; C = (st & 1) * 32 + (swz % 64) / 2; }
DI int perm32(int rho) { const int n = rho >> 4, i = rho & 15; return 8 * (i >> 2) + 4 * n + (i & 3); }

struct Unit { const char* A; const char* B; int pm, pn, aux; };
struct Gemm { unsigned lda, ldb; int K; };

struct DenseOrder {
    static constexpr bool GATHER = false;
    const char* A; const char* B; unsigned lda, ldb; int nM, nN, nwg, G, c;
    DI void init(const void* A_, const void* B_, unsigned lda_, unsigned ldb_, int M, int N, int G_, int c_) { A = (const char*)A_; B = (const char*)B_; lda = lda_; ldb = ldb_; nM = M / BM; nN = N / BM; nwg = nM * nN; G = G_; c = c_; }
    DI bool next(int i, Unit& u) const {
        const long Lx = (long)i * G + c; if (Lx >= nwg) return false;
        int wgid = (int)Lx; { const int q = nwg / NXCD, r = nwg % NXCD, xcd = wgid % NXCD, off = wgid / NXCD; wgid = (xcd < r ? xcd * (q + 1) : r * (q + 1) + (xcd - r) * q) + off; }
        const int nig = WGM * nN, gid = wgid / nig, fm = gid * WGM, gsz = (nM - fm) < WGM ? (nM - fm) : WGM;
        u.pm = fm + ((wgid % nig) % gsz); u.pn = (wgid % nig) / gsz; u.aux = 0;
        u.A = A + (size_t)u.pm * BM * lda; u.B = B + (size_t)u.pn * BM * ldb; return true;
    }
    DI unsigned voff(const Unit&, int, int) const { return 0u; }
    DI void a_ready(const Unit&) const {}
};
struct GroupOrder {
    static constexpr bool GATHER = false;
    const char* A; const char* B; size_t astride, bstride; unsigned lda; int nunits, G, c;
    DI bool next(int i, Unit& u) const {
        const int Lx = i * G + c; if (Lx >= nunits) return false;
        const int g = Lx >> 2, pm = Lx & 3; u.pm = pm; u.pn = 0; u.aux = g; u.A = A + (size_t)g * astride + (size_t)pm * BM * lda; u.B = B + (size_t)g * bstride; return true;
    }
    DI unsigned voff(const Unit&, int, int) const { return 0u; }
    DI void a_ready(const Unit&) const {}
};
template <bool GATHER_>
struct MoeOrder {
    static constexpr bool GATHER = GATHER_;
    const char* A; const char* B; unsigned lda, ldb; size_t bstride; const LAS int* tbase; const LAS int* cnt; const int* buf_t; unsigned* done; int nunits, G, c, n3, nb;
    DI bool next(int i, Unit& u) const {
        int Lx;
        if constexpr (GATHER_) { Lx = i * G + c; }
        else { const int cr = (c - n3 + G) % G; const bool bonus = (c >= n3) && (c - n3 < nb); if (bonus && i == 0) Lx = c - n3; else Lx = nb + cr + (bonus ? i - 1 : i) * G; }
        if (Lx >= nunits) return false;
        const int T = Lx >> 2, pn = Lx & 3; int e = 0; while (e < NE_ - 1 && tbase[e + 1] <= T) ++e;
        const int k = T - tbase[e]; u.pm = T; u.pn = pn; u.aux = e * 128 + k;
        u.B = B + (size_t)e * bstride + (size_t)pn * BM * ldb; u.A = GATHER_ ? A : A + (size_t)T * BM * lda; return true;
    }
    DI unsigned voff(const Unit& u, int R, int C) const {
        const int e = u.aux >> 7, idx = (u.aux & 127) * 256 + R; const int tok = (idx < cnt[e]) ? buf_t[(size_t)e * ECAP_ + idx] : 0;
        return (unsigned)tok * lda + (unsigned)C * 2u;
    }
    DI void a_ready(const Unit& u) const {
        if constexpr (!GATHER_) {
            if (threadIdx.x < 64) {
                unsigned spins = 0;
                while ((unsigned)__builtin_amdgcn_readfirstlane(__hip_atomic_load(done + 16 * u.pm, __ATOMIC_RELAXED, __HIP_MEMORY_SCOPE_AGENT)) < 32u) { __builtin_amdgcn_s_sleep(2); if (++spins > (1u << 22)) break; }
                __builtin_amdgcn_fence(__ATOMIC_ACQUIRE, "agent");
                asm volatile("s_waitcnt vmcnt(0)" ::: "memory");
            }
            asm volatile("" ::: "memory"); __builtin_amdgcn_s_barrier(); asm volatile("" ::: "memory");
        }
    }
};

template <class Epi, class Sched>
DI void gemm_phase(LAS unsigned char* lds, const Gemm g, const Sched& S, const Epi& E) {
    int tid = threadIdx.x; asm volatile("" : "+v"(tid)); tid &= 511;
    const int wid = __builtin_amdgcn_readfirstlane(tid >> 6), lane = tid & 63, wr = wid >> 2, wc = wid & 3, fr = lane & 15, fq = lane >> 4;
    const int nt = g.K / BK;
    unsigned voffA[2][2], nvoffA[2][2], voffB[2];
#pragma unroll
    for (int i = 0; i < 2; ++i) { int R, C; stage_rc(tid * 16 + i * 8192, R, C); const int Rb = Epi::PERM ? ((R & ~31) + perm32(R & 31)) : R;
        voffB[i] = (unsigned)Rb * g.ldb + (unsigned)C * 2u;
        voffA[0][i] = (unsigned)R * g.lda + (unsigned)C * 2u; voffA[1][i] = (unsigned)(R + HALF) * g.lda + (unsigned)C * 2u;
        nvoffA[0][i] = voffA[0][i]; nvoffA[1][i] = voffA[1][i]; }
    const size_t kstep = (size_t)(BK * 2);
    const size_t hstepB = (size_t)HALF * g.ldb;
    const unsigned ldsw = (unsigned)wid * 1024u;
    const int aoff = lds_byte(wr * 64 + fr, fq * 8), boff = lds_byte(wc * 32 + fr, fq * 8);
#define PG8_SA(b, h) (((b) * 2 + (h)) * HTB)
#define PG8_SB(b, h) ((4 + (b) * 2 + (h)) * HTB)
#define PG8_STAGE(bufoff, gbase, voff) do { _Pragma("unroll") for (int _i = 0; _i < 2; ++_i) \
        __builtin_amdgcn_global_load_lds((const unsigned*)((const char*)(gbase) + (voff)[_i]), (LAS unsigned*)(lds + (bufoff) + ldsw + _i * 8192), 16, 0, 0); } while (0)
#define PG8_LDA(dst, b, h) do { if constexpr (Epi::FP8) { _Pragma("unroll") for (int m = 0; m < 4; ++m) dst##8[m] = __builtin_shufflevector(*(const LAS v4i*)(lds + PG8_SA(b, h) + aoff + m * 2048), *(const LAS v4i*)(lds + PG8_SA(b, h) + aoff + m * 2048 + 1024), 0, 1, 2, 3, 4, 5, 6, 7); } \
        else { _Pragma("unroll") for (int m = 0; m < 4; ++m) _Pragma("unroll") for (int k = 0; k < 2; ++k) dst[m][k] = *(const LAS bf16x8*)(lds + PG8_SA(b, h) + aoff + m * 2048 + k * 1024); } } while (0)
#define PG8_LDB(dst, b, h) do { if constexpr (Epi::FP8) { _Pragma("unroll") for (int n = 0; n < 2; ++n) dst##8[n] = __builtin_shufflevector(*(const LAS v4i*)(lds + PG8_SB(b, h) + boff + n * 2048), *(const LAS v4i*)(lds + PG8_SB(b, h) + boff + n * 2048 + 1024), 0, 1, 2, 3, 4, 5, 6, 7); } \
        else { _Pragma("unroll") for (int n = 0; n < 2; ++n) _Pragma("unroll") for (int k = 0; k < 2; ++k) dst[n][k] = *(const LAS bf16x8*)(lds + PG8_SB(b, h) + boff + n * 2048 + k * 1024); } } while (0)
#define PG8_MMA(ai, bj, At, Bt) do { __builtin_amdgcn_s_setprio(1); _Pragma("unroll") for (int m = 0; m < 4; ++m) _Pragma("unroll") for (int n = 0; n < 2; ++n) { \
        if constexpr (Epi::FP8)   \
            asm volatile("v_mfma_scale_f32_16x16x128_f8f6f4 %0, %1, %2, %0, %3, %3 op_sel_hi:[0,0,0]" : "+v"(acc[ai][bj][m][n]) : "v"(Bt##8[n]), "v"(At##8[m]), "v"(sc8));   \
        else { _Pragma("unroll") for (int k = 0; k < 2; ++k) acc[ai][bj][m][n] = __builtin_amdgcn_mfma_f32_16x16x32_bf16(Bt[n][k], At[m][k], acc[ai][bj][m][n], 0, 0, 0); } } \
        __builtin_amdgcn_s_setprio(0); } while (0)
#define PG8_WAIT_V(n) asm volatile("s_waitcnt vmcnt(" #n ")" ::: "memory")
#define PG8_WAIT_L(n) asm volatile("s_waitcnt lgkmcnt(" #n ")" ::: "memory")
#define PG8_BAR __builtin_amdgcn_s_barrier()
#define PG8_SCHED __builtin_amdgcn_sched_barrier(0)
    Unit cur, nxt; int ui = 0;
    if (!S.next(0, cur)) return;
    if constexpr (Sched::GATHER) {
#pragma unroll
        for (int i = 0; i < 2; ++i) { int R, C; stage_rc(tid * 16 + i * 8192, R, C); voffA[0][i] = S.voff(cur, R, C); voffA[1][i] = S.voff(cur, R + HALF, C); }
    }
    f32x4 acc[2][2][4][2];
#pragma unroll
    for (int a = 0; a < 2; ++a)
#pragma unroll
        for (int b = 0; b < 2; ++b)
#pragma unroll
            for (int m = 0; m < 4; ++m)
#pragma unroll
                for (int n = 0; n < 2; ++n) acc[a][b][m][n] = (f32x4){0.f, 0.f, 0.f, 0.f};
    const int sc8 = 0x7f7f7f7f;
    bf16x8 At[4][2], B0[2][2], B1[2][2]; v8i At8[4], B08[2], B18[2];
    const char* cA = cur.A; const char* cB = cur.B;
    S.a_ready(cur);
    PG8_STAGE(PG8_SB(0, 0), cB, voffB); PG8_STAGE(PG8_SB(0, 1), cB + hstepB, voffB); PG8_STAGE(PG8_SA(0, 0), cA, voffA[0]); PG8_STAGE(PG8_SA(0, 1), cA, voffA[1]);
    if (wr == 1) PG8_BAR;
    PG8_WAIT_V(2); PG8_BAR;
    PG8_STAGE(PG8_SB(1, 0), cB + kstep, voffB); PG8_STAGE(PG8_SA(1, 0), cA + kstep, voffA[0]); PG8_STAGE(PG8_SB(1, 1), cB + hstepB + kstep, voffB);
    PG8_WAIT_V(6); PG8_BAR;
    for (;;) {
        const bool has_next = S.next(ui + 1, nxt);
        const char* nA = has_next ? nxt.A : cA; const char* nB = has_next ? nxt.B : cB;
        if constexpr (Sched::GATHER) {
            if (has_next) {
#pragma unroll
                for (int i = 0; i < 2; ++i) { int R, C; stage_rc(tid * 16 + i * 8192, R, C); nvoffA[0][i] = S.voff(nxt, R, C); nvoffA[1][i] = S.voff(nxt, R + HALF, C); }
            } else {
#pragma unroll
                for (int i = 0; i < 2; ++i) { nvoffA[0][i] = voffA[0][i]; nvoffA[1][i] = voffA[1][i]; }
            }
        }
        for (int t = 0; t < nt; t += 2) {
            const bool last = (t == nt - 2);
            if constexpr (Epi::MIDSCALE) { if (t == nt / 2) E.mid(acc, cur, wr, fr); }
            if (last && has_next) S.a_ready(nxt);
            const char* a1 = cA + (size_t)(t + 1) * kstep;
            const char* a2 = last ? nA : cA + (size_t)(t + 2) * kstep; const char* b2 = last ? nB : cB + (size_t)(t + 2) * kstep;
            const char* a3 = a2 + kstep; const char* b3 = b2 + kstep;
            unsigned va0[2], va1[2];
#pragma unroll
            for (int i = 0; i < 2; ++i) { va0[i] = (Sched::GATHER && last) ? nvoffA[0][i] : voffA[0][i]; va1[i] = (Sched::GATHER && last) ? nvoffA[1][i] : voffA[1][i]; }
            PG8_LDB(B0, 0, 0); PG8_LDB(B1, 0, 1); PG8_SCHED; PG8_LDA(At, 0, 0); PG8_STAGE(PG8_SA(1, 1), a1, voffA[1]);
            PG8_WAIT_V(8); PG8_WAIT_L(0); PG8_BAR; PG8_MMA(0, 0, At, B0); PG8_MMA(0, 1, At, B1); PG8_BAR; PG8_SCHED;
            PG8_LDA(At, 0, 1); PG8_STAGE(PG8_SB(0, 0), b2, voffB); PG8_STAGE(PG8_SB(0, 1), b2 + hstepB, voffB); PG8_STAGE(PG8_SA(0, 0), a2, va0);
            PG8_WAIT_V(8); PG8_WAIT_L(0); PG8_BAR; PG8_MMA(1, 0, At, B0); PG8_MMA(1, 1, At, B1); PG8_BAR; PG8_SCHED;
            PG8_LDB(B0, 1, 0); PG8_LDB(B1, 1, 1); PG8_SCHED; PG8_LDA(At, 1, 0); PG8_STAGE(PG8_SA(0, 1), a2, va1);
            PG8_WAIT_V(8); PG8_WAIT_L(0); PG8_BAR; PG8_MMA(0, 0, At, B0); PG8_MMA(0, 1, At, B1); PG8_BAR; PG8_SCHED;
            PG8_LDA(At, 1, 1); PG8_STAGE(PG8_SB(1, 0), b3, voffB); PG8_STAGE(PG8_SB(1, 1), b3 + hstepB, voffB); PG8_STAGE(PG8_SA(1, 0), a3, va0);
            PG8_WAIT_V(8); PG8_WAIT_L(0); PG8_BAR; PG8_MMA(1, 0, At, B0); PG8_MMA(1, 1, At, B1); PG8_BAR; PG8_SCHED;
        }
        if (wr == 0) PG8_BAR;
        if constexpr (Epi::FP8) {
#define PG8_PIN8(a, b) asm volatile("s_nop 15\n\ts_nop 15" : "+v"(acc[a][b][0][0]), "+v"(acc[a][b][0][1]), "+v"(acc[a][b][1][0]), "+v"(acc[a][b][1][1]), "+v"(acc[a][b][2][0]), "+v"(acc[a][b][2][1]), "+v"(acc[a][b][3][0]), "+v"(acc[a][b][3][1]))
            PG8_PIN8(0, 0); PG8_PIN8(0, 1); PG8_PIN8(1, 0); PG8_PIN8(1, 1);
#undef PG8_PIN8
        }
        { int tz = tid; asm volatile("" : "+v"(tz)); tz &= 511;
          const int wz = __builtin_amdgcn_readfirstlane(tz >> 6), lz = tz & 63; if constexpr (!Epi::AFTER_DRAIN) E(acc, cur, wz >> 2, wz & 3, lz & 15, lz >> 4); }
        if (!has_next) break;
#pragma unroll
        for (int a = 0; a < 2; ++a)
#pragma unroll
            for (int b = 0; b < 2; ++b)
#pragma unroll
                for (int m = 0; m < 4; ++m)
#pragma unroll
                    for (int n = 0; n < 2; ++n) acc[a][b][m][n] = (f32x4){0.f, 0.f, 0.f, 0.f};
        cur = nxt; cA = nA; cB = nB; ++ui;
        if constexpr (Sched::GATHER) {
#pragma unroll
            for (int i = 0; i < 2; ++i) { voffA[0][i] = nvoffA[0][i]; voffA[1][i] = nvoffA[1][i]; }
        }
        if (wr == 1) PG8_BAR;
    }
    PG8_WAIT_V(0);
    PG8_BAR;
    if constexpr (Epi::AFTER_DRAIN) {
        int tz = tid; asm volatile("" : "+v"(tz)); tz &= 511;
        const int wz = __builtin_amdgcn_readfirstlane(tz >> 6), lz = tz & 63; E.fused(acc, cur, wz >> 2, wz & 3, lz & 15, lz >> 4, lds, tz);
    }
#undef PG8_SA
#undef PG8_SB
#undef PG8_STAGE
#undef PG8_LDA
#undef PG8_LDB
#undef PG8_MMA
#undef PG8_WAIT_V
#undef PG8_WAIT_L
#undef PG8_BAR
#undef PG8_SCHED
}


struct EpiInProj {
    static constexpr bool PERM = true, MIDSCALE = false, FP8 = false, AFTER_DRAIN = false;
    bf16_t* zb; bf16_t* AS5;
    DI void operator()(const f32x4 (&acc)[2][2][4][2], const Unit& u, int wr, int wc, int fr, int fq) const {
        const int row0 = u.pm * BM + wr * 64 + fr, col0 = u.pn * BM + wc * 32 + 8 * fq;
#pragma unroll
        for (int ai = 0; ai < 2; ++ai)
#pragma unroll
            for (int m = 0; m < 4; ++m) { const int row = row0 + ai * HALF + m * 16;
#pragma unroll
                for (int bj = 0; bj < 2; ++bj) { const f32x4 v0 = acc[ai][bj][m][0], v1 = acc[ai][bj][m][1]; const int col = col0 + bj * HALF;
                    u32x4 o; o.x = cvt_pk_bf16(v0[0], v0[1]); o.y = cvt_pk_bf16(v0[2], v0[3]); o.z = cvt_pk_bf16(v1[0], v1[1]); o.w = cvt_pk_bf16(v1[2], v1[3]);
                    if (u.pn < 6) *(u32x4*)(zb + (size_t)row * ZLD_ + col) = o;
                    else { const int cs = col - 1536; *(u32x4*)(AS5 + ((size_t)(cs >> 4) * S5R_ + (row >> 4)) * S5K_ + (row & 15) * 16 + (cs & 15)) = o; } } }
    }
};
struct EpiS5E {
    static constexpr bool PERM = false, MIDSCALE = false, FP8 = false, AFTER_DRAIN = false;
    bf16_t* E;
    DI void operator()(const f32x4 (&acc)[2][2][4][2], const Unit& u, int wr, int wc, int fr, int fq) const {
        const int row0 = u.pm * BM + wr * 64 + fr, col0 = wc * 32 + 4 * fq;
#pragma unroll
        for (int ai = 0; ai < 2; ++ai)
#pragma unroll
            for (int m = 0; m < 4; ++m) { bf16_t* rowp = E + ((size_t)u.aux * S5R_ + row0 + ai * HALF + m * 16) * 128 + col0;
#pragma unroll
                for (int n = 0; n < 2; ++n) { const f32x4 v = acc[ai][0][m][n]; u32x2 o; o.x = cvt_pk_bf16(v[0], v[1]); o.y = cvt_pk_bf16(v[2], v[3]); *(u32x2*)(rowp + n * 16) = o; } }
    }
};
struct EpiS5Y {
    static constexpr bool PERM = false, MIDSCALE = false, FP8 = false, AFTER_DRAIN = false;
    bf16_t* gy;
    DI void operator()(const f32x4 (&acc)[2][2][4][2], const Unit& u, int wr, int wc, int fr, int fq) const {
        const int row0 = u.pm * BM + wr * 64 + fr;
#pragma unroll
        for (int ai = 0; ai < 2; ++ai)
#pragma unroll
            for (int m = 0; m < 4; ++m) { const int row = row0 + ai * HALF + m * 16;
#pragma unroll
                for (int bj = 0; bj < 2; ++bj)
#pragma unroll
                    for (int n = 0; n < 2; ++n) { const int j = 8 * bj + 2 * wc + n; const f32x4 v = acc[ai][bj][m][n];
                        u32x2 o; o.x = cvt_pk_bf16(fast_gelu_tanh(v[0]), fast_gelu_tanh(v[1])); o.y = cvt_pk_bf16(fast_gelu_tanh(v[2]), fast_gelu_tanh(v[3]));
                        *(u32x2*)(gy + (size_t)(16 * row + j) * DM_ + 16 * u.aux + 4 * fq) = o; } }
    }
};
struct EpiGlu {
    static constexpr bool PERM = false, MIDSCALE = false, FP8 = false, AFTER_DRAIN = false;
    const bf16_t* gy; const float* b_glu; bf16_t* yb; float* ssqS;
    DI void operator()(const f32x4 (&acc)[2][2][4][2], const Unit& u, int wr, int wc, int fr, int fq) const {
        const int row0 = u.pm * BM + wr * 64 + fr, col0 = u.pn * BM + wc * 32 + 4 * fq;
#pragma unroll
        for (int ai = 0; ai < 2; ++ai)
#pragma unroll
            for (int m = 0; m < 4; ++m) { const int row = row0 + ai * HALF + m * 16; float ss = 0.f;
#pragma unroll
                for (int bj = 0; bj < 2; ++bj)
#pragma unroll
                    for (int n = 0; n < 2; ++n) { const int col = col0 + bj * HALF + n * 16; const f32x4 a = acc[ai][bj][m][n]; const f32x4 bb = *(const f32x4*)(b_glu + col);
                        const u32x2 gv = *(const u32x2*)(gy + (size_t)row * DM_ + col);
                        const float y0 = bflo(gv.x) * fast_sigmoid(a[0] + bb[0]), y1 = bfhi(gv.x) * fast_sigmoid(a[1] + bb[1]), y2 = bflo(gv.y) * fast_sigmoid(a[2] + bb[2]), y3 = bfhi(gv.y) * fast_sigmoid(a[3] + bb[3]);
                        ss += (y0 * y0 + y1 * y1) + (y2 * y2 + y3 * y3);
                        u32x2 o; o.x = cvt_pk_bf16(y0, y1); o.y = cvt_pk_bf16(y2, y3); *(u32x2*)(yb + (size_t)row * D_ + col) = o; }
                ss += __shfl_xor(ss, 16); ss += __shfl_xor(ss, 32);
                if (fq == 0) ssqS[(size_t)row * 8 + u.pn * 4 + wc] = ss; }
    }
};
struct EpiOutProj {
    static constexpr bool PERM = true, MIDSCALE = true, FP8 = false, AFTER_DRAIN = false;
    const bf16_t* xres; const float* ssqS; bf16_t* r1;
    DI void mid(f32x4 (&acc)[2][2][4][2], const Unit& u, int wr, int fr) const {
        const int row0 = u.pm * BM + wr * 64 + fr;
#pragma unroll
        for (int ai = 0; ai < 2; ++ai)
#pragma unroll
            for (int m = 0; m < 4; ++m) { const int row = row0 + ai * HALF + m * 16; const f32x4 s0 = *(const f32x4*)(ssqS + (size_t)row * 8), s1 = *(const f32x4*)(ssqS + (size_t)row * 8 + 4);
                const float rstd = rsqrtf(((s0[0] + s0[1]) + (s0[2] + s0[3]) + (s1[0] + s1[1]) + (s1[2] + s1[3])) * (1.f / DM_) + EPS_);
#pragma unroll
                for (int bj = 0; bj < 2; ++bj)
#pragma unroll
                    for (int n = 0; n < 2; ++n) acc[ai][bj][m][n] = acc[ai][bj][m][n] * rstd; }
    }
    DI void operator()(const f32x4 (&acc)[2][2][4][2], const Unit& u, int wr, int wc, int fr, int fq) const {
        const int row0 = u.pm * BM + wr * 64 + fr, col0 = u.pn * BM + wc * 32 + 8 * fq;
#pragma unroll
        for (int ai = 0; ai < 2; ++ai)
#pragma unroll
            for (int m = 0; m < 4; ++m) { const size_t rb = (size_t)(row0 + ai * HALF + m * 16) * D_ + col0;
#pragma unroll
                for (int bj = 0; bj < 2; ++bj) { const u32x4 xv = *(const u32x4*)(xres + rb + bj * HALF); const f32x4 v0 = acc[ai][bj][m][0], v1 = acc[ai][bj][m][1];
                    u32x4 o; o.x = cvt_pk_bf16(ALPHA_ * bflo(xv.x) + v0[0], ALPHA_ * bfhi(xv.x) + v0[1]); o.y = cvt_pk_bf16(ALPHA_ * bflo(xv.y) + v0[2], ALPHA_ * bfhi(xv.y) + v0[3]);
                    o.z = cvt_pk_bf16(ALPHA_ * bflo(xv.z) + v1[0], ALPHA_ * bfhi(xv.z) + v1[1]); o.w = cvt_pk_bf16(ALPHA_ * bflo(xv.w) + v1[2], ALPHA_ * bfhi(xv.w) + v1[3]);
                    *(u32x4*)(r1 + rb + bj * HALF) = o; } }
    }
};
struct EpiOutLn {
    static constexpr bool PERM = true, MIDSCALE = true, FP8 = false, AFTER_DRAIN = true;
    const bf16_t* xres; const float* ssqS; const bf16_t* ghl; const float* rtc; const float* ln_g; const float* ln_b;
    float* xch; unsigned* cnt; bf16_t* x1b; unsigned char* x1q; unsigned* cur; int* buf_t; float* buf_w; int* slot_of;
    DI void mid(f32x4 (&acc)[2][2][4][2], const Unit& u, int wr, int fr) const {
        const int row0 = u.pm * BM + wr * 64 + fr;
#pragma unroll
        for (int ai = 0; ai < 2; ++ai)
#pragma unroll
            for (int m = 0; m < 4; ++m) { const int row = row0 + ai * HALF + m * 16; const f32x4 s0 = *(const f32x4*)(ssqS + (size_t)row * 8), s1 = *(const f32x4*)(ssqS + (size_t)row * 8 + 4);
                const float rstd = rsqrtf(((s0[0] + s0[1]) + (s0[2] + s0[3]) + (s1[0] + s1[1]) + (s1[2] + s1[3])) * (1.f / DM_) + EPS_);
#pragma unroll
                for (int bj = 0; bj < 2; ++bj)
#pragma unroll
                    for (int n = 0; n < 2; ++n) acc[ai][bj][m][n] = acc[ai][bj][m][n] * rstd; }
    }
    DI void operator()(const f32x4 (&)[2][2][4][2], const Unit&, int, int, int, int) const {}
    DI void fused(f32x4 (&acc)[2][2][4][2], const Unit& u, int wr, int wc, int fr, int fq, LAS unsigned char* lds, int tid) const {
        LAS float* PT4 = (LAS float*)lds;
        LAS float* MS = (LAS float*)(lds + 81920);
        const int row0 = u.pm * BM + wr * 64 + fr, col0 = u.pn * BM + wc * 32 + 8 * fq;
        u32x4 gtv[6];
#pragma unroll
        for (int i = 0; i < 6; ++i) { const int idx = tid + i * NT_; gtv[i] = *(const u32x4*)(ghl + (size_t)(idx >> 5) * D_ + u.pn * BM + (idx & 31) * 8); }
#pragma unroll
        for (int ai = 0; ai < 2; ++ai) {
#pragma unroll
            for (int m = 0; m < 4; ++m) { const size_t rb = (size_t)(row0 + ai * HALF + m * 16) * D_ + col0;
#pragma unroll
                for (int bj = 0; bj < 2; ++bj) { const u32x4 xv = *(const u32x4*)(xres + rb + bj * HALF); f32x4 v0 = acc[ai][bj][m][0], v1 = acc[ai][bj][m][1];
                    v0[0] += ALPHA_ * bflo(xv.x); v0[1] += ALPHA_ * bfhi(xv.x); v0[2] += ALPHA_ * bflo(xv.y); v0[3] += ALPHA_ * bfhi(xv.y);
                    v1[0] += ALPHA_ * bflo(xv.z); v1[1] += ALPHA_ * bfhi(xv.z); v1[2] += ALPHA_ * bflo(xv.w); v1[3] += ALPHA_ * bfhi(xv.w);
                    acc[ai][bj][m][0] = v0; acc[ai][bj][m][1] = v1; } } }
        asm volatile("" ::: "memory");
        LAS unsigned char* GT = lds + 83968;
        LAS float* LG = (LAS float*)(lds + 134656);
        LAS int* cntL = (LAS int*)(lds + 144896); LAS int* baseL = cntL + 32; LAS int* tokE = baseL + 32; LAS float* tokW = (LAS float*)(tokE + 128);
        if (tid < 32) cntL[tid] = 0;
#pragma unroll
        for (int i = 0; i < 6; ++i) { const int idx = tid + i * NT_; *(LAS u32x4*)(GT + (idx >> 5) * 528 + (idx & 31) * 16) = gtv[i]; }
        __syncthreads();
        const LAS unsigned char* gfrag = GT + fr * 528 + (wc * 32 + 8 * fq) * 2;
        float* xq = xch + (size_t)(u.pm * 4 + u.pn) * 256 * 40;
#pragma unroll
        for (int ai = 0; ai < 2; ++ai) {
#pragma unroll
            for (int m = 0; m < 4; ++m) {
                f32x4 d[3]; d[0] = (f32x4){0.f, 0.f, 0.f, 0.f}; d[1] = d[0]; d[2] = d[0]; float s2 = 0.f;
#pragma unroll
                for (int bj = 0; bj < 2; ++bj) { const f32x4 v0 = acc[ai][bj][m][0], v1 = acc[ai][bj][m][1];
                    u32x4 h, lo; h.x = cvt_pk_bf16(v0[0], v0[1]); h.y = cvt_pk_bf16(v0[2], v0[3]); h.z = cvt_pk_bf16(v1[0], v1[1]); h.w = cvt_pk_bf16(v1[2], v1[3]);
                    lo.x = cvt_pk_bf16(v0[0] - bflo(h.x), v0[1] - bfhi(h.x)); lo.y = cvt_pk_bf16(v0[2] - bflo(h.y), v0[3] - bfhi(h.y));
                    lo.z = cvt_pk_bf16(v1[0] - bflo(h.z), v1[1] - bfhi(h.z)); lo.w = cvt_pk_bf16(v1[2] - bflo(h.w), v1[3] - bfhi(h.w));
                    const bf16x8 ah = __builtin_bit_cast(bf16x8, h), al = __builtin_bit_cast(bf16x8, lo);
#pragma unroll
                    for (int ob = 0; ob < 3; ++ob) { const bf16x8 gh = *(const LAS bf16x8*)(gfrag + ob * 16 * 528 + bj * 256), gl = *(const LAS bf16x8*)(gfrag + (48 + ob * 16) * 528 + bj * 256);
                        d[ob] = mfma16(gh, ah, d[ob]); d[ob] = mfma16(gl, ah, d[ob]); d[ob] = mfma16(gh, al, d[ob]); }
                    s2 += ((v0[0] * v0[0] + v0[1] * v0[1]) + (v0[2] * v0[2] + v0[3] * v0[3])) + ((v1[0] * v1[0] + v1[1] * v1[1]) + (v1[2] * v1[2] + v1[3] * v1[3])); }
                s2 += __shfl_xor(s2, 16); s2 += __shfl_xor(s2, 32);
                if (fq == 1) d[2][1] = s2;
                LAS float* rp = PT4 + (wc * 128 + wr * 64 + m * 16 + fr) * 40;
                *(LAS f32x4*)(rp + 4 * fq) = d[0]; *(LAS f32x4*)(rp + 16 + 4 * fq) = d[1]; if (fq < 2) *(LAS f32x4*)(rp + 32 + 4 * fq) = d[2];
            }
            __syncthreads();
            for (int idx = tid; idx < 1280; idx += NT_) { const LAS f32x4* q4 = (const LAS f32x4*)PT4 + idx; const f32x4 s = ((q4[0] + q4[1280]) + q4[2560]) + q4[3840];
                unsigned long long* dst = (unsigned long long*)(xq + (size_t)ai * 5120 + (size_t)idx * 4);
                __hip_atomic_store(dst, ((unsigned long long)__float_as_uint(s[1]) << 32) | __float_as_uint(s[0]), __ATOMIC_RELAXED, __HIP_MEMORY_SCOPE_AGENT);
                __hip_atomic_store(dst + 1, ((unsigned long long)__float_as_uint(s[3]) << 32) | __float_as_uint(s[2]), __ATOMIC_RELAXED, __HIP_MEMORY_SCOPE_AGENT); }
            __syncthreads();
        }
        f32x4 gg[2][2], bb[2][2];
#pragma unroll
        for (int bj = 0; bj < 2; ++bj)
#pragma unroll
            for (int n = 0; n < 2; ++n) { gg[bj][n] = *(const f32x4*)(ln_g + col0 + bj * HALF + 4 * n); bb[bj][n] = *(const f32x4*)(ln_b + col0 + bj * HALF + 4 * n); }
        asm volatile("s_waitcnt vmcnt(0)" ::: "memory");
        if (fr == 0 && fq == 0) __hip_atomic_fetch_add(cnt + 16 * u.pm, 1u, __ATOMIC_RELAXED, __HIP_MEMORY_SCOPE_AGENT);
        if (tid < 64) {
            unsigned spins = 0;
            while ((unsigned)__builtin_amdgcn_readfirstlane(__hip_atomic_load(cnt + 16 * u.pm, __ATOMIC_RELAXED, __HIP_MEMORY_SCOPE_AGENT)) < 32u) { __builtin_amdgcn_s_sleep(2); if (++spins > (1u << 22)) break; }
            __builtin_amdgcn_fence(__ATOMIC_ACQUIRE, "agent");
            asm volatile("s_waitcnt vmcnt(0)" ::: "memory");
        }
        __syncthreads();
        const float* xp = xch + (size_t)u.pm * 4 * 256 * 40;
        {
            const int rl = tid >> 3, rr = u.pn * 64 + rl, q = tid & 7;
            f32x4 pa[4], pb[4]; f32x2_ st[4], sm[4];
#pragma unroll
            for (int t = 0; t < 4; ++t) { const float* rec = xp + ((size_t)t * 256 + rr) * 40; pa[t] = *(const f32x4*)(rec + 4 * q); st[t] = *(const f32x2_*)(rec + 36);
                pb[t] = (f32x4){0.f, 0.f, 0.f, 0.f}; if (q == 0) pb[t] = *(const f32x4*)(rec + 32);
                sm[t] = (f32x2_){0.f, 0.f}; if (tid < 256) sm[t] = *(const f32x2_*)(xp + ((size_t)t * 256 + tid) * 40 + 36); }
            const f32x4 cs = *(const f32x4*)(rtc + 4 * q), bw = *(const f32x4*)(rtc + 40 + 4 * q), cs8 = *(const f32x4*)(rtc + 32), bw8 = *(const f32x4*)(rtc + 72);
            const f32x2_ sr = ((st[0] + st[1]) + st[2]) + st[3], sq = ((sm[0] + sm[1]) + sm[2]) + sm[3];
            const float mean = sr[0] * (1.f / D_), rstd = rsqrtf(fmaxf(sr[1] * (1.f / D_) - mean * mean, 0.f) + EPS_);
            const f32x4 sa = ((pa[0] + pa[1]) + pa[2]) + pa[3], sb = ((pb[0] + pb[1]) + pb[2]) + pb[3];
            *(LAS f32x4*)(LG + rl * 40 + 4 * q) = (sa - cs * mean) * rstd + bw;
            if (q == 0) *(LAS f32x4*)(LG + rl * 40 + 32) = (sb - cs8 * mean) * rstd + bw8;
            if (tid < 256) { const float mq = sq[0] * (1.f / D_); MS[2 * tid] = mq; MS[2 * tid + 1] = rsqrtf(fmaxf(sq[1] * (1.f / D_) - mq * mq, 0.f) + EPS_); }
        }
        __syncthreads();
        if (tid < 64) { const LAS float* lg = LG + tid * 40;
            const f32x4 gl = *(const LAS f32x4*)lg; float mx = gl[0]; int gi = 0;
#pragma unroll
            for (int i = 1; i < 4; ++i) if (gl[i] > mx) { mx = gl[i]; gi = i; }
            float se = 0.f;
#pragma unroll
            for (int i = 0; i < 4; ++i) se += expf(gl[i] - mx);
            const float pg = 1.0f / se;
            const f32x4 e0 = *(const LAS f32x4*)(lg + 4 + gi * 8), e1 = *(const LAS f32x4*)(lg + 8 + gi * 8);
            float ev[8];
#pragma unroll
            for (int i = 0; i < 4; ++i) { ev[i] = e0[i]; ev[4 + i] = e1[i]; }
            int i0 = 0;
#pragma unroll
            for (int i = 1; i < 8; ++i) if (ev[i] > ev[i0]) i0 = i;
            int i1 = (i0 == 0) ? 1 : 0;
#pragma unroll
            for (int i = 0; i < 8; ++i) if (i != i0 && ev[i] > ev[i1]) i1 = i;
            const float e1x = expf(ev[i1] - ev[i0]); const float w0 = 1.f / (1.f + e1x), w1 = e1x / (1.f + e1x);
            const int ea = gi * 8 + i0, eb = gi * 8 + i1;
            const int ra = atomicAdd((int*)&cntL[ea], 1), rb = atomicAdd((int*)&cntL[eb], 1);
            tokE[tid * 2] = (ea << 16) | ra; tokE[tid * 2 + 1] = (eb << 16) | rb; tokW[tid * 2] = pg * w0; tokW[tid * 2 + 1] = pg * w1;
        }
        __syncthreads();
        int basev = 0;
        if (tid < 32) { const int cl = cntL[tid]; basev = cl ? (int)atomicAdd(&cur[tid * 16], (unsigned)cl) : 0; }
#pragma unroll
        for (int ai = 0; ai < 2; ++ai)
#pragma unroll
            for (int m = 0; m < 4; ++m) { const int rl = ai * HALF + wr * 64 + m * 16 + fr; const float mean = MS[2 * rl], rstd = MS[2 * rl + 1]; const size_t rb = (size_t)(u.pm * BM + rl) * D_ + col0;
#pragma unroll
                for (int bj = 0; bj < 2; ++bj) { const f32x4 y0 = (acc[ai][bj][m][0] - mean) * rstd * gg[bj][0] + bb[bj][0], y1 = (acc[ai][bj][m][1] - mean) * rstd * gg[bj][1] + bb[bj][1];
                    u32x4 o; o.x = cvt_pk_bf16(y0[0], y0[1]); o.y = cvt_pk_bf16(y0[2], y0[3]); o.z = cvt_pk_bf16(y1[0], y1[1]); o.w = cvt_pk_bf16(y1[2], y1[3]);
                    *(u32x4*)(x1b + rb + bj * HALF) = o;
                    u32x2 q8; q8.x = pack4_fp8(y0[0], y0[1], y0[2], y0[3]); q8.y = pack4_fp8(y1[0], y1[1], y1[2], y1[3]); *(u32x2*)(x1q + rb + bj * HALF) = q8; } }
        if (tid < 32) baseL[tid] = basev;
        __syncthreads();
        if (tid < 128) { const int v = tokE[tid]; const int e = v >> 16, r = baseL[e] + (v & 0xffff); const int token = u.pm * BM + u.pn * 64 + (tid >> 1);
            buf_t[(size_t)e * ECAP_ + r] = token; buf_w[(size_t)e * ECAP_ + r] = tokW[tid]; slot_of[token * 2 + (tid & 1)] = (e << 16) | r; }
    }
};
struct EpiSiluMul {
    static constexpr bool PERM = true, MIDSCALE = false, FP8 = true, AFTER_DRAIN = false;
    unsigned char* Hb; unsigned* done;
    DI void operator()(const f32x4 (&acc)[2][2][4][2], const Unit& u, int wr, int wc, int fr, int fq) const {
        const int row0 = u.pm * BM + wr * 64 + fr, hu0 = u.pn * 128 + wc * 32 + 8 * fq;
#pragma unroll
        for (int ai = 0; ai < 2; ++ai)
#pragma unroll
            for (int m = 0; m < 4; ++m) { unsigned char* rowp = Hb + (size_t)(row0 + ai * HALF + m * 16) * DE_ + hu0;
                const f32x4 g0 = acc[ai][0][m][0] * W8_INV, g1 = acc[ai][0][m][1] * W8_INV, u0 = acc[ai][1][m][0] * W8_INV, u1 = acc[ai][1][m][1] * W8_INV;
                const unsigned lo = pack4_fp8(fast_silu(g0[0]) * u0[0], fast_silu(g0[1]) * u0[1], fast_silu(g0[2]) * u0[2], fast_silu(g0[3]) * u0[3]);
                const unsigned hi = pack4_fp8(fast_silu(g1[0]) * u1[0], fast_silu(g1[1]) * u1[1], fast_silu(g1[2]) * u1[2], fast_silu(g1[3]) * u1[3]);
                __hip_atomic_store((unsigned long long*)rowp, ((unsigned long long)hi << 32) | lo, __ATOMIC_RELAXED, __HIP_MEMORY_SCOPE_AGENT); }
        asm volatile("s_waitcnt vmcnt(0)" ::: "memory");
        if (fr == 0 && fq == 0) __hip_atomic_fetch_add(done + 16 * u.pm, 1u, __ATOMIC_RELAXED, __HIP_MEMORY_SCOPE_AGENT);
    }
};
struct EpiDown {
    static constexpr bool PERM = true, MIDSCALE = false, FP8 = true, AFTER_DRAIN = false;
    unsigned char* O; const float* buf_w; const LAS int* cnt;
    DI void operator()(const f32x4 (&acc)[2][2][4][2], const Unit& u, int wr, int wc, int fr, int fq) const {
        const int e = u.aux >> 7, kb = (u.aux & 127) * 256, ce = cnt[e];
        const int rl0 = wr * 64 + fr, col0 = u.pn * BM + wc * 32 + 8 * fq;
#pragma unroll
        for (int ai = 0; ai < 2; ++ai)
#pragma unroll
            for (int m = 0; m < 4; ++m) { const int rl = rl0 + ai * HALF + m * 16; const float sc = (kb + rl < ce) ? buf_w[(size_t)e * ECAP_ + kb + rl] * (W8_INV * YE_SCALE) : 0.f;
                unsigned char* rowp = O + (size_t)(u.pm * BM + rl) * D_ + col0;
#pragma unroll
                for (int bj = 0; bj < 2; ++bj) { const f32x4 v0 = acc[ai][bj][m][0] * sc, v1 = acc[ai][bj][m][1] * sc;
                    u32x2 o; o.x = pack4_fp8(v0[0], v0[1], v0[2], v0[3]); o.y = pack4_fp8(v1[0], v1[1], v1[2], v1[3]);
                    *(u32x2*)(rowp + bj * HALF) = o; } }
    }
};
struct EpiT {
    static constexpr bool PERM = false, MIDSCALE = false, FP8 = false, AFTER_DRAIN = false;
    bf16_t* Tb; float* ssqT;
    DI void operator()(const f32x4 (&acc)[2][2][4][2], const Unit& u, int wr, int wc, int fr, int fq) const {
        const int row0 = u.pm * BM + wr * 64 + fr, col0 = u.pn * BM + wc * 32 + 4 * fq;
#pragma unroll
        for (int ai = 0; ai < 2; ++ai)
#pragma unroll
            for (int m = 0; m < 4; ++m) { const int row = row0 + ai * HALF + m * 16; float ss = 0.f;
#pragma unroll
                for (int bj = 0; bj < 2; ++bj)
#pragma unroll
                    for (int n = 0; n < 2; ++n) { const f32x4 a = acc[ai][bj][m][n]; ss += (a[0] * a[0] + a[1] * a[1]) + (a[2] * a[2] + a[3] * a[3]);
                        u32x2 o; o.x = cvt_pk_bf16(a[0], a[1]); o.y = cvt_pk_bf16(a[2], a[3]); *(u32x2*)(Tb + (size_t)row * D_ + col0 + bj * HALF + n * 16) = o; }
                ss += __shfl_xor(ss, 16); ss += __shfl_xor(ss, 32);
                if (fq == 0) ssqT[(size_t)row * 16 + u.pn * 4 + wc] = ss; }
    }
};
struct EpiPle {
    static constexpr bool PERM = true, MIDSCALE = false, FP8 = false, AFTER_DRAIN = false;
    const bf16_t* x2b; const bf16_t* Tb; const float* rstdT; const float* b_pg; const float* ple_g; float* xout; bf16_t* xb;
    DI void operator()(const f32x4 (&acc)[2][2][4][2], const Unit& u, int wr, int wc, int fr, int fq) const {
        const int row0 = u.pm * BM + wr * 64 + fr, col0 = u.pn * BM + wc * 32 + 8 * fq;
        f32x4 bp[2][2], pg[2][2];
#pragma unroll
        for (int bj = 0; bj < 2; ++bj)
#pragma unroll
            for (int n = 0; n < 2; ++n) { bp[bj][n] = *(const f32x4*)(b_pg + col0 + bj * HALF + 4 * n); pg[bj][n] = *(const f32x4*)(ple_g + col0 + bj * HALF + 4 * n); }
#pragma unroll
        for (int ai = 0; ai < 2; ++ai)
#pragma unroll
            for (int m = 0; m < 4; ++m) { const int row = row0 + ai * HALF + m * 16; const float rstd = rstdT[row];
#pragma unroll
                for (int bj = 0; bj < 2; ++bj) { const size_t o = (size_t)row * D_ + col0 + bj * HALF;
                    const u32x4 xv = *(const u32x4*)(x2b + o), tv = *(const u32x4*)(Tb + o);
                    const f32x4 a0 = acc[ai][bj][m][0], a1 = acc[ai][bj][m][1];
                    f32x4 r0, r1;
                    r0[0] = bflo(xv.x) + fast_sigmoid(a0[0] + bp[bj][0][0]) * bflo(tv.x) * rstd * pg[bj][0][0]; r0[1] = bfhi(xv.x) + fast_sigmoid(a0[1] + bp[bj][0][1]) * bfhi(tv.x) * rstd * pg[bj][0][1];
                    r0[2] = bflo(xv.y) + fast_sigmoid(a0[2] + bp[bj][0][2]) * bflo(tv.y) * rstd * pg[bj][0][2]; r0[3] = bfhi(xv.y) + fast_sigmoid(a0[3] + bp[bj][0][3]) * bfhi(tv.y) * rstd * pg[bj][0][3];
                    r1[0] = bflo(xv.z) + fast_sigmoid(a1[0] + bp[bj][1][0]) * bflo(tv.z) * rstd * pg[bj][1][0]; r1[1] = bfhi(xv.z) + fast_sigmoid(a1[1] + bp[bj][1][1]) * bfhi(tv.z) * rstd * pg[bj][1][1];
                    r1[2] = bflo(xv.w) + fast_sigmoid(a1[2] + bp[bj][1][2]) * bflo(tv.w) * rstd * pg[bj][1][2]; r1[3] = bfhi(xv.w) + fast_sigmoid(a1[3] + bp[bj][1][3]) * bfhi(tv.w) * rstd * pg[bj][1][3];
                    if (xout) { *(f32x4*)(xout + o) = r0; *(f32x4*)(xout + o + 4) = r1; }
                    else { u32x4 ob; ob.x = cvt_pk_bf16(r0[0], r0[1]); ob.y = cvt_pk_bf16(r0[2], r0[3]); ob.z = cvt_pk_bf16(r1[0], r1[1]); ob.w = cvt_pk_bf16(r1[2], r1[3]); *(u32x4*)(xb + o) = ob; } } }
    }
};

struct Ctx { int G, bid, tid, lane, w; };
DI const float* IN(PR p, int i) { return p.in[i]; }
template <class T> DI T* WSP(PR p, size_t off) { return (T*)(p.ws + off); }

struct TJob { const float* src0; const float* src1; bf16_t* dst; int ldw, K, N, mode, nmat, krot, kscale_n, fp8; size_t sstr, dstr, kstr; float scale; const float* kscale; };
DI void transpose_job(const TJob& j, int gwave, int nwaves, LAS float* scr, int lane) {
    const int nkb = j.K / 64, nnb = j.N / 32; const long per = (long)nkb * nnb, total = per * j.nmat;
    for (long it = gwave; it < total; it += nwaves) {
        const int mat = (int)(it / per); const int r = (int)(it % per); const int kb = r / nnb, nb = r % nnb, k0 = kb * 64, n0 = nb * 32;
        const int n = n0 + (lane & 31);
        const float* sp; int col;
        if (j.mode == 2) { const int blk = n >> 7; sp = (const float*)((const char*)j.src0 + (ptrdiff_t)(blk & 1) * ((const char*)j.src1 - (const char*)j.src0)); col = 128 * (blk >> 1) + (n & 127); }
        else { sp = j.src0; col = n + ((j.mode == 1 && n >= 1536) ? 8 : 0); }
        sp += (size_t)mat * j.sstr + col;
#pragma unroll
        for (int i = 0; i < 32; ++i) { const int kk = 2 * i + (lane >> 5); const int kd = k0 + kk; const int ksrc = (kd + j.krot) & (j.K - 1);
            float v = sp[(size_t)ksrc * j.ldw] * j.scale; if (j.kscale && kd < j.kscale_n) v *= j.kscale[(size_t)mat * j.kstr + kd];
            scr[kk * 33 + (lane & 31)] = v; }
        __builtin_amdgcn_s_waitcnt(0xC07F); __builtin_amdgcn_wave_barrier();
        const int c = lane & 7;
        bf16_t* d = j.dst + (size_t)mat * j.dstr;
#pragma unroll
        for (int jj = 0; jj < 4; ++jj) { const int nn = (lane >> 3) + 8 * jj; const LAS float* s = scr + (8 * c) * 33 + nn;
            if (j.fp8) { u32x2 o8; o8.x = pack4_fp8(s[0 * 33], s[1 * 33], s[2 * 33], s[3 * 33]); o8.y = pack4_fp8(s[4 * 33], s[5 * 33], s[6 * 33], s[7 * 33]);
                *(u32x2*)((unsigned char*)j.dst + (size_t)mat * j.dstr + (size_t)(n0 + nn) * j.K + k0 + 8 * c) = o8; }
            else { u32x4 o; o.x = cvt_pk_bf16(s[0 * 33], s[1 * 33]); o.y = cvt_pk_bf16(s[2 * 33], s[3 * 33]); o.z = cvt_pk_bf16(s[4 * 33], s[5 * 33]); o.w = cvt_pk_bf16(s[6 * 33], s[7 * 33]);
                *(u32x4*)(d + (size_t)(n0 + nn) * j.K + k0 + 8 * c) = o; } }
        __builtin_amdgcn_s_waitcnt(0xC07F); __builtin_amdgcn_wave_barrier();
    }
}
DI TJob mk_job(const float* s0, const float* s1, int ldw, int K, int N, bf16_t* dst, int mode, int nmat, size_t sstr, size_t dstr, float scale = 1.f) {
    TJob j; j.src0 = s0; j.src1 = s1; j.dst = dst; j.ldw = ldw; j.K = K; j.N = N; j.mode = mode; j.nmat = nmat; j.krot = 0; j.kscale_n = 0; j.fp8 = 0; j.sstr = sstr; j.dstr = dstr; j.kstr = 0; j.scale = scale; j.kscale = nullptr; return j;
}
DI void cvt_rows(const float* __restrict__ src, bf16_t* __restrict__ dst, size_t n8, size_t gt, size_t nthreads) {
    for (size_t i = gt; i < n8; i += nthreads) { const f32x4 a = ((const f32x4*)src)[2 * i], b = ((const f32x4*)src)[2 * i + 1];
        u32x4 o; o.x = cvt_pk_bf16(a[0], a[1]); o.y = cvt_pk_bf16(a[2], a[3]); o.z = cvt_pk_bf16(b[0], b[1]); o.w = cvt_pk_bf16(b[2], b[3]); ((u32x4*)dst)[i] = o; }
}
DI void moe_weight_jobs(PR p, const Ctx& c, int l, LAS unsigned char* lds, bool probe_dummy = false) {
    LAS float* scr = (LAS float*)(lds + c.w * 8448);
    const int gwave = c.bid * 4 + (c.w - 4), nwaves = c.G * 4;
    { TJob j = mk_job(IN(p, 28) + (size_t)l * NE_ * D_ * DE_, IN(p, 29) + (size_t)l * NE_ * D_ * DE_, DE_, D_, D_, probe_dummy ? WSP<bf16_t>(p, WS_YE) : WSP<bf16_t>(p, WS_WGU), 2, NE_, (size_t)D_ * DE_, (size_t)D_ * D_, W8_SCALE); j.fp8 = 1;
      transpose_job(j, gwave, nwaves, scr, c.lane); }
    { TJob j = mk_job(IN(p, 30) + (size_t)l * NE_ * DE_ * D_, nullptr, D_, DE_, D_, probe_dummy ? WSP<bf16_t>(p, WS_YE) + (size_t)NE_ * D_ * D_ / 2 : WSP<bf16_t>(p, WS_WED), 0, NE_, (size_t)DE_ * D_, (size_t)D_ * DE_, W8_SCALE); j.fp8 = 1;
      transpose_job(j, gwave, nwaves, scr, c.lane); }
}

DI void s5_prep_job(PR p, int lg, LAS unsigned char* lds, int tid) {
    LAS float* apr = (LAS float*)lds;
    LAS float* api = apr + 17 * 64;
    LAS float* bbr = api + 17 * 64;
    LAS float* bbi = bbr + 1024;
    LAS float* ccr = bbi + 1024;
    LAS float* cci = ccr + 16 * 68;
    LAS float* kd = cci + 16 * 68;
    const float* lam_re = IN(p, 10); const float* lam_im = IN(p, 11); const float* b_re = IN(p, 13); const float* b_im = IN(p, 14); const float* c_re = IN(p, 15); const float* c_im = IN(p, 16);
    const float dt = expf(IN(p, 12)[lg]);
    __syncthreads();
    for (int idx = tid; idx < 17 * 64; idx += NT_) { const int pp = idx & 63, d = idx >> 6; const float lr = lam_re[lg * 64 + pp], li = lam_im[lg * 64 + pp];
        const float er = expf((float)d * lr * dt), ang = (float)d * li * dt; apr[d * 64 + pp] = er * cosf(ang); api[d * 64 + pp] = er * sinf(ang); }
    for (int idx = tid; idx < 1024; idx += NT_) { const int pp = idx >> 4, ci = idx & 15; const float lr = lam_re[lg * 64 + pp], li = lam_im[lg * 64 + pp];
        const float er = expf(lr * dt), ar = er * cosf(li * dt), ai = er * sinf(li * dt); const float mag2 = lr * lr + li * li, xr0 = ar - 1.f, xi0 = ai;
        const float cr = (xr0 * lr + xi0 * li) / mag2, cim = (xi0 * lr - xr0 * li) / mag2; const float br = b_re[(size_t)(lg * 64 + pp) * 16 + ci], bi = b_im[(size_t)(lg * 64 + pp) * 16 + ci];
        bbr[pp * 16 + ci] = cr * br - cim * bi; bbi[pp * 16 + ci] = cr * bi + cim * br; }
    for (int idx = tid; idx < 1024; idx += NT_) { ccr[(idx >> 6) * 68 + (idx & 63)] = c_re[(size_t)lg * 1024 + idx]; cci[(idx >> 6) * 68 + (idx & 63)] = c_im[(size_t)lg * 1024 + idx]; }
    __syncthreads();
    {
        const int d = tid >> 5, co = (tid >> 1) & 15, hf = tid & 1; f32x4 v0 = (f32x4){0.f, 0.f, 0.f, 0.f}, v1 = v0;
        for (int pp = 0; pp < 64; ++pp) { const float ar = apr[d * 64 + pp], ai = api[d * 64 + pp], cr = ccr[co * 68 + pp], ci_ = cci[co * 68 + pp];
            const float wr_ = cr * ar - ci_ * ai, wi_ = cr * ai + ci_ * ar;
            const f32x4 r0 = *(const LAS f32x4*)(bbr + pp * 16 + hf * 8), r1 = *(const LAS f32x4*)(bbr + pp * 16 + hf * 8 + 4), i0 = *(const LAS f32x4*)(bbi + pp * 16 + hf * 8), i1 = *(const LAS f32x4*)(bbi + pp * 16 + hf * 8 + 4);
            v0 = v0 + r0 * wr_ - i0 * wi_; v1 = v1 + r1 * wr_ - i1 * wi_; }
        if (d == 0) { const float dsk = IN(p, 17)[lg * 16 + co];
#pragma unroll
            for (int e = 0; e < 4; ++e) { if (co == hf * 8 + e) v0[e] += dsk; if (co == hf * 8 + 4 + e) v1[e] += dsk; } }
        *(LAS f32x4*)(kd + (d * 16 + co) * 16 + hf * 8) = v0; *(LAS f32x4*)(kd + (d * 16 + co) * 16 + hf * 8 + 4) = v1; }
    __syncthreads();
    bf16_t* wy = WSP<bf16_t>(p, WS_WYT) + (size_t)lg * 256 * S5K_;
    for (int idx = tid; idx < 256 * 48; idx += NT_) { const int n = idx / 48, kc = idx % 48, j = n >> 4, co = n & 15; f32x4 v0 = (f32x4){0.f, 0.f, 0.f, 0.f}, v1 = v0;
        if (kc < 32) { const int i = kc >> 1, ci0 = (kc & 1) * 8; if (i <= j) { v0 = *(const LAS f32x4*)(kd + ((j - i) * 16 + co) * 16 + ci0); v1 = *(const LAS f32x4*)(kd + ((j - i) * 16 + co) * 16 + ci0 + 4); } }
        else { const int kk0 = (kc - 32) * 8, pp0 = kk0 & 63;
            const f32x4 c0r = *(const LAS f32x4*)(ccr + co * 68 + pp0), c1r = *(const LAS f32x4*)(ccr + co * 68 + pp0 + 4), c0i = *(const LAS f32x4*)(cci + co * 68 + pp0), c1i = *(const LAS f32x4*)(cci + co * 68 + pp0 + 4);
            const f32x4 a0r = *(const LAS f32x4*)(apr + (j + 1) * 64 + pp0), a1r = *(const LAS f32x4*)(apr + (j + 1) * 64 + pp0 + 4), a0i = *(const LAS f32x4*)(api + (j + 1) * 64 + pp0), a1i = *(const LAS f32x4*)(api + (j + 1) * 64 + pp0 + 4);
            if (kk0 < 64) { v0 = c0r * a0r - c0i * a0i; v1 = c1r * a1r - c1i * a1i; } else { v0 = -(c0r * a0i + c0i * a0r); v1 = -(c1r * a1i + c1i * a1r); } }
        u32x4 o; o.x = cvt_pk_bf16(v0[0], v0[1]); o.y = cvt_pk_bf16(v0[2], v0[3]); o.z = cvt_pk_bf16(v1[0], v1[1]); o.w = cvt_pk_bf16(v1[2], v1[3]);
        *(u32x4*)(wy + (size_t)n * S5K_ + kc * 8) = o; }
    bf16_t* we = WSP<bf16_t>(p, WS_WET) + (size_t)lg * 256 * 256;
    for (int idx = tid; idx < 256 * 32; idx += NT_) { const int n = idx >> 5, kc = idx & 31; f32x4 v0 = (f32x4){0.f, 0.f, 0.f, 0.f}, v1 = v0;
        if (n < 128) { const int pp = n & 63, i = kc >> 1, ci0 = (kc & 1) * 8; const float ar = apr[(15 - i) * 64 + pp], ai = api[(15 - i) * 64 + pp];
            const f32x4 r0 = *(const LAS f32x4*)(bbr + pp * 16 + ci0), r1 = *(const LAS f32x4*)(bbr + pp * 16 + ci0 + 4), i0 = *(const LAS f32x4*)(bbi + pp * 16 + ci0), i1 = *(const LAS f32x4*)(bbi + pp * 16 + ci0 + 4);
            if (n < 64) { v0 = r0 * ar - i0 * ai; v1 = r1 * ar - i1 * ai; } else { v0 = i0 * ar + r0 * ai; v1 = i1 * ar + r1 * ai; } }
        u32x4 o; o.x = cvt_pk_bf16(v0[0], v0[1]); o.y = cvt_pk_bf16(v0[2], v0[3]); o.z = cvt_pk_bf16(v1[0], v1[1]); o.w = cvt_pk_bf16(v1[2], v1[3]);
        *(u32x4*)(we + (size_t)n * 256 + kc * 8) = o; }
    if (tid < 64) { float* A16 = WSP<float>(p, WS_A16); A16[(size_t)lg * 128 + tid] = apr[16 * 64 + tid]; A16[(size_t)lg * 128 + 64 + tid] = api[16 * 64 + tid]; }
}

DI void ph_prologue(PR p, const Ctx& c, LAS unsigned char* lds, int sel = 15) {
    const size_t gt = (size_t)c.bid * NT_ + c.tid, nth = (size_t)c.G * NT_;
    if (sel & 1) {
    cvt_rows(IN(p, 0), WSP<bf16_t>(p, WS_XB), (size_t)M_ * D_ / 8, gt, nth);
    cvt_rows(IN(p, 1), WSP<bf16_t>(p, WS_PBF), (size_t)L_ * M_ * PLE_ / 8, gt, nth);
    }
    if (sel & 2) {
    { bf16_t* wg = WSP<bf16_t>(p, WS_WGATE); const float* w_in = IN(p, 2);
      for (size_t i = gt; i < (size_t)L_ * 16 * D_; i += nth) { const int k = (int)(i % D_), n = (int)((i / D_) % 16), l = (int)(i / (16 * D_));
          wg[i] = (n < 8) ? f2bf(w_in[((size_t)l * D_ + k) * DIN_ + 1536 + n]) : (bf16_t)0; } }
    { bf16_t* ghl = WSP<bf16_t>(p, WS_GHL); const float* w_grp = IN(p, 24); const float* w_rt = IN(p, 26); const float* lng = IN(p, 22);
      for (size_t i = gt; i < (size_t)L_ * 48 * D_; i += nth) { const int k = (int)(i % D_), o = (int)((i / D_) % 48), l = (int)(i / (48 * D_));
          const float gk = lng[(size_t)l * D_ + k];
          const float v = (o < 4) ? w_grp[((size_t)l * D_ + k) * 4 + o] * gk : (o < 36) ? w_rt[((size_t)l * D_ + k) * 32 + (o - 4)] * gk : (o == 36 ? 1.f : 0.f);
          const bf16_t h = f2bf(v); ghl[((size_t)(l * 2) * 48 + o) * D_ + k] = h; ghl[((size_t)(l * 2 + 1) * 48 + o) * D_ + k] = f2bf(v - bf2f(h)); } }
    { float* rtc = WSP<float>(p, WS_RTC); const float* w_grp = IN(p, 24); const float* w_rt = IN(p, 26); const float* lng = IN(p, 22); const float* lnb = IN(p, 23);
      for (int job = c.bid * 8 + c.w; job < L_ * 40; job += c.G * 8) { const int l = job / 40, o = job % 40; float cs = 0.f, bw = 0.f;
          if (o < 36) { for (int k = c.lane; k < D_; k += 64) { const float wv = (o < 4) ? w_grp[((size_t)l * D_ + k) * 4 + o] : w_rt[((size_t)l * D_ + k) * 32 + (o - 4)];
                  cs += wv * lng[(size_t)l * D_ + k]; bw += wv * lnb[(size_t)l * D_ + k]; }
              cs = wave_sum(cs); bw = wave_sum(bw) + ((o < 4) ? IN(p, 25)[l * 4 + o] : IN(p, 27)[l * 32 + o - 4]); }
          if (c.lane == 0) { rtc[(l * 2) * 40 + o] = cs; rtc[(l * 2 + 1) * 40 + o] = bw; } } }
    }
    LAS float* scr = (LAS float*)(lds + c.w * 8448);
    const int gwave = c.bid * 8 + c.w, nwaves = c.G * 8;
    const bool split = (sel == 15) && (c.G >= 2 * L_ * G5_);
    if (split) {
        if (c.bid < L_ * G5_) { s5_prep_job(p, c.bid, lds, c.tid); __syncthreads(); }
        else transpose_job(mk_job(IN(p, 2), nullptr, DIN_, D_, 2048, WSP<bf16_t>(p, WS_WIN), 1, L_, (size_t)D_ * DIN_, (size_t)2048 * D_), (c.bid - L_ * G5_) * 8 + c.w, (c.G - L_ * G5_) * 8, scr, c.lane);
    }
    if (sel & 4) {
    if (!split) transpose_job(mk_job(IN(p, 2), nullptr, DIN_, D_, 2048, WSP<bf16_t>(p, WS_WIN), 1, L_, (size_t)D_ * DIN_, (size_t)2048 * D_), gwave, nwaves, scr, c.lane);
    { TJob j = mk_job(IN(p, 21), nullptr, D_, D_, D_, WSP<bf16_t>(p, WS_WOUT), 0, L_, (size_t)D_ * D_, (size_t)D_ * D_); j.krot = 512; j.kscale = IN(p, 20); j.kscale_n = 512; j.kstr = DM_;
      transpose_job(j, gwave, nwaves, scr, c.lane); }
    transpose_job(mk_job(IN(p, 33), nullptr, D_, D_, D_, WSP<bf16_t>(p, WS_WPG), 0, L_, (size_t)D_ * D_, (size_t)D_ * D_), gwave, nwaves, scr, c.lane);
    transpose_job(mk_job(IN(p, 35), nullptr, D_, PLE_, D_, WSP<bf16_t>(p, WS_WPP), 0, L_, (size_t)PLE_ * D_, (size_t)D_ * PLE_), gwave, nwaves, scr, c.lane);
    transpose_job(mk_job(IN(p, 18), nullptr, DM_, DM_, DM_, WSP<bf16_t>(p, WS_WGLU), 0, L_, (size_t)DM_ * DM_, (size_t)DM_ * DM_), gwave, nwaves, scr, c.lane);
    transpose_job(mk_job(IN(p, 5), nullptr, DH_, DH_, DH_, WSP<bf16_t>(p, WS_WQK), 0, L_ * H_, (size_t)DH_ * DH_, (size_t)256 * DH_), gwave, nwaves, scr, c.lane);
    transpose_job(mk_job(IN(p, 6), nullptr, DH_, DH_, DH_, WSP<bf16_t>(p, WS_WQK) + (size_t)DH_ * DH_, 0, L_ * H_, (size_t)DH_ * DH_, (size_t)256 * DH_, 0.08838834764831845f), gwave, nwaves, scr, c.lane);
    }
    if ((sel & 8) && !split) { for (int job = c.bid; job < L_ * G5_; job += c.G) { s5_prep_job(p, job, lds, c.tid); __syncthreads(); } }
}

DI void ph_inproj(PR p, const Ctx& c, int l, LAS unsigned char* lds) {
    DenseOrder S; S.init(WSP<bf16_t>(p, WS_XB), WSP<bf16_t>(p, WS_WIN) + (size_t)l * 2048 * D_, D_ * 2, D_ * 2, M_, 2048, c.G, c.bid);
    EpiInProj E{WSP<bf16_t>(p, WS_ZB), WSP<bf16_t>(p, WS_AS5)};
    gemm_phase<EpiInProj, DenseOrder>(lds, Gemm{(unsigned)(D_ * 2), (unsigned)(D_ * 2), D_}, S, E);
}

DI void mlstm_sum_unit(PR p, const Ctx& c, int l, int unit, LAS unsigned char* lds) {
    LAS unsigned char* ctile = lds;
    LAS unsigned char* ktile = lds + 32768;
    LAS unsigned char* vtile = lds + 65536;
    LAS float* wsS = (LAS float*)(lds + 98304);
    LAS float* gred = wsS + 256;
    const bf16_t* zb = WSP<bf16_t>(p, WS_ZB); const bf16_t* xb = WSP<bf16_t>(p, WS_XB); const bf16_t* wgate = WSP<bf16_t>(p, WS_WGATE) + (size_t)l * 16 * D_;
    const bf16_t* wqkT = WSP<bf16_t>(p, WS_WQK) + (size_t)l * H_ * 256 * DH_;
    const float* cw = IN(p, 3) + (size_t)l * 4 * DM_; const float* cb = IN(p, 4) + (size_t)l * DM_; const float* b_i = IN(p, 7) + l * H_; const float* b_f = IN(p, 8) + l * H_;
    bf16_t* cvb = WSP<bf16_t>(p, WS_QB); bf16_t* Csum = WSP<bf16_t>(p, WS_CSUM); float* nsum = WSP<float>(p, WS_NSUM);
    float* gG = WSP<float>(p, WS_GG); float* mlG = WSP<float>(p, WS_MLG); float* igG = WSP<float>(p, WS_IGG); float* bcumG = WSP<float>(p, WS_BCUM);
    const int tid = c.tid, lane = c.lane, w = c.w, fr = lane & 15, fq = lane >> 4, hh = w >> 2, wq = w & 3;
    const int b = unit / (S_ / 64), cc = unit % (S_ / 64); const int tok0 = b * S_ + cc * 64;
    __syncthreads();
    {
        f32x4 ga[4];
#pragma unroll
        for (int ms = 0; ms < 4; ++ms) ga[ms] = (f32x4){0.f, 0.f, 0.f, 0.f};
#pragma unroll
        for (int kk = 0; kk < 4; ++kk) { const int ks = 4 * w + kk; const bf16x8 bw = ld_frag_g(wgate + (size_t)fr * D_ + 32 * ks + 8 * fq);
#pragma unroll
            for (int ms = 0; ms < 4; ++ms) { const bf16x8 af = ld_frag_g(xb + (size_t)(tok0 + 16 * ms + fr) * D_ + 32 * ks + 8 * fq); ga[ms] = mfma16(af, bw, ga[ms]); } }
#pragma unroll
        for (int ms = 0; ms < 4; ++ms)
#pragma unroll
            for (int r = 0; r < 4; ++r) gred[(w * 64 + 16 * ms + 4 * fq + r) * 16 + fr] = ga[ms][r];
    }
    __syncthreads();
    if (w < 4) {
        const int h = w; const int tok = tok0 + lane; float ip = 0.f, fp = 0.f;
#pragma unroll
        for (int ww = 0; ww < 8; ++ww) { ip += gred[(ww * 64 + lane) * 16 + h]; fp += gred[(ww * 64 + lane) * 16 + 4 + h]; }
        const float ig = ip + b_i[h]; const float lf = log_sigmoid_(fp + b_f[h]);
        float cum = lf;
#pragma unroll
        for (int o = 1; o < 64; o <<= 1) { const float t = __shfl_up(cum, o); if (lane >= o) cum += t; }
        const float g = __shfl(cum, 63); const float a = g - cum + ig;
        float mx = a;
#pragma unroll
        for (int o = 32; o > 0; o >>= 1) mx = fmaxf(mx, __shfl_xor(mx, o));
        wsS[h * 64 + lane] = __expf(a - mx);
        igG[(size_t)tok * 4 + h] = ig; bcumG[(size_t)tok * 4 + h] = cum;
        if (lane == 0) { gG[(b * H_ + h) * 32 + cc] = g; mlG[(b * H_ + h) * 32 + cc] = mx; }
    }
    for (int rd = 0; rd < 2; ++rd) {
        for (int it = tid; it < 2048; it += NT_) { const int hq = it >> 10, sr = (it >> 4) & 63, cg = it & 15; const int t = cc * 64 + sr; const int ch0 = (2 * rd + hq) * DH_ + cg * 8;
            float a[8];
#pragma unroll
            for (int e = 0; e < 8; ++e) a[e] = cb[ch0 + e];
#pragma unroll
            for (int j = 0; j < 4; ++j) { if (t - 3 + j >= 0) { const u32x4 uv = *(const u32x4*)(zb + (size_t)(tok0 + sr - 3 + j) * ZLD_ + ch0);
                    const float* wj = cw + j * DM_ + ch0;
                    a[0] += wj[0] * bflo(uv.x); a[1] += wj[1] * bfhi(uv.x); a[2] += wj[2] * bflo(uv.y); a[3] += wj[3] * bfhi(uv.y);
                    a[4] += wj[4] * bflo(uv.z); a[5] += wj[5] * bfhi(uv.z); a[6] += wj[6] * bflo(uv.w); a[7] += wj[7] * bfhi(uv.w); } }
            u32x4 o; o.x = cvt_pk_bf16(fast_silu(a[0]), fast_silu(a[1])); o.y = cvt_pk_bf16(fast_silu(a[2]), fast_silu(a[3])); o.z = cvt_pk_bf16(fast_silu(a[4]), fast_silu(a[5])); o.w = cvt_pk_bf16(fast_silu(a[6]), fast_silu(a[7]));
            *(LAS u32x4*)(ctile + hq * 16384 + off_b(sr, cg)) = o; *(u32x4*)(cvb + (size_t)(tok0 + sr) * DM_ + ch0) = o;
            *(LAS u32x4*)(vtile + hq * 16384 + off_b(sr, cg)) = *(const u32x4*)(zb + (size_t)(tok0 + sr) * ZLD_ + 512 + ch0);
        }
        __syncthreads();
        const int h = 2 * rd + hh;
        const LAS unsigned char* ct = ctile + hh * 16384; LAS unsigned char* kt = ktile + hh * 16384; const LAS unsigned char* vt = vtile + hh * 16384;
        if (wq >= 2) {
            f32x4 acc[4][4];
#pragma unroll
            for (int ms = 0; ms < 4; ++ms)
#pragma unroll
                for (int i = 0; i < 4; ++i) acc[ms][i] = (f32x4){0.f, 0.f, 0.f, 0.f};
#pragma unroll
            for (int ks = 0; ks < 4; ++ks) {
                bf16x8 wf[4];
#pragma unroll
                for (int i = 0; i < 4; ++i) wf[i] = ld_frag_g(wqkT + ((size_t)(h * 256 + 16 * (4 * wq + i) + fr)) * DH_ + 32 * ks + 8 * fq);
#pragma unroll
                for (int ms = 0; ms < 4; ++ms) { const bf16x8 cf = tile_row_read(ct, lane, ms, ks);
#pragma unroll
                    for (int i = 0; i < 4; ++i) acc[ms][i] = mfma16(wf[i], cf, acc[ms][i]); }
            }
#pragma unroll
            for (int ms = 0; ms < 4; ++ms) { const int sr = 16 * ms + fr; const float wsv = wsS[h * 64 + sr];
#pragma unroll
                for (int i = 0; i < 4; ++i) { const int nf = 4 * wq + i; const f32x4 v = acc[ms][i];
                    u32x2 o; o.x = cvt_pk_bf16(v[0], v[1]); o.y = cvt_pk_bf16(v[2], v[3]);
                    const f32x4 kr = (f32x4){bflo(o.x), bfhi(o.x), bflo(o.y), bfhi(o.y)};
                    { const int col = 16 * (nf - 8) + 4 * fq;
                        u32x2 o2; o2.x = cvt_pk_bf16(v[0] * wsv, v[1] * wsv); o2.y = cvt_pk_bf16(v[2] * wsv, v[3] * wsv); (void)kr;
                        *(LAS u32x2*)(kt + off_b(sr, col >> 3) + 2 * (col & 7)) = o2; } } }
        }
        __syncthreads();
        {
            f32x4 acc[2][8];
#pragma unroll
            for (int i = 0; i < 2; ++i)
#pragma unroll
                for (int nd = 0; nd < 8; ++nd) acc[i][nd] = (f32x4){0.f, 0.f, 0.f, 0.f};
#pragma unroll
            for (int ks = 0; ks < 2; ++ks) {
                s16x4 va[2][2], kbq[8][2];
                tile_tr_read4(tr_addr(vt, lane, 32 * ks + 8 * fq, 2 * wq), tr_addr(vt, lane, 32 * ks + 8 * fq + 4, 2 * wq), tr_addr(vt, lane, 32 * ks + 8 * fq, 2 * wq + 1), tr_addr(vt, lane, 32 * ks + 8 * fq + 4, 2 * wq + 1),
                              va[0][0], va[0][1], va[1][0], va[1][1]);
#pragma unroll
                for (int nd = 0; nd < 8; nd += 2)
                    tile_tr_read4(tr_addr(kt, lane, 32 * ks + 8 * fq, nd), tr_addr(kt, lane, 32 * ks + 8 * fq + 4, nd), tr_addr(kt, lane, 32 * ks + 8 * fq, nd + 1), tr_addr(kt, lane, 32 * ks + 8 * fq + 4, nd + 1),
                                  kbq[nd][0], kbq[nd][1], kbq[nd + 1][0], kbq[nd + 1][1]);
#pragma unroll
                for (int nd = 0; nd < 8; ++nd) { const bf16x8 kf = cat8(kbq[nd][0], kbq[nd][1]);
#pragma unroll
                    for (int i = 0; i < 2; ++i) acc[i][nd] = mfma16(kf, cat8(va[i][0], va[i][1]), acc[i][nd]); }
            }
            bf16_t* Cp = Csum + ((size_t)((b * H_ + h) * 32 + cc)) * DH_ * DH_;
#pragma unroll
            for (int i = 0; i < 2; ++i)
#pragma unroll
                for (int nd = 0; nd < 8; ++nd) { u32x2 o; o.x = cvt_pk_bf16(acc[i][nd][0], acc[i][nd][1]); o.y = cvt_pk_bf16(acc[i][nd][2], acc[i][nd][3]); *(u32x2*)(Cp + (size_t)(16 * (2 * wq + i) + fr) * DH_ + 16 * nd + 4 * fq) = o; }
            if ((tid & 255) < DH_) { float sacc = 0.f; const int d = tid & 255;
                for (int sr = 0; sr < 64; ++sr) sacc += bf2f(*(const LAS bf16_t*)(kt + off_b(sr, d >> 3) + 2 * (d & 7)));
                nsum[((size_t)((b * H_ + h) * 32 + cc)) * DH_ + d] = sacc; }
        }
        __syncthreads();
    }
}
DI void ph_mix1(PR p, const Ctx& c, int l, LAS unsigned char* lds) {
    for (int unit = c.bid; unit < NB_ * (S_ / 64); unit += c.G) mlstm_sum_unit(p, c, l, unit, lds);
    __syncthreads();
    GroupOrder S; S.A = (const char*)WSP<bf16_t>(p, WS_AS5); S.B = (const char*)(WSP<bf16_t>(p, WS_WET) + (size_t)l * G5_ * 256 * 256); S.astride = (size_t)S5R_ * S5K_ * 2; S.bstride = (size_t)256 * 256 * 2;
    S.lda = S5K_ * 2; S.nunits = G5_ * 4; S.G = c.G; S.c = (c.bid + c.G / 2) % c.G;
    EpiS5E E{WSP<bf16_t>(p, WS_ESUM)};
    gemm_phase<EpiS5E, GroupOrder>(lds, Gemm{(unsigned)(S5K_ * 2), 512u, 256}, S, E);
}

DI void ph_scan(PR p, const Ctx& c, int l, LAS unsigned char* lds) {
    const bf16_t* Csum = WSP<bf16_t>(p, WS_CSUM); const float* nsum = WSP<float>(p, WS_NSUM); const float* gG = WSP<float>(p, WS_GG); const float* mlG = WSP<float>(p, WS_MLG);
    bf16_t* CprevT = WSP<bf16_t>(p, WS_CPREV); float* nprev = WSP<float>(p, WS_NPREV); float* mprev = WSP<float>(p, WS_MPREV);
    const bf16_t* Esum = WSP<bf16_t>(p, WS_ESUM); const float* A16 = WSP<float>(p, WS_A16) + (size_t)l * G5_ * 128; bf16_t* AS5 = WSP<bf16_t>(p, WS_AS5);
    constexpr int NC1 = NB_ * H_ * DH_ * (DH_ / 4), NC2 = NC1 + NB_ * H_ * DH_, NC3 = NC2 + NB_ * G5_ * P5_;
    if (c.w < 4) for (int gid = c.bid * 256 + c.tid; gid < NC3; gid += c.G * 256) {
        if (gid < NC1) {
            const int bh = gid / (DH_ * DH_ / 4), r = gid % (DH_ * DH_ / 4);
            f32x4 C = (f32x4){0.f, 0.f, 0.f, 0.f}; float m = 0.f;
            const size_t base0 = ((size_t)bh * 32) * DH_ * DH_ + (size_t)r * 4;
#pragma unroll 1
            for (int c8 = 0; c8 < 32; c8 += 8) {
                f32x4 cv[8]; float gv[8], mv[8];
#pragma unroll
                for (int k = 0; k < 8; ++k) { const u32x2 cq = *(const u32x2*)(Csum + base0 + (size_t)(c8 + k) * DH_ * DH_); cv[k] = (f32x4){bflo(cq.x), bfhi(cq.x), bflo(cq.y), bfhi(cq.y)}; gv[k] = gG[bh * 32 + c8 + k]; mv[k] = mlG[bh * 32 + c8 + k]; }
#pragma unroll
                for (int k = 0; k < 8; ++k) {
                    u32x2 o; o.x = cvt_pk_bf16(C[0], C[1]); o.y = cvt_pk_bf16(C[2], C[3]); *(u32x2*)(CprevT + base0 + (size_t)(c8 + k) * DH_ * DH_) = o;
                    if (r == 0) mprev[bh * 32 + c8 + k] = m;
                    const float mn = fmaxf(gv[k] + m, mv[k]), so = __expf(gv[k] + m - mn), sn = __expf(mv[k] - mn);
                    C = C * so + cv[k] * sn; m = mn;
                }
            }
        } else if (gid < NC2) {
            const int i = gid - NC1; const int bh = i / DH_, d = i % DH_;
            float n = 0.f, m = 0.f;
#pragma unroll 1
            for (int c8 = 0; c8 < 32; c8 += 8) {
                float nv[8], gv[8], mv[8];
#pragma unroll
                for (int k = 0; k < 8; ++k) { nv[k] = nsum[(size_t)(bh * 32 + c8 + k) * DH_ + d]; gv[k] = gG[bh * 32 + c8 + k]; mv[k] = mlG[bh * 32 + c8 + k]; }
#pragma unroll
                for (int k = 0; k < 8; ++k) {
                    nprev[(size_t)(bh * 32 + c8 + k) * DH_ + d] = n;
                    const float mn = fmaxf(gv[k] + m, mv[k]), so = __expf(gv[k] + m - mn), sn = __expf(mv[k] - mn);
                    n = so * n + sn * nv[k]; m = mn;
                }
            }
        } else {
            const int i = gid - NC2; const int pp = i & 63, g = (i >> 6) & 31, b = i >> 11;
            const float ar = A16[(size_t)g * 128 + pp], ai = A16[(size_t)g * 128 + 64 + pp];
            float xr = 0.f, xi = 0.f;
            const size_t row0 = (size_t)g * S5R_ + b * (S_ / 16);
#pragma unroll 1
            for (int c16 = 0; c16 < S_ / 16; c16 += 16) {
                float er[16], ei[16];
#pragma unroll
                for (int k = 0; k < 16; ++k) { er[k] = bf2f(Esum[(row0 + c16 + k) * 128 + pp]); ei[k] = bf2f(Esum[(row0 + c16 + k) * 128 + 64 + pp]); }
#pragma unroll
                for (int k = 0; k < 16; ++k) { const size_t row = row0 + c16 + k;
                    AS5[row * S5K_ + 256 + pp] = f2bf(xr); AS5[row * S5K_ + 320 + pp] = f2bf(xi);
                    const float nr = ar * xr - ai * xi + er[k], ni = ar * xi + ai * xr + ei[k]; xr = nr; xi = ni; }
            }
        }
    }
    else { moe_weight_jobs(p, c, l, lds); if (MK_REP == 97) moe_weight_jobs(p, c, (l + 2) & 3, lds, true); }
    if (MK_REP == 98) { const size_t gt = (size_t)c.bid * NT_ + c.tid, nth = (size_t)c.G * NT_; bf16_t* dmy = WSP<bf16_t>(p, WS_HB);
        cvt_rows(IN(p, 28) + (size_t)l * NE_ * D_ * DE_, dmy, (size_t)NE_ * D_ * DE_ / 8, gt, nth); cvt_rows(IN(p, 29) + (size_t)l * NE_ * D_ * DE_, dmy + (size_t)NE_ * D_ * DE_, (size_t)NE_ * D_ * DE_ / 8, gt, nth);
        cvt_rows(IN(p, 30) + (size_t)l * NE_ * DE_ * D_, dmy + (size_t)2 * NE_ * D_ * DE_, (size_t)NE_ * DE_ * D_ / 8, gt, nth); }
}

DI void mlstm_out_unit(PR p, const Ctx& c, int l, int unit, LAS unsigned char* lds) {
    LAS unsigned char* vt0 = lds;
    LAS unsigned char* kt0 = lds + 32768;
    LAS unsigned char* ct0 = lds + 65536;
    LAS float* RT = (LAS float*)(lds + 131072);
    LAS float* CT = RT + 128;
    LAS float* INr = CT + 128;
    LAS float* EM = INr + 128;
    LAS float* NP = EM + 128;
    LAS unsigned char* cv0 = ct0;
    LAS unsigned char* qt0 = ct0 + 32768;
    const bf16_t* zb = WSP<bf16_t>(p, WS_ZB); const bf16_t* CprevT = WSP<bf16_t>(p, WS_CPREV);
    const bf16_t* wqkT = WSP<bf16_t>(p, WS_WQK) + (size_t)l * H_ * 256 * DH_; const bf16_t* cvb = WSP<bf16_t>(p, WS_QB);
    const float* nprev = WSP<float>(p, WS_NPREV); const float* mprev = WSP<float>(p, WS_MPREV); const float* igG = WSP<float>(p, WS_IGG); const float* bcumG = WSP<float>(p, WS_BCUM);
    const float* mh_g = IN(p, 9) + (size_t)l * DM_; bf16_t* yb = WSP<bf16_t>(p, WS_YB);
    const int tid = c.tid, lane = c.lane, w = c.w, fr = lane & 15, fq = lane >> 4, hh = w >> 2, nt = w & 3;
    const int b = unit / (S_ / 64), cc = unit % (S_ / 64); const int tok0 = b * S_ + cc * 64;
    for (int rd = 0; rd < 2; ++rd) {
        __syncthreads();
        u32x4 cp[8];
#pragma unroll
        for (int i = 0; i < 8; ++i) { const int it = tid + i * NT_; const int hq = it >> 11, er = (it >> 4) & 127, cg = it & 15; const int bh = b * H_ + 2 * rd + hq;
            cp[i] = *(const u32x4*)(CprevT + ((size_t)(bh * 32 + cc) * DH_ + er) * DH_ + cg * 8); }
        for (int it = tid; it < 2048; it += NT_) { const int hq = it >> 10, sr = (it >> 4) & 63, cg = it & 15; const int h = 2 * rd + hq; const int ch0 = h * DH_ + cg * 8;
            *(LAS u32x4*)(vt0 + hq * 16384 + off_b(sr, cg)) = *(const u32x4*)(zb + (size_t)(tok0 + sr) * ZLD_ + 512 + ch0);
            const u32x4 o = *(const u32x4*)(cvb + (size_t)(tok0 + sr) * DM_ + ch0);
            *(LAS u32x4*)(cv0 + hq * 16384 + off_b(sr, cg)) = o; }
        if (w < 2) { const int h = 2 * rd + w; const int tok = tok0 + lane; const int bh = b * H_ + h;
            const float ig = igG[(size_t)tok * 4 + h], bc = bcumG[(size_t)tok * 4 + h]; const float rt = ig - bc;
            float pm = rt;
#pragma unroll
            for (int o = 1; o < 64; o <<= 1) { const float t = __shfl_up(pm, o); if (lane >= o) pm = fmaxf(pm, t); }
            const float mp = mprev[bh * 32 + cc]; const float li = bc + mp; const float mt = fmaxf(li, bc + pm);
            RT[w * 64 + lane] = rt; CT[w * 64 + lane] = bc - mt; INr[w * 64 + lane] = __expf(li - mt); EM[w * 64 + lane] = __expf(-mt);
            NP[w * 128 + lane] = nprev[(size_t)(bh * 32 + cc) * DH_ + lane]; NP[w * 128 + 64 + lane] = nprev[(size_t)(bh * 32 + cc) * DH_ + 64 + lane];
        }
        __syncthreads();
        {
            const int h = 2 * rd + hh; const LAS unsigned char* cv = cv0 + hh * 16384; LAS unsigned char* qt = qt0 + hh * 16384; LAS unsigned char* ktw = kt0 + hh * 16384;
            f32x4 acc[4][4];
#pragma unroll
            for (int ms = 0; ms < 4; ++ms)
#pragma unroll
                for (int i = 0; i < 4; ++i) acc[ms][i] = (f32x4){0.f, 0.f, 0.f, 0.f};
#pragma unroll
            for (int ks = 0; ks < 4; ++ks) {
                bf16x8 wf[4];
#pragma unroll
                for (int i = 0; i < 4; ++i) wf[i] = ld_frag_g(wqkT + ((size_t)(h * 256 + 16 * (4 * nt + i) + fr)) * DH_ + 32 * ks + 8 * fq);
#pragma unroll
                for (int ms = 0; ms < 4; ++ms) { const bf16x8 cf = tile_row_read(cv, lane, ms, ks);
#pragma unroll
                    for (int i = 0; i < 4; ++i) acc[ms][i] = mfma16(wf[i], cf, acc[ms][i]); }
            }
#pragma unroll
            for (int ms = 0; ms < 4; ++ms) { const int sr = 16 * ms + fr;
#pragma unroll
                for (int i = 0; i < 4; ++i) { const int nf = 4 * nt + i; const f32x4 v = acc[ms][i];
                    u32x2 o; o.x = cvt_pk_bf16(v[0], v[1]); o.y = cvt_pk_bf16(v[2], v[3]);
                    const int col = 16 * (nf & 7) + 4 * fq;
                    *(LAS u32x2*)((nf < 8 ? qt : ktw) + off_b(sr, col >> 3) + 2 * (col & 7)) = o; } }
        }
        __syncthreads();
        {
            const int h = 2 * rd + hh; const LAS unsigned char* vt = vt0 + hh * 16384; const LAS unsigned char* kt = kt0 + hh * 16384; const LAS unsigned char* ct = ct0 + hh * 32768;
            const int trow = 16 * nt + fr;
            bf16x8 qf[4];
#pragma unroll
            for (int ks = 0; ks < 4; ++ks) qf[ks] = tile_row_read(qt0 + hh * 16384, lane, nt, ks);
            __syncthreads();
#pragma unroll
            for (int i = 0; i < 8; ++i) { const int it = tid + i * NT_; const int hq = it >> 11, er = (it >> 4) & 127, cg = it & 15; *(LAS u32x4*)(ct0 + hq * 32768 + off_b(er, cg)) = cp[i]; }
            __syncthreads();
            f32x4 Sf[4];
#pragma unroll
            for (int ms = 0; ms < 4; ++ms) { Sf[ms] = (f32x4){0.f, 0.f, 0.f, 0.f};
                if (ms <= nt) {
#pragma unroll
                    for (int ks = 0; ks < 4; ++ks) Sf[ms] = mfma16(tile_row_read(kt, lane, ms, ks), qf[ks], Sf[ms]);
                } }
            const float ct_ = CT[hh * 64 + trow];
            float dsum = 0.f;
#pragma unroll
            for (int ms = 0; ms < 4; ++ms)
#pragma unroll
                for (int r = 0; r < 4; ++r) { const int sr = 16 * ms + 4 * fq + r; float v = 0.f;
                    if (ms <= nt && sr <= trow) v = Sf[ms][r] * __expf(RT[hh * 64 + sr] + ct_);
                    Sf[ms][r] = v; dsum += v; }
            dsum += __shfl_xor(dsum, 16); dsum += __shfl_xor(dsum, 32);
            float qn = 0.f;
#pragma unroll
            for (int ks = 0; ks < 4; ++ks)
#pragma unroll
                for (int j = 0; j < 8; ++j) qn += bf2f((bf16_t)qf[ks][j]) * NP[hh * 128 + 32 * ks + 8 * fq + j];
            qn += __shfl_xor(qn, 16); qn += __shfl_xor(qn, 32);
            const float inter = INr[hh * 64 + trow];
            float den = dsum + inter * qn; den = fmaxf(fabsf(den), EM[hh * 64 + trow]); const float rden = __builtin_amdgcn_rcpf(den);
            bf16x8 Pf[2];
#pragma unroll
            for (int k2 = 0; k2 < 2; ++k2) { u32x4 pk; pk.x = cvt_pk_bf16(Sf[2 * k2][0], Sf[2 * k2][1]); pk.y = cvt_pk_bf16(Sf[2 * k2][2], Sf[2 * k2][3]);
                pk.z = cvt_pk_bf16(Sf[2 * k2 + 1][0], Sf[2 * k2 + 1][1]); pk.w = cvt_pk_bf16(Sf[2 * k2 + 1][2], Sf[2 * k2 + 1][3]); Pf[k2] = __builtin_bit_cast(bf16x8, pk); }
            float hv[8][4]; float ssum = 0.f;
#pragma unroll
            for (int me = 0; me < 8; ++me) {
                f32x4 a1 = (f32x4){0.f, 0.f, 0.f, 0.f}, a2 = (f32x4){0.f, 0.f, 0.f, 0.f};
                s16x4 v0, v1, v2, v3;
                tile_tr_read4(tr_addr(vt, lane, 4 * fq, me), tr_addr(vt, lane, 16 + 4 * fq, me), tr_addr(vt, lane, 32 + 4 * fq, me), tr_addr(vt, lane, 48 + 4 * fq, me), v0, v1, v2, v3);
#pragma unroll
                for (int ks = 0; ks < 4; ++ks) a2 = mfma16(tile_row_read(ct, lane, me, ks), qf[ks], a2);
                a1 = mfma16(cat8(v0, v1), Pf[0], a1);
                if (nt >= 2) a1 = mfma16(cat8(v2, v3), Pf[1], a1);
                const u32x2 og = *(const u32x2*)(zb + (size_t)(tok0 + trow) * ZLD_ + 1024 + h * DH_ + 16 * me + 4 * fq);
                hv[me][0] = (a1[0] + inter * a2[0]) * rden * fast_sigmoid(bflo(og.x)); hv[me][1] = (a1[1] + inter * a2[1]) * rden * fast_sigmoid(bfhi(og.x));
                hv[me][2] = (a1[2] + inter * a2[2]) * rden * fast_sigmoid(bflo(og.y)); hv[me][3] = (a1[3] + inter * a2[3]) * rden * fast_sigmoid(bfhi(og.y));
                ssum += (hv[me][0] + hv[me][1]) + (hv[me][2] + hv[me][3]);
            }
            ssum += __shfl_xor(ssum, 16); ssum += __shfl_xor(ssum, 32);
            const float mu = ssum * (1.f / DH_); float qv = 0.f;
#pragma unroll
            for (int me = 0; me < 8; ++me)
#pragma unroll
                for (int r = 0; r < 4; ++r) { const float d0 = hv[me][r] - mu; qv += d0 * d0; }
            qv += __shfl_xor(qv, 16); qv += __shfl_xor(qv, 32);
            const float rstd = rsqrtf(qv * (1.f / DH_) + EPS_);
#pragma unroll
            for (int me = 0; me < 8; ++me) { const int e0 = h * DH_ + 16 * me + 4 * fq; const f32x4 gg = *(const f32x4*)(mh_g + e0);
                u32x2 o; o.x = cvt_pk_bf16((hv[me][0] - mu) * rstd * gg[0], (hv[me][1] - mu) * rstd * gg[1]); o.y = cvt_pk_bf16((hv[me][2] - mu) * rstd * gg[2], (hv[me][3] - mu) * rstd * gg[3]);
                *(u32x2*)(yb + (size_t)(tok0 + trow) * D_ + DM_ + e0) = o; }
        }
    }
}
DI void ph_mix2(PR p, const Ctx& c, int l, LAS unsigned char* lds) {
    for (int unit = c.bid; unit < NB_ * (S_ / 64); unit += c.G) mlstm_out_unit(p, c, l, unit, lds);
    __syncthreads();
    GroupOrder S; S.A = (const char*)WSP<bf16_t>(p, WS_AS5); S.B = (const char*)(WSP<bf16_t>(p, WS_WYT) + (size_t)l * G5_ * 256 * S5K_); S.astride = (size_t)S5R_ * S5K_ * 2; S.bstride = (size_t)256 * S5K_ * 2;
    S.lda = S5K_ * 2; S.nunits = G5_ * 4; S.G = c.G; S.c = (c.bid + c.G / 2) % c.G;
    EpiS5Y E{WSP<bf16_t>(p, WS_GYB)};
    gemm_phase<EpiS5Y, GroupOrder>(lds, Gemm{(unsigned)(S5K_ * 2), (unsigned)(S5K_ * 2), S5K_}, S, E);
}

DI void ph_glu(PR p, const Ctx& c, int l, LAS unsigned char* lds) {
    const int hg = c.G / 2;
    if (c.bid < hg) {
        DenseOrder S; S.init(WSP<bf16_t>(p, WS_GYB), WSP<bf16_t>(p, WS_WGLU) + (size_t)l * DM_ * DM_, DM_ * 2, DM_ * 2, M_, DM_, hg, c.bid);
        EpiGlu E{WSP<bf16_t>(p, WS_GYB), IN(p, 19) + (size_t)l * DM_, WSP<bf16_t>(p, WS_YB), WSP<float>(p, WS_SSQS)};
        gemm_phase<EpiGlu, DenseOrder>(lds, Gemm{(unsigned)(DM_ * 2), (unsigned)(DM_ * 2), DM_}, S, E);
    } else {
        DenseOrder S2; S2.init(WSP<bf16_t>(p, WS_PBF) + (size_t)l * M_ * PLE_, WSP<bf16_t>(p, WS_WPP) + (size_t)l * D_ * PLE_, PLE_ * 2, PLE_ * 2, M_, D_, c.G - hg, c.bid - hg);
        EpiT E2{WSP<bf16_t>(p, WS_TB), WSP<float>(p, WS_SSQT)};
        gemm_phase<EpiT, DenseOrder>(lds, Gemm{(unsigned)(PLE_ * 2), (unsigned)(PLE_ * 2), PLE_}, S2, E2);
    }
}
DI void ph_outproj(PR p, const Ctx& c, int l, LAS unsigned char* lds) {
    DenseOrder S; S.init(WSP<bf16_t>(p, WS_YB), WSP<bf16_t>(p, WS_WOUT) + (size_t)l * D_ * D_, D_ * 2, D_ * 2, M_, D_, c.G, c.bid);
    EpiOutLn E{WSP<bf16_t>(p, WS_XB), WSP<float>(p, WS_SSQS), WSP<bf16_t>(p, WS_GHL) + (size_t)l * 2 * 48 * D_, WSP<float>(p, WS_RTC) + l * 80, IN(p, 22) + (size_t)l * D_, IN(p, 23) + (size_t)l * D_,
               WSP<float>(p, WS_XCH), WSP<unsigned>(p, WS_LNC) + (size_t)l * 64 * 16, WSP<bf16_t>(p, WS_X1B), WSP<unsigned char>(p, WS_X1Q),
               WSP<unsigned>(p, WS_CUR) + (size_t)l * NE_ * 16, WSP<int>(p, WS_BUFT), WSP<float>(p, WS_BUFW), WSP<int>(p, WS_SLOT)};
    gemm_phase<EpiOutLn, DenseOrder>(lds, Gemm{(unsigned)(D_ * 2), (unsigned)(D_ * 2), D_}, S, E);
}
DI void ph_route(PR p, const Ctx& c, int l, LAS unsigned char* lds, bool dry = false) {
    LAS int* cntL = (LAS int*)lds; LAS int* baseL = cntL + 32; LAS int* tokE = baseL + 32; LAS float* tokW = (LAS float*)(tokE + 128);
    const float* logits = WSP<float>(p, WS_LOGIT);
    unsigned* cur = WSP<unsigned>(p, WS_CUR) + (size_t)(l + (dry ? L_ : 0)) * NE_ * 16; int* buf_t = WSP<int>(p, WS_BUFT); float* buf_w = WSP<float>(p, WS_BUFW); int* slot_of = WSP<int>(p, WS_SLOT);
    const int tid = c.tid;
    __syncthreads();
    if (tid < 32) cntL[tid] = 0;
    __syncthreads();
    for (int unit = c.bid; unit < M_ / 64; unit += c.G) {
        if (tid < 64) { const float* lg = logits + (size_t)(unit * 64 + tid) * 40;
            const f32x4 gl = *(const f32x4*)lg; float mx = gl[0]; int gi = 0;
#pragma unroll
            for (int i = 1; i < 4; ++i) if (gl[i] > mx) { mx = gl[i]; gi = i; }
            float se = 0.f;
#pragma unroll
            for (int i = 0; i < 4; ++i) se += expf(gl[i] - mx);
            const float pg = 1.0f / se;
            const f32x4 e0 = *(const f32x4*)(lg + 4 + gi * 8), e1 = *(const f32x4*)(lg + 8 + gi * 8);
            float ev[8];
#pragma unroll
            for (int i = 0; i < 4; ++i) { ev[i] = e0[i]; ev[4 + i] = e1[i]; }
            int i0 = 0;
#pragma unroll
            for (int i = 1; i < 8; ++i) if (ev[i] > ev[i0]) i0 = i;
            int i1 = (i0 == 0) ? 1 : 0;
#pragma unroll
            for (int i = 0; i < 8; ++i) if (i != i0 && ev[i] > ev[i1]) i1 = i;
            const float e1x = expf(ev[i1] - ev[i0]); const float w0 = 1.f / (1.f + e1x), w1 = e1x / (1.f + e1x);
            const int ea = gi * 8 + i0, eb = gi * 8 + i1;
            const int ra = atomicAdd((int*)&cntL[ea], 1), rb = atomicAdd((int*)&cntL[eb], 1);
            tokE[tid * 2] = (ea << 16) | ra; tokE[tid * 2 + 1] = (eb << 16) | rb; tokW[tid * 2] = pg * w0; tokW[tid * 2 + 1] = pg * w1;
        }
        __syncthreads();
        if (tid < 32) baseL[tid] = cntL[tid] ? (int)atomicAdd(&cur[tid * 16], (unsigned)cntL[tid]) : 0;
        __syncthreads();
        if (tid < 128 && !dry) { const int v = tokE[tid]; const int e = v >> 16, r = baseL[e] + (v & 0xffff); const int token = unit * 64 + (tid >> 1);
            buf_t[(size_t)e * ECAP_ + r] = token; buf_w[(size_t)e * ECAP_ + r] = tokW[tid]; slot_of[token * 2 + (tid & 1)] = (e << 16) | r; }
        __syncthreads();
        if (tid < 32) cntL[tid] = 0;
        __syncthreads();
    }
}

DI void treduce16(float (&a)[16], int lane) {
#pragma unroll
    for (int i = 0; i < 8; ++i) { const bool hi = lane & 32; const float send = hi ? a[i] : a[i + 8], keep = hi ? a[i + 8] : a[i]; a[i] = keep + __shfl_xor(send, 32); }
#pragma unroll
    for (int i = 0; i < 4; ++i) { const bool hi = lane & 16; const float send = hi ? a[i] : a[i + 4], keep = hi ? a[i + 4] : a[i]; a[i] = keep + __shfl_xor(send, 16); }
#pragma unroll
    for (int i = 0; i < 2; ++i) { const bool hi = lane & 8; const float send = hi ? a[i] : a[i + 2], keep = hi ? a[i + 2] : a[i]; a[i] = keep + __shfl_xor(send, 8); }
    { const bool hi = lane & 4; const float send = hi ? a[0] : a[1], keep = hi ? a[1] : a[0]; a[0] = keep + __shfl_xor(send, 4); }
    a[0] += __shfl_xor(a[0], 2); a[0] += __shfl_xor(a[0], 1);
}
DI void ph_router(PR p, const Ctx& c, int l, LAS unsigned char* lds, bool dry = false) {
    LAS float* W = (LAS float*)lds;
    LAS float* LG = (LAS float*)(lds + 147456);
    LAS int* cntL = (LAS int*)(lds + 147456 + 9216);
    LAS int* baseL = cntL + 32;
    LAS int* tokE = baseL + 32;
    LAS float* tokW = (LAS float*)(tokE + 128);
    const float* b_grp = IN(p, 25) + l * 4; const float* b_rt = IN(p, 27) + l * 32;
    const float* ln_g = IN(p, 22) + (size_t)l * D_; const float* ln_b = IN(p, 23) + (size_t)l * D_;
    const bf16_t* r1 = WSP<bf16_t>(p, WS_X2B); bf16_t* x1b = WSP<bf16_t>(p, WS_X1B); unsigned char* x1q = WSP<unsigned char>(p, WS_X1Q);
    unsigned* cur = WSP<unsigned>(p, WS_CUR) + (size_t)(l + (dry ? L_ : 0)) * NE_ * 16; int* buf_t = WSP<int>(p, WS_BUFT); float* buf_w = WSP<float>(p, WS_BUFW); int* slot_of = WSP<int>(p, WS_SLOT);
    const int tid = c.tid, lane = c.lane, w = c.w;
    __syncthreads();
    { const f32x4* wsrc = (const f32x4*)(WSP<float>(p, WS_WRT) + (size_t)l * 36 * D_); for (int idx = tid; idx < 36 * D_ / 4; idx += NT_) ((LAS f32x4*)W)[idx] = wsrc[idx]; }
    if (tid < 32) cntL[tid] = 0;
    __syncthreads();
    for (int unit = c.bid; unit < M_ / 64; unit += c.G) {
#pragma unroll 1
        for (int half = 0; half < 2; ++half) {
        const int tokb = unit * 64 + w * 8 + half * 4;
        f32x4 xv[4][4];
#pragma unroll
        for (int tk = 0; tk < 4; ++tk) { const bf16_t* rin = r1 + (size_t)(tokb + tk) * D_; float s = 0.f;
#pragma unroll
            for (int j = 0; j < 4; ++j) { const u32x2 rv = ((const u32x2*)rin)[lane + 64 * j]; xv[tk][j] = (f32x4){bflo(rv.x), bfhi(rv.x), bflo(rv.y), bfhi(rv.y)}; s += (xv[tk][j][0] + xv[tk][j][1]) + (xv[tk][j][2] + xv[tk][j][3]); }
            const float mu = wave_sum(s) * (1.f / D_); float qv = 0.f;
#pragma unroll
            for (int j = 0; j < 4; ++j) { xv[tk][j] = xv[tk][j] - mu; qv += (xv[tk][j][0] * xv[tk][j][0] + xv[tk][j][1] * xv[tk][j][1]) + (xv[tk][j][2] * xv[tk][j][2] + xv[tk][j][3] * xv[tk][j][3]); }
            const float rstd = rsqrtf(wave_sum(qv) * (1.f / D_) + EPS_);
#pragma unroll
            for (int j = 0; j < 4; ++j) { const f32x4 gg = ((const f32x4*)ln_g)[lane + 64 * j], bb = ((const f32x4*)ln_b)[lane + 64 * j];
                xv[tk][j] = xv[tk][j] * rstd * gg + bb;
                u32x2 o; o.x = cvt_pk_bf16(xv[tk][j][0], xv[tk][j][1]); o.y = cvt_pk_bf16(xv[tk][j][2], xv[tk][j][3]); ((u32x2*)(x1b + (size_t)(tokb + tk) * D_))[lane + 64 * j] = o;
                ((unsigned*)(x1q + (size_t)(tokb + tk) * D_))[lane + 64 * j] = pack4_fp8(xv[tk][j][0], xv[tk][j][1], xv[tk][j][2], xv[tk][j][3]); }
        }
        f32x2_ xq[2][4][4];
#pragma unroll
        for (int tp = 0; tp < 2; ++tp)
#pragma unroll
            for (int j = 0; j < 4; ++j)
#pragma unroll
                for (int e = 0; e < 4; ++e) xq[tp][j][e] = (f32x2_){xv[2 * tp][j][e], xv[2 * tp + 1][j][e]};
#pragma unroll 1
        for (int ob = 0; ob < 9; ++ob) {
            f32x2_ a2[2][4];
#pragma unroll
            for (int tp = 0; tp < 2; ++tp)
#pragma unroll
                for (int oo = 0; oo < 4; ++oo) a2[tp][oo] = (f32x2_){0.f, 0.f};
#pragma unroll
            for (int oo = 0; oo < 4; ++oo)
#pragma unroll
                for (int j = 0; j < 4; ++j) { const f32x4 wv = ((const LAS f32x4*)W)[(4 * ob + oo) * 256 + lane + 64 * j];
#pragma unroll
                    for (int e = 0; e < 4; ++e) { const f32x2_ wb = (f32x2_){wv[e], wv[e]};
                        a2[0][oo] = __builtin_elementwise_fma(xq[0][j][e], wb, a2[0][oo]); a2[1][oo] = __builtin_elementwise_fma(xq[1][j][e], wb, a2[1][oo]); } }
            float part[16];
#pragma unroll
            for (int tp = 0; tp < 2; ++tp)
#pragma unroll
                for (int oo = 0; oo < 4; ++oo) { part[(2 * tp) * 4 + oo] = a2[tp][oo][0]; part[(2 * tp + 1) * 4 + oo] = a2[tp][oo][1]; }
            treduce16(part, lane);
            if ((lane & 3) == 0) { const int idx = lane >> 2; LG[(w * 8 + half * 4 + (idx >> 2)) * 36 + 4 * ob + (idx & 3)] = part[0]; }
        }
        }
        __builtin_amdgcn_s_waitcnt(0xC07F); __builtin_amdgcn_wave_barrier();
        if (lane < 8) { const LAS float* lg = LG + (w * 8 + lane) * 36;
            float gl[4]; float mx = -1e30f; int gi = 0;
#pragma unroll
            for (int i = 0; i < 4; ++i) { gl[i] = lg[i] + b_grp[i]; if (gl[i] > mx) { mx = gl[i]; gi = i; } }
            float se = 0.f;
#pragma unroll
            for (int i = 0; i < 4; ++i) se += expf(gl[i] - mx);
            const float pg = 1.0f / se;
            float ev[8];
#pragma unroll
            for (int i = 0; i < 8; ++i) ev[i] = lg[4 + gi * 8 + i] + b_rt[gi * 8 + i];
            int i0 = 0;
#pragma unroll
            for (int i = 1; i < 8; ++i) if (ev[i] > ev[i0]) i0 = i;
            int i1 = (i0 == 0) ? 1 : 0;
#pragma unroll
            for (int i = 0; i < 8; ++i) if (i != i0 && ev[i] > ev[i1]) i1 = i;
            const float e1 = expf(ev[i1] - ev[i0]); const float w0 = 1.f / (1.f + e1), w1 = e1 / (1.f + e1);
            const int ea = gi * 8 + i0, eb = gi * 8 + i1;
            const int ra = atomicAdd((int*)&cntL[ea], 1), rb = atomicAdd((int*)&cntL[eb], 1);
            tokE[(w * 8 + lane) * 2] = (ea << 16) | ra; tokE[(w * 8 + lane) * 2 + 1] = (eb << 16) | rb; tokW[(w * 8 + lane) * 2] = pg * w0; tokW[(w * 8 + lane) * 2 + 1] = pg * w1;
        }
        __syncthreads();
        if (tid < 32) baseL[tid] = cntL[tid] ? (int)atomicAdd(&cur[tid * 16], (unsigned)cntL[tid]) : 0;
        __syncthreads();
        if (tid < 128 && !dry) { const int v = tokE[tid]; const int e = v >> 16, r = baseL[e] + (v & 0xffff); const int token = unit * 64 + (tid >> 1);
            buf_t[(size_t)e * ECAP_ + r] = token; buf_w[(size_t)e * ECAP_ + r] = tokW[tid]; slot_of[token * 2 + (tid & 1)] = (e << 16) | r; }
        __syncthreads();
        if (tid < 32) cntL[tid] = 0;
        __syncthreads();
    }
}

DI void moe_tables(PR p, const Ctx& c, int l, LAS int* cnt, LAS int* tbase) {
    unsigned* cur = WSP<unsigned>(p, WS_CUR) + (size_t)l * NE_ * 16;
    __syncthreads();
    if (c.tid < 32) cnt[c.tid] = (int)xb_ld(&cur[c.tid * 16]);
    __syncthreads();
    if (c.tid == 0) { int run = 0; for (int e = 0; e < 32; ++e) { tbase[e] = run; run += (cnt[e] + 255) >> 8; } tbase[32] = run; }
    __syncthreads();
}
DI void ph_moe(PR p, const Ctx& c, int l, LAS unsigned char* lds, bool dry = false) {
    LAS int* cnt = (LAS int*)(lds + STAGE_BYTES); LAS int* tbase = cnt + 32;
    moe_tables(p, c, l, cnt, tbase);
    unsigned* done = WSP<unsigned>(p, WS_DONE) + (size_t)(l + (dry ? L_ : 0)) * MT_ * 16;
    const int nu = tbase[32] * 4;
    {
        MoeOrder<true> S; S.A = (const char*)WSP<unsigned char>(p, WS_X1Q); S.B = (const char*)WSP<unsigned char>(p, WS_WGU); S.lda = D_; S.ldb = D_; S.bstride = (size_t)D_ * D_;
        S.tbase = tbase; S.cnt = cnt; S.buf_t = WSP<int>(p, WS_BUFT); S.done = done; S.nunits = nu; S.G = c.G; S.c = c.bid; S.n3 = 0; S.nb = 0;
        EpiSiluMul E{WSP<unsigned char>(p, WS_HB), done};
        gemm_phase<EpiSiluMul, MoeOrder<true>>(lds, Gemm{(unsigned)D_, (unsigned)D_, D_ / 2}, S, E);
    }
    __syncthreads();
    {
        MoeOrder<false> S; S.A = (const char*)WSP<unsigned char>(p, WS_HB); S.B = (const char*)WSP<unsigned char>(p, WS_WED); S.lda = DE_; S.ldb = DE_; S.bstride = (size_t)D_ * DE_;
        S.tbase = tbase; S.cnt = cnt; S.buf_t = WSP<int>(p, WS_BUFT); S.done = done; S.nunits = nu; S.G = c.G; S.c = c.bid;
        { const int maxups = (nu + c.G - 1) / c.G; S.n3 = (nu % c.G) ? nu - (maxups - 1) * c.G : c.G; S.nb = (c.G - S.n3) < nu ? (c.G - S.n3) : nu; }
        EpiDown E{WSP<unsigned char>(p, WS_YE), WSP<float>(p, WS_BUFW), cnt};
        gemm_phase<EpiDown, MoeOrder<false>>(lds, Gemm{(unsigned)DE_, (unsigned)DE_, DE_ / 2}, S, E);
    }
}
DI void ph_ln2(PR p, const Ctx& c, int l, LAS unsigned char* lds) {
    LAS int* cnt = (LAS int*)(lds + STAGE_BYTES); LAS int* tbase = cnt + 32;
    moe_tables(p, c, l, cnt, tbase);
    const bf16_t* x1b = WSP<bf16_t>(p, WS_X1B); const unsigned char* ye = WSP<unsigned char>(p, WS_YE); const int* slot_of = WSP<int>(p, WS_SLOT);
    const float* ln_g = IN(p, 31) + (size_t)l * D_; const float* ln_b = IN(p, 32) + (size_t)l * D_; bf16_t* x2b = WSP<bf16_t>(p, WS_X2B);
    const int lane = c.lane;
    const float* ssqT = WSP<float>(p, WS_SSQT); float* rstdT = WSP<float>(p, WS_RSTDT);
    for (int tok = c.bid * 8 + c.w; tok < M_; tok += c.G * 8) {
        { float tq = (lane < 16) ? ssqT[(size_t)tok * 16 + lane] : 0.f; tq += __shfl_xor(tq, 8); tq += __shfl_xor(tq, 4); tq += __shfl_xor(tq, 2); tq += __shfl_xor(tq, 1);
          if (lane == 0) rstdT[tok] = rsqrtf(tq * (1.f / D_) + EPS_); }
        const int s0 = slot_of[tok * 2], s1 = slot_of[tok * 2 + 1];
        const size_t r0 = ((size_t)(tbase[s0 >> 16] + ((s0 & 0xffff) >> 8)) * 256 + (s0 & 255)) * D_, r1 = ((size_t)(tbase[s1 >> 16] + ((s1 & 0xffff) >> 8)) * 256 + (s1 & 255)) * D_;
        f32x4 v[4]; float s = 0.f;
#pragma unroll
        for (int j = 0; j < 4; ++j) { const u32x2 xr = ((const u32x2*)(x1b + (size_t)tok * D_))[lane + 64 * j]; const f32x4 xv = (f32x4){bflo(xr.x), bfhi(xr.x), bflo(xr.y), bfhi(xr.y)};
            const int a = ((const int*)(ye + r0))[lane + 64 * j], bq = ((const int*)(ye + r1))[lane + 64 * j];
            v[j][0] = ALPHA_ * xv[0] + YE_INV * (__builtin_amdgcn_cvt_f32_fp8(a, 0) + __builtin_amdgcn_cvt_f32_fp8(bq, 0)); v[j][1] = ALPHA_ * xv[1] + YE_INV * (__builtin_amdgcn_cvt_f32_fp8(a, 1) + __builtin_amdgcn_cvt_f32_fp8(bq, 1));
            v[j][2] = ALPHA_ * xv[2] + YE_INV * (__builtin_amdgcn_cvt_f32_fp8(a, 2) + __builtin_amdgcn_cvt_f32_fp8(bq, 2)); v[j][3] = ALPHA_ * xv[3] + YE_INV * (__builtin_amdgcn_cvt_f32_fp8(a, 3) + __builtin_amdgcn_cvt_f32_fp8(bq, 3));
            s += (v[j][0] + v[j][1]) + (v[j][2] + v[j][3]); }
        const float mu = wave_sum(s) * (1.f / D_); float qv = 0.f;
#pragma unroll
        for (int j = 0; j < 4; ++j) { v[j] = v[j] - mu; qv += (v[j][0] * v[j][0] + v[j][1] * v[j][1]) + (v[j][2] * v[j][2] + v[j][3] * v[j][3]); }
        const float rstd = rsqrtf(wave_sum(qv) * (1.f / D_) + EPS_);
#pragma unroll
        for (int j = 0; j < 4; ++j) { const f32x4 gg = ((const f32x4*)ln_g)[lane + 64 * j], bb = ((const f32x4*)ln_b)[lane + 64 * j]; const f32x4 o = v[j] * rstd * gg + bb;
            u32x2 ob; ob.x = cvt_pk_bf16(o[0], o[1]); ob.y = cvt_pk_bf16(o[2], o[3]); ((u32x2*)(x2b + (size_t)tok * D_))[lane + 64 * j] = ob; }
    }
}
DI void ph_ple(PR p, const Ctx& c, int l, LAS unsigned char* lds) {
    DenseOrder S; S.init(WSP<bf16_t>(p, WS_X2B), WSP<bf16_t>(p, WS_WPG) + (size_t)l * D_ * D_, D_ * 2, D_ * 2, M_, D_, c.G, c.bid);
    EpiPle E{WSP<bf16_t>(p, WS_X2B), WSP<bf16_t>(p, WS_TB), WSP<float>(p, WS_RSTDT), IN(p, 34) + (size_t)l * D_, IN(p, 36) + (size_t)l * D_, (l == L_ - 1) ? p.out : (float*)nullptr, WSP<bf16_t>(p, WS_XB)};
    gemm_phase<EpiPle, DenseOrder>(lds, Gemm{(unsigned)(D_ * 2), (unsigned)(D_ * 2), D_}, S, E);
}

DI Ctx mk_ctx() { Ctx c; int t = threadIdx.x; asm volatile("" : "+v"(t)); t &= 511; int g = gridDim.x, b = blockIdx.x; asm volatile("" : "+s"(g), "+s"(b)); c.G = g; c.bid = b; c.tid = t; c.lane = t & 63; c.w = __builtin_amdgcn_readfirstlane(t >> 6); return c; }

DI PR getP() { const __attribute__((address_space(4))) P* q = (const __attribute__((address_space(4))) P*)__builtin_amdgcn_kernarg_segment_ptr(); asm volatile("" : "+s"(q)); return *q; }
template <int PH> DI void run_phase(int l, LAS unsigned char* lds0) {
    unsigned la = (unsigned)(size_t)lds0; asm volatile("" : "+s"(la)); LAS unsigned char* lds = (LAS unsigned char*)(size_t)la;
    PR p = getP(); const Ctx c = mk_ctx();
    if constexpr (PH == 0) ph_prologue(p, c, lds);
    if constexpr (PH >= 200 && PH < 216) ph_prologue(p, c, lds, PH - 200);
    if constexpr (PH == 1) ph_inproj(p, c, l, lds);
    if constexpr (PH == 2) ph_mix1(p, c, l, lds);
    if constexpr (PH == 3) ph_scan(p, c, l, lds);
    if constexpr (PH == 4) ph_mix2(p, c, l, lds);
    if constexpr (PH == 5) ph_glu(p, c, l, lds);
    if constexpr (PH == 6) ph_outproj(p, c, l, lds);
    if constexpr (PH == 7) ph_route(p, c, l, lds, false);
    if constexpr (PH == 107) ph_route(p, c, l, lds, true);
    if constexpr (PH == 8) ph_moe(p, c, l, lds, false);
    if constexpr (PH == 108) ph_moe(p, c, l, lds, true);
    if constexpr (PH == 10) ph_ln2(p, c, l, lds);
    if constexpr (PH == 11) ph_ple(p, c, l, lds);
}
DI void grid_bar(LAS unsigned char* lds) {
    PR p = getP();
    XcdBarrier b; b.bar = WSP<unsigned>(p, WS_BAR); b.x = xb_xcc_id(); b.st = (volatile LAS unsigned*)(lds + LDS_BYTES - 16);
    xcd_barrier(b);
}

#if MK_MULTI
template <int PH> __global__ __launch_bounds__(512, 2) void k_phase(P p, int l) {
    extern __shared__ __attribute__((aligned(16))) unsigned char smem[];
    (void)p;
    run_phase<PH>(l, (LAS unsigned char*)smem);
}
#else
__global__ __launch_bounds__(512, 2) void k_fwd(P p) {
    extern __shared__ __attribute__((aligned(16))) unsigned char smem[];
    LAS unsigned char* lds = (LAS unsigned char*)smem;
    volatile LAS unsigned* bst = (volatile LAS unsigned*)(lds + LDS_BYTES - 16);
    if (threadIdx.x < 4) bst[threadIdx.x] = 0u;
    __syncthreads();
    (void)xcd_barrier_post((unsigned*)(p.ws + WS_BAR), bst);
    run_phase<0>(0, lds); grid_bar(lds);
    if (MK_REP == 0) { run_phase<0>(0, lds); grid_bar(lds); }
    if (MK_REP >= 200 && MK_REP < 216) { run_phase<(MK_REP >= 200 && MK_REP < 216) ? MK_REP : 200>(0, lds); grid_bar(lds); }
#define MK_PH(k, l) do { run_phase<k>(l, lds); if (MK_REP == k) { grid_bar(lds); run_phase<(k == 7 ? 107 : k == 8 ? 108 : k)>(l, lds); } } while (0)
#define MK_LAYER(l, lastbar) do { MK_PH(1, l); grid_bar(lds); MK_PH(2, l); grid_bar(lds); MK_PH(3, l); grid_bar(lds); MK_PH(4, l); grid_bar(lds); \
        MK_PH(5, l); grid_bar(lds); MK_PH(6, l); grid_bar(lds); MK_PH(8, l); grid_bar(lds); \
        MK_PH(10, l); grid_bar(lds); MK_PH(11, l); if (lastbar) grid_bar(lds); if (MK_REP == 99) { for (int q_ = 0; q_ < 10; ++q_) grid_bar(lds); } } while (0)
    MK_LAYER(0, true); MK_LAYER(1, true); MK_LAYER(2, true); MK_LAYER(3, false);
#undef MK_LAYER
#undef MK_PH
}
#endif
}

#if MK_MULTI
template <int PH> static void launch_phase(const P& p, int l, int grid, hipStream_t st) {
    static bool attr_set = false;
    if (!attr_set) { (void)hipFuncSetAttribute((const void*)k_phase<PH>, hipFuncAttributeMaxDynamicSharedMemorySize, LDS_BYTES); attr_set = true; }
    hipLaunchKernelGGL(k_phase<PH>, dim3(grid), dim3(NT_), LDS_BYTES, st, p, l);
}
#endif

extern "C" void kernel_launch(void* const* d_in, const int* in_sizes, int n_in, void* d_out, int out_size, void* d_ws, size_t ws_size, hipStream_t stream) {
    (void)in_sizes; (void)n_in; (void)out_size; (void)ws_size;
    static int grid = 0;
    if (grid == 0) { int dev = 0, cus = 0; (void)hipGetDevice(&dev); (void)hipDeviceGetAttribute(&cus, hipDeviceAttributeMultiprocessorCount, dev); grid = cus > 0 ? cus : 256; }
    P p{};
    for (int i = 0; i < 37; ++i) p.in[i] = (const float*)d_in[i];
    p.out = (float*)d_out; p.ws = (unsigned char*)d_ws;
    (void)hipMemsetAsync(d_ws, 0, WS_CTL_END, stream);
#if MK_MULTI
    launch_phase<0>(p, 0, grid, stream);
    for (int l = 0; l < L_; ++l) {
        launch_phase<1>(p, l, grid, stream); launch_phase<2>(p, l, grid, stream); launch_phase<3>(p, l, grid, stream); launch_phase<4>(p, l, grid, stream);
        launch_phase<5>(p, l, grid, stream); launch_phase<6>(p, l, grid, stream); launch_phase<8>(p, l, grid, stream);
        launch_phase<10>(p, l, grid, stream); launch_phase<11>(p, l, grid, stream);
    }
#else
    static bool attr_set = false;
    if (!attr_set) { (void)hipFuncSetAttribute((const void*)k_fwd, hipFuncAttributeMaxDynamicSharedMemorySize, LDS_BYTES); attr_set = true; }
    hipLaunchKernelGGL(k_fwd, dim3(grid), dim3(NT_), LDS_BYTES, stream, p);
#endif
}
```

```cpp
#include <hip/hip_runtime.h>
#include <math.h>
#include <stdint.h>

#ifndef MK_MULTI
#define MK_MULTI 0
#endif

#ifndef MK_REP
#define MK_REP -1
#endif

namespace {
#define LAS __attribute__((address_space(3)))
#define DI __device__ __forceinline__
typedef unsigned short bf16_t;
typedef short bf16x8 __attribute__((ext_vector_type(8)));
typedef short s16x4 __attribute__((ext_vector_type(4)));
typedef float f32x4 __attribute__((ext_vector_type(4)));
typedef unsigned u32x4 __attribute__((ext_vector_type(4)));
typedef unsigned u32x2 __attribute__((ext_vector_type(2)));
typedef int v8i __attribute__((ext_vector_type(8)));
typedef int v4i __attribute__((ext_vector_type(4)));

constexpr int NB_ = 8, S_ = 2048, D_ = 1024, M_ = NB_ * S_, L_ = 4;
constexpr int DM_ = 512, H_ = 4, DH_ = 128, DIN_ = 2056, ZLD_ = 1536;
constexpr int G5_ = 32, P5_ = 64;
constexpr int PLE_ = 256, NE_ = 32, DE_ = 512;
constexpr int MT_ = 160, PS2_ = MT_ * 256, ECAP_ = 32768;
constexpr int S5K_ = 384, S5R_ = M_ / 16;
constexpr float ALPHA_ = 1.681792830507429f, EPS_ = 1e-5f;
constexpr int NT_ = 512;
constexpr int LDS_BYTES = 163840;

constexpr size_t al256(size_t x) { return (x + 255) & ~(size_t)255; }
constexpr int XCD_BAR_WORDS = 3456;
constexpr size_t WS_BAR = 0;
constexpr size_t WS_CUR = al256(WS_BAR + XCD_BAR_WORDS * 4);
constexpr size_t WS_DONE = al256(WS_CUR + (size_t)2 * L_ * NE_ * 64);
constexpr size_t WS_LNC = al256(WS_DONE + (size_t)2 * L_ * MT_ * 64);
constexpr size_t WS_CTL_END = al256(WS_LNC + (size_t)L_ * 64 * 64);
constexpr size_t WS_XB = WS_CTL_END;
constexpr size_t WS_XC = al256(WS_XB + (size_t)M_ * D_ * 2);
constexpr size_t WS_XCH = WS_XC;
constexpr size_t WS_LOGIT = WS_XC + ((size_t)16 << 20);
constexpr size_t WS_GHL = WS_XC + ((size_t)24 << 20);
constexpr size_t WS_RTC = WS_XC + ((size_t)26 << 20);
constexpr size_t WS_ZB = al256(WS_XC + (size_t)M_ * D_ * 4);
constexpr size_t WS_AS5 = al256(WS_ZB + (size_t)M_ * ZLD_ * 2);
constexpr size_t WS_ESUM = al256(WS_AS5 + (size_t)G5_ * S5R_ * S5K_ * 2);
constexpr size_t WS_QB = al256(WS_ESUM + (size_t)G5_ * S5R_ * 128 * 4);
constexpr size_t WS_KB = al256(WS_QB + (size_t)M_ * DM_ * 2);
constexpr size_t WS_CSUM = al256(WS_KB + (size_t)M_ * DM_ * 2);
constexpr size_t WS_CPREV = al256(WS_CSUM + (size_t)1024 * DH_ * DH_ * 4);
constexpr size_t WS_NSUM = al256(WS_CPREV + (size_t)1024 * DH_ * DH_ * 2);
constexpr size_t WS_NPREV = al256(WS_NSUM + (size_t)1024 * DH_ * 4);
constexpr size_t WS_GG = al256(WS_NPREV + (size_t)1024 * DH_ * 4);
constexpr size_t WS_MLG = al256(WS_GG + 4096);
constexpr size_t WS_MPREV = al256(WS_MLG + 4096);
constexpr size_t WS_IGG = al256(WS_MPREV + 4096);
constexpr size_t WS_BCUM = al256(WS_IGG + (size_t)M_ * 16);
constexpr size_t WS_YB = al256(WS_BCUM + (size_t)M_ * 16);
constexpr size_t WS_GYB = al256(WS_YB + (size_t)M_ * D_ * 2);
constexpr size_t WS_SSQS = al256(WS_GYB + (size_t)M_ * DM_ * 2);
constexpr size_t WS_X1 = al256(WS_SSQS + (size_t)M_ * 32);
constexpr size_t WS_X1B = al256(WS_X1 + (size_t)M_ * D_ * 4);
constexpr size_t WS_X1Q = al256(WS_X1B + (size_t)M_ * D_ * 2);
constexpr size_t WS_BUFT = al256(WS_X1Q + (size_t)M_ * D_);
constexpr size_t WS_BUFW = al256(WS_BUFT + (size_t)NE_ * ECAP_ * 4);
constexpr size_t WS_SLOT = al256(WS_BUFW + (size_t)NE_ * ECAP_ * 4);
constexpr size_t WS_HB = al256(WS_SLOT + (size_t)M_ * 8);
constexpr size_t WS_YE = al256(WS_HB + (size_t)PS2_ * DE_ * 2);
constexpr size_t WS_X2 = al256(WS_YE + (size_t)PS2_ * D_ * 2);
constexpr size_t WS_X2B = al256(WS_X2 + (size_t)M_ * D_ * 4);
constexpr size_t WS_TB = al256(WS_X2B + (size_t)M_ * D_ * 2);
constexpr size_t WS_SSQT = al256(WS_TB + (size_t)M_ * D_ * 2);
constexpr size_t WS_RSTDT = al256(WS_SSQT + (size_t)M_ * 64);
constexpr size_t WS_PBF = al256(WS_RSTDT + (size_t)M_ * 4);
constexpr size_t WS_WIN = al256(WS_PBF + (size_t)L_ * M_ * PLE_ * 2);
constexpr size_t WS_WOUT = al256(WS_WIN + (size_t)L_ * 2048 * D_ * 2);
constexpr size_t WS_WPG = al256(WS_WOUT + (size_t)L_ * D_ * D_ * 2);
constexpr size_t WS_WPP = al256(WS_WPG + (size_t)L_ * D_ * D_ * 2);
constexpr size_t WS_WGLU = al256(WS_WPP + (size_t)L_ * D_ * PLE_ * 2);
constexpr size_t WS_WQK = al256(WS_WGLU + (size_t)L_ * DM_ * DM_ * 2);
constexpr size_t WS_WGATE = al256(WS_WQK + (size_t)L_ * H_ * 256 * DH_ * 2);
constexpr size_t WS_WET = al256(WS_WGATE + (size_t)L_ * 16 * D_ * 2);
constexpr size_t WS_WYT = al256(WS_WET + (size_t)L_ * G5_ * 256 * 256 * 2);
constexpr size_t WS_A16 = al256(WS_WYT + (size_t)L_ * G5_ * 256 * S5K_ * 2);
constexpr size_t WS_WGU = al256(WS_A16 + (size_t)L_ * G5_ * 128 * 4);
constexpr size_t WS_WED = al256(WS_WGU + (size_t)NE_ * D_ * D_ * 2);
constexpr size_t WS_WRT = al256(WS_WED + (size_t)NE_ * D_ * DE_ * 2);
constexpr size_t WS_END = al256(WS_WRT + (size_t)L_ * 36 * D_ * 4);
static_assert(WS_END <= (size_t)1073741824, "workspace over 1 GiB");

struct P { const float* in[37]; float* out; unsigned char* ws; };
typedef const __attribute__((address_space(4))) P& PR;

typedef float f32x2_ __attribute__((ext_vector_type(2)));
typedef __bf16 bf16x2_ __attribute__((ext_vector_type(2)));
DI unsigned cvt_pk_bf16(float lo, float hi) { const f32x2_ v = {lo, hi}; return __builtin_bit_cast(unsigned, __builtin_convertvector(v, bf16x2_)); }
DI float bf2f(bf16_t v) { return __uint_as_float(((unsigned)v) << 16); }
DI float bflo(unsigned v) { return __uint_as_float(v << 16); }
DI float bfhi(unsigned v) { return __uint_as_float(v & 0xffff0000u); }
DI unsigned pack4_fp8(float a, float b, float c, float d) { int w = 0; w = __builtin_amdgcn_cvt_pk_fp8_f32(a, b, w, false); w = __builtin_amdgcn_cvt_pk_fp8_f32(c, d, w, true); return (unsigned)w; }
constexpr float W8_SCALE = 64.0f, W8_INV = 1.0f / 64.0f, YE_SCALE = 32.0f, YE_INV = 1.0f / 32.0f;
DI bf16_t f2bf(float f) { unsigned u = __float_as_uint(f); u += 0x7fffu + ((u >> 16) & 1u); return (bf16_t)(u >> 16); }
DI float wave_sum(float v) {
#pragma unroll
    for (int o = 32; o > 0; o >>= 1) v += __shfl_xor(v, o);
    return v;
}
DI float sigmoidf_(float x) { return 1.0f / (1.0f + expf(-x)); }
DI float siluf_(float x) { return x * sigmoidf_(x); }
DI float fast_sigmoid(float x) { return __builtin_amdgcn_rcpf(1.0f + __builtin_amdgcn_exp2f(-1.4426950408889634f * x)); }
DI float fast_silu(float x) { return x * fast_sigmoid(x); }
DI float fast_gelu_tanh(float x) { const float z2 = 1.5957691216057308f * (x + 0.044715f * x * x * x); return x * fast_sigmoid(z2); }
DI float log_sigmoid_(float x) { return (x >= 0.f) ? -log1pf(expf(-x)) : (x - log1pf(expf(x))); }
DI f32x4 mfma16(bf16x8 a, bf16x8 b, f32x4 c) { return __builtin_amdgcn_mfma_f32_16x16x32_bf16(a, b, c, 0, 0, 0); }
DI bf16x8 ld_frag_g(const bf16_t* p) { return *(const bf16x8*)p; }
DI bf16x8 cat8(s16x4 lo, s16x4 hi) { return __builtin_shufflevector(lo, hi, 0, 1, 2, 3, 4, 5, 6, 7); }
DI unsigned off_b(unsigned row, unsigned ch) { return 256u * row + 16u * (ch ^ (((row & 3u) << 2) | ((row >> 2) & 3u))); }
DI bf16x8 tile_row_read(const LAS unsigned char* tile, int lane, int rb, int s) {
    return *(const LAS bf16x8*)(tile + off_b((unsigned)((lane & 15) + 16 * rb), (unsigned)(4 * s + (lane >> 4))));
}
DI s16x4 tile_tr_read(const LAS unsigned char* tile, int lane, int row0, int c) {
    const unsigned q = (unsigned)(lane & 15) >> 2, p = (unsigned)lane & 3u;
    const unsigned addr = (unsigned)(size_t)tile + off_b((unsigned)row0 + q, (unsigned)(2 * c) + (p >> 1)) + 8u * (p & 1u);
    s16x4 r; asm volatile("ds_read_b64_tr_b16 %0, %1\n\ts_waitcnt lgkmcnt(0)" : "=&v"(r) : "v"(addr) : "memory"); return r;
}

DI unsigned tr_addr(const LAS unsigned char* tile, int lane, int row0, int c) {
    const unsigned q = (unsigned)(lane & 15) >> 2, p = (unsigned)lane & 3u;
    return (unsigned)(size_t)tile + off_b((unsigned)row0 + q, (unsigned)(2 * c) + (p >> 1)) + 8u * (p & 1u);
}
DI void tile_tr_read4(unsigned a0, unsigned a1, unsigned a2, unsigned a3, s16x4& r0, s16x4& r1, s16x4& r2, s16x4& r3) {
    asm volatile("ds_read_b64_tr_b16 %0, %4\n\tds_read_b64_tr_b16 %1, %5\n\tds_read_b64_tr_b16 %2, %6\n\tds_read_b64_tr_b16 %3, %7\n\ts_waitcnt lgkmcnt(0)"
                 : "=&v"(r0), "=&v"(r1), "=&v"(r2), "=&v"(r3) : "v"(a0), "v"(a1), "v"(a2), "v"(a3) : "memory");
}

#define XB_TMO      128
#define XB_XCNT(j)  (256  + 64 * (j))
#define XB_XSUB(j)  (1280 + 64 * (j))
#define XB_XGEN(j)  (2304 + 64 * (j))
#define XB_TOP      3328
#define XB_TOPGEN   3392
#define XB_SPIN_CAP (1u << 18)
DI unsigned xb_ld(unsigned* p)              { return __hip_atomic_load(p, __ATOMIC_RELAXED, __HIP_MEMORY_SCOPE_AGENT); }
DI unsigned xb_add(unsigned* p, unsigned v) { return __hip_atomic_fetch_add(p, v, __ATOMIC_RELAXED, __HIP_MEMORY_SCOPE_AGENT); }
DI unsigned xb_xcc_id() { return (unsigned)__builtin_amdgcn_s_getreg((3 << 11) | 20) & 0xFu; }
#define XB_SPIN(cond, bar) do { unsigned _sp = 0; while (cond) { __builtin_amdgcn_s_sleep(1); \
    if ((++_sp & 255u) == 0u) { if (xb_ld(&(bar)[XB_TMO])) break; if (_sp > XB_SPIN_CAP) { atomicAdd(&(bar)[XB_TMO], 1u); break; } } } } while (0)
struct XcdBarrier { unsigned* bar; unsigned x; volatile LAS unsigned* st; };
DI XcdBarrier xcd_barrier_post(unsigned* bar, volatile LAS unsigned* st) {
    XcdBarrier b; b.bar = bar; b.x = xb_xcc_id(); b.st = st;
    if (threadIdx.x == 0) (void)xb_add(&bar[XB_XCNT(b.x)], 1u);
    return b;
}
DI void xcd_barrier_complete(unsigned* bar, unsigned x, unsigned& nloc, unsigned& nx) {
    const unsigned G = gridDim.x * gridDim.y * gridDim.z;
    unsigned sum, cnt, mine, sp = 0u;
    for (;;) {
        sum = 0u; cnt = 0u; mine = 0u;
#pragma unroll
        for (unsigned j = 0; j < 16; ++j) { const unsigned c = xb_ld(&bar[XB_XCNT(j)]); sum += c; cnt += (c > 0u) ? 1u : 0u; mine = (j == x) ? c : mine; }
        if (sum == G) break;
        __builtin_amdgcn_s_sleep(1);
        if ((++sp & 255u) == 0u) { if (xb_ld(&bar[XB_TMO])) break; if (sp > XB_SPIN_CAP) { atomicAdd(&bar[XB_TMO], 1u); break; } }
    }
    nloc = mine > 0u ? mine : 1u; nx = cnt > 0u ? cnt : 1u;
}
DI void xcd_barrier(const XcdBarrier& b) {
    asm volatile("s_waitcnt vmcnt(0)" ::: "memory");
    __syncthreads();
    if (threadIdx.x == 0) {
        unsigned* bar = b.bar;
        __builtin_amdgcn_s_waitcnt(0);
        unsigned nloc = b.st[0], nx = b.st[1];
        if (nloc == 0u) { xcd_barrier_complete(bar, b.x, nloc, nx); b.st[0] = nloc; b.st[1] = nx; }
        const unsigned old = xb_add(&bar[XB_XSUB(b.x)], 1u);
        const unsigned gen = old / nloc;
        if (old + 1u == (gen + 1u) * nloc) {
            __builtin_amdgcn_fence(__ATOMIC_RELEASE, "agent");
            asm volatile("s_waitcnt vmcnt(0)" ::: "memory");
            const unsigned og = xb_add(&bar[XB_TOP], 1u);
            const unsigned tg = og / nx;
            if (og + 1u == (tg + 1u) * nx) xb_add(&bar[XB_TOPGEN], 1u);
            else XB_SPIN(xb_ld(&bar[XB_TOPGEN]) == tg, bar);
            __builtin_amdgcn_fence(__ATOMIC_ACQUIRE, "agent");
            xb_add(&bar[XB_XGEN(b.x)], 1u);
            asm volatile("s_waitcnt vmcnt(0)" ::: "memory");
        } else {
            XB_SPIN(xb_ld(&bar[XB_XGEN(b.x)]) == gen, bar);
            __builtin_amdgcn_fence(__ATOMIC_ACQUIRE, "agent");
            asm volatile("s_waitcnt vmcnt(0)" ::: "memory");
        }
    }
    __syncthreads();
}

constexpr int BM = 256, BK = 64, HALF = 128, HTB = HALF * BK * 2, STAGE_BYTES = 8 * HTB, NXCD = 8, WGM = 8;
DI int lds_byte(int r, int c) { const int st = (r >> 4) * 2 + (c >> 5), rr = r & 15, cc = c & 31, ob = rr * 64 + cc * 2; return st * 1024 + (ob ^ (((ob >> 9) & 1) << 5)); }
DI void stage_rc(int b, int& R, int& C) { const int st = b / 1024, sb = b % 1024, swz = sb ^ (((sb >> 9) & 1) << 5); R = (st >> 1) * 16 + swz / 64; C = (st & 1) * 32 + (swz % 64) / 2; }
DI int perm32(int rho) { const int n = rho >> 4, i = rho & 15; return 8 * (i >> 2) + 4 * n + (i & 3); }

struct Unit { const char* A; const char* B; int pm, pn, aux; };
struct Gemm { unsigned lda, ldb; int K; };

struct DenseOrder {
    static constexpr bool GATHER = false;
    const char* A; const char* B; unsigned lda, ldb; int nM, nN, nwg, G, c;
    DI void init(const void* A_, const void* B_, unsigned lda_, unsigned ldb_, int M, int N, int G_, int c_) { A = (const char*)A_; B = (const char*)B_; lda = lda_; ldb = ldb_; nM = M / BM; nN = N / BM; nwg = nM * nN; G = G_; c = c_; }
    DI bool next(int i, Unit& u) const {
        const long Lx = (long)i * G + c; if (Lx >= nwg) return false;
        int wgid = (int)Lx; { const int q = nwg / NXCD, r = nwg % NXCD, xcd = wgid % NXCD, off = wgid / NXCD; wgid = (xcd < r ? xcd * (q + 1) : r * (q + 1) + (xcd - r) * q) + off; }
        const int nig = WGM * nN, gid = wgid / nig, fm = gid * WGM, gsz = (nM - fm) < WGM ? (nM - fm) : WGM;
        u.pm = fm + ((wgid % nig) % gsz); u.pn = (wgid % nig) / gsz; u.aux = 0;
        u.A = A + (size_t)u.pm * BM * lda; u.B = B + (size_t)u.pn * BM * ldb; return true;
    }
    DI unsigned voff(const Unit&, int, int) const { return 0u; }
    DI void a_ready(const Unit&) const {}
};
struct GroupOrder {
    static constexpr bool GATHER = false;
    const char* A; const char* B; size_t astride, bstride; unsigned lda; int nunits, G, c;
    DI bool next(int i, Unit& u) const {
        const int Lx = i * G + c; if (Lx >= nunits) return false;
        const int g = Lx >> 2, pm = Lx & 3; u.pm = pm; u.pn = 0; u.aux = g; u.A = A + (size_t)g * astride + (size_t)pm * BM * lda; u.B = B + (size_t)g * bstride; return true;
    }
    DI unsigned voff(const Unit&, int, int) const { return 0u; }
    DI void a_ready(const Unit&) const {}
};
template <bool GATHER_>
struct MoeOrder {
    static constexpr bool GATHER = GATHER_;
    const char* A; const char* B; unsigned lda, ldb; size_t bstride; const LAS int* tbase; const LAS int* cnt; const int* buf_t; unsigned* done; int nunits, G, c, n3, nb;
    DI bool next(int i, Unit& u) const {
        int Lx;
        if constexpr (GATHER_) { Lx = i * G + c; }
        else { const int cr = (c - n3 + G) % G; const bool bonus = (c >= n3) && (c - n3 < nb); if (bonus && i == 0) Lx = c - n3; else Lx = nb + cr + (bonus ? i - 1 : i) * G; }
        if (Lx >= nunits) return false;
        const int T = Lx >> 2, pn = Lx & 3; int e = 0; while (e < NE_ - 1 && tbase[e + 1] <= T) ++e;
        const int k = T - tbase[e]; u.pm = T; u.pn = pn; u.aux = e * 128 + k;
        u.B = B + (size_t)e * bstride + (size_t)pn * BM * ldb; u.A = GATHER_ ? A : A + (size_t)T * BM * lda; return true;
    }
    DI unsigned voff(const Unit& u, int R, int C) const {
        const int e = u.aux >> 7, idx = (u.aux & 127) * 256 + R; const int tok = (idx < cnt[e]) ? buf_t[(size_t)e * ECAP_ + idx] : 0;
        return (unsigned)tok * lda + (unsigned)C * 2u;
    }
    DI void a_ready(const Unit& u) const {
        if constexpr (!GATHER_) {
            if (threadIdx.x < 64) {
                unsigned spins = 0;
                while ((unsigned)__builtin_amdgcn_readfirstlane(__hip_atomic_load(done + 16 * u.pm, __ATOMIC_RELAXED, __HIP_MEMORY_SCOPE_AGENT)) < 32u) { __builtin_amdgcn_s_sleep(2); if (++spins > (1u << 22)) break; }
                __builtin_amdgcn_fence(__ATOMIC_ACQUIRE, "agent");
                asm volatile("s_waitcnt vmcnt(0)" ::: "memory");
            }
            asm volatile("" ::: "memory"); __builtin_amdgcn_s_barrier(); asm volatile("" ::: "memory");
        }
    }
};

template <class Epi, class Sched>
DI void gemm_phase(LAS unsigned char* lds, const Gemm g, const Sched& S, const Epi& E) {
    int tid = threadIdx.x; asm volatile("" : "+v"(tid)); tid &= 511;
    const int wid = __builtin_amdgcn_readfirstlane(tid >> 6), lane = tid & 63, wr = wid >> 2, wc = wid & 3, fr = lane & 15, fq = lane >> 4;
    const int nt = g.K / BK;
    unsigned voffA[2][2], nvoffA[2][2], voffB[2];
#pragma unroll
    for (int i = 0; i < 2; ++i) { int R, C; stage_rc(tid * 16 + i * 8192, R, C); const int Rb = Epi::PERM ? ((R & ~31) + perm32(R & 31)) : R;
        voffB[i] = (unsigned)Rb * g.ldb + (unsigned)C * 2u;
        voffA[0][i] = (unsigned)R * g.lda + (unsigned)C * 2u; voffA[1][i] = (unsigned)(R + HALF) * g.lda + (unsigned)C * 2u;
        nvoffA[0][i] = voffA[0][i]; nvoffA[1][i] = voffA[1][i]; }
    const size_t kstep = (size_t)(BK * 2);
    const size_t hstepB = (size_t)HALF * g.ldb;
    const unsigned ldsw = (unsigned)wid * 1024u;
    const int aoff = lds_byte(wr * 64 + fr, fq * 8), boff = lds_byte(wc * 32 + fr, fq * 8);
#define PG8_SA(b, h) (((b) * 2 + (h)) * HTB)
#define PG8_SB(b, h) ((4 + (b) * 2 + (h)) * HTB)
#define PG8_STAGE(bufoff, gbase, voff) do { _Pragma("unroll") for (int _i = 0; _i < 2; ++_i) \
        __builtin_amdgcn_global_load_lds((const unsigned*)((const char*)(gbase) + (voff)[_i]), (LAS unsigned*)(lds + (bufoff) + ldsw + _i * 8192), 16, 0, 0); } while (0)
#define PG8_LDA(dst, b, h) do { if constexpr (Epi::FP8) { _Pragma("unroll") for (int m = 0; m < 4; ++m) dst##8[m] = __builtin_shufflevector(*(const LAS v4i*)(lds + PG8_SA(b, h) + aoff + m * 2048), *(const LAS v4i*)(lds + PG8_SA(b, h) + aoff + m * 2048 + 1024), 0, 1, 2, 3, 4, 5, 6, 7); } \
        else { _Pragma("unroll") for (int m = 0; m < 4; ++m) _Pragma("unroll") for (int k = 0; k < 2; ++k) dst[m][k] = *(const LAS bf16x8*)(lds + PG8_SA(b, h) + aoff + m * 2048 + k * 1024); } } while (0)
#define PG8_LDB(dst, b, h) do { if constexpr (Epi::FP8) { _Pragma("unroll") for (int n = 0; n < 2; ++n) dst##8[n] = __builtin_shufflevector(*(const LAS v4i*)(lds + PG8_SB(b, h) + boff + n * 2048), *(const LAS v4i*)(lds + PG8_SB(b, h) + boff + n * 2048 + 1024), 0, 1, 2, 3, 4, 5, 6, 7); } \
        else { _Pragma("unroll") for (int n = 0; n < 2; ++n) _Pragma("unroll") for (int k = 0; k < 2; ++k) dst[n][k] = *(const LAS bf16x8*)(lds + PG8_SB(b, h) + boff + n * 2048 + k * 1024); } } while (0)
#define PG8_MMA(ai, bj, At, Bt) do { __builtin_amdgcn_s_setprio(1); _Pragma("unroll") for (int m = 0; m < 4; ++m) _Pragma("unroll") for (int n = 0; n < 2; ++n) { \
        if constexpr (Epi::FP8)   \
            asm volatile("v_mfma_scale_f32_16x16x128_f8f6f4 %0, %1, %2, %0, %3, %3 op_sel_hi:[0,0,0]" : "+v"(acc[ai][bj][m][n]) : "v"(Bt##8[n]), "v"(At##8[m]), "v"(sc8));   \
        else { _Pragma("unroll") for (int k = 0; k < 2; ++k) acc[ai][bj][m][n] = __builtin_amdgcn_mfma_f32_16x16x32_bf16(Bt[n][k], At[m][k], acc[ai][bj][m][n], 0, 0, 0); } } \
        __builtin_amdgcn_s_setprio(0); } while (0)
#define PG8_WAIT_V(n) asm volatile("s_waitcnt vmcnt(" #n ")" ::: "memory")
#define PG8_WAIT_L(n) asm volatile("s_waitcnt lgkmcnt(" #n ")" ::: "memory")
#define PG8_BAR __builtin_amdgcn_s_barrier()
#define PG8_SCHED __builtin_amdgcn_sched_barrier(0)
    Unit cur, nxt; int ui = 0;
    if (!S.next(0, cur)) return;
    if constexpr (Sched::GATHER) {
#pragma unroll
        for (int i = 0; i < 2; ++i) { int R, C; stage_rc(tid * 16 + i * 8192, R, C); voffA[0][i] = S.voff(cur, R, C); voffA[1][i] = S.voff(cur, R + HALF, C); }
    }
    f32x4 acc[2][2][4][2];
#pragma unroll
    for (int a = 0; a < 2; ++a)
#pragma unroll
        for (int b = 0; b < 2; ++b)
#pragma unroll
            for (int m = 0; m < 4; ++m)
#pragma unroll
                for (int n = 0; n < 2; ++n) acc[a][b][m][n] = (f32x4){0.f, 0.f, 0.f, 0.f};
    const int sc8 = 0x7f7f7f7f;
    bf16x8 At[4][2], B0[2][2], B1[2][2]; v8i At8[4], B08[2], B18[2];
    const char* cA = cur.A; const char* cB = cur.B;
    S.a_ready(cur);
    PG8_STAGE(PG8_SB(0, 0), cB, voffB); PG8_STAGE(PG8_SB(0, 1), cB + hstepB, voffB); PG8_STAGE(PG8_SA(0, 0), cA, voffA[0]); PG8_STAGE(PG8_SA(0, 1), cA, voffA[1]);
    if (wr == 1) PG8_BAR;
    PG8_WAIT_V(2); PG8_BAR;
    PG8_STAGE(PG8_SB(1, 0), cB + kstep, voffB); PG8_STAGE(PG8_SA(1, 0), cA + kstep, voffA[0]); PG8_STAGE(PG8_SB(1, 1), cB + hstepB + kstep, voffB);
    PG8_WAIT_V(6); PG8_BAR;
    for (;;) {
        const bool has_next = S.next(ui + 1, nxt);
        const char* nA = has_next ? nxt.A : cA; const char* nB = has_next ? nxt.B : cB;
        if constexpr (Sched::GATHER) {
            if (has_next) {
#pragma unroll
                for (int i = 0; i < 2; ++i) { int R, C; stage_rc(tid * 16 + i * 8192, R, C); nvoffA[0][i] = S.voff(nxt, R, C); nvoffA[1][i] = S.voff(nxt, R + HALF, C); }
            } else {
#pragma unroll
                for (int i = 0; i < 2; ++i) { nvoffA[0][i] = voffA[0][i]; nvoffA[1][i] = voffA[1][i]; }
            }
        }
        for (int t = 0; t < nt; t += 2) {
            const bool last = (t == nt - 2);
            if constexpr (Epi::MIDSCALE) { if (t == nt / 2) E.mid(acc, cur, wr, fr); }
            if (last && has_next) S.a_ready(nxt);
            const char* a1 = cA + (size_t)(t + 1) * kstep;
            const char* a2 = last ? nA : cA + (size_t)(t + 2) * kstep; const char* b2 = last ? nB : cB + (size_t)(t + 2) * kstep;
            const char* a3 = a2 + kstep; const char* b3 = b2 + kstep;
            unsigned va0[2], va1[2];
#pragma unroll
            for (int i = 0; i < 2; ++i) { va0[i] = (Sched::GATHER && last) ? nvoffA[0][i] : voffA[0][i]; va1[i] = (Sched::GATHER && last) ? nvoffA[1][i] : voffA[1][i]; }
            PG8_LDB(B0, 0, 0); PG8_LDB(B1, 0, 1); PG8_SCHED; PG8_LDA(At, 0, 0); PG8_STAGE(PG8_SA(1, 1), a1, voffA[1]);
            PG8_WAIT_V(8); PG8_WAIT_L(0); PG8_BAR; PG8_MMA(0, 0, At, B0); PG8_MMA(0, 1, At, B1); PG8_BAR; PG8_SCHED;
            PG8_LDA(At, 0, 1); PG8_STAGE(PG8_SB(0, 0), b2, voffB); PG8_STAGE(PG8_SB(0, 1), b2 + hstepB, voffB); PG8_STAGE(PG8_SA(0, 0), a2, va0);
            PG8_WAIT_V(8); PG8_WAIT_L(0); PG8_BAR; PG8_MMA(1, 0, At, B0); PG8_MMA(1, 1, At, B1); PG8_BAR; PG8_SCHED;
            PG8_LDB(B0, 1, 0); PG8_LDB(B1, 1, 1); PG8_SCHED; PG8_LDA(At, 1, 0); PG8_STAGE(PG8_SA(0, 1), a2, va1);
            PG8_WAIT_V(8); PG8_WAIT_L(0); PG8_BAR; PG8_MMA(0, 0, At, B0); PG8_MMA(0, 1, At, B1); PG8_BAR; PG8_SCHED;
            PG8_LDA(At, 1, 1); PG8_STAGE(PG8_SB(1, 0), b3, voffB); PG8_STAGE(PG8_SB(1, 1), b3 + hstepB, voffB); PG8_STAGE(PG8_SA(1, 0), a3, va0);
            PG8_WAIT_V(8); PG8_WAIT_L(0); PG8_BAR; PG8_MMA(1, 0, At, B0); PG8_MMA(1, 1, At, B1); PG8_BAR; PG8_SCHED;
        }
        if (wr == 0) PG8_BAR;
        if constexpr (Epi::FP8) {
#define PG8_PIN8(a, b) asm volatile("s_nop 15\n\ts_nop 15" : "+v"(acc[a][b][0][0]), "+v"(acc[a][b][0][1]), "+v"(acc[a][b][1][0]), "+v"(acc[a][b][1][1]), "+v"(acc[a][b][2][0]), "+v"(acc[a][b][2][1]), "+v"(acc[a][b][3][0]), "+v"(acc[a][b][3][1]))
            PG8_PIN8(0, 0); PG8_PIN8(0, 1); PG8_PIN8(1, 0); PG8_PIN8(1, 1);
#undef PG8_PIN8
        }
        { int tz = tid; asm volatile("" : "+v"(tz)); tz &= 511;
          const int wz = __builtin_amdgcn_readfirstlane(tz >> 6), lz = tz & 63; if constexpr (!Epi::AFTER_DRAIN) E(acc, cur, wz >> 2, wz & 3, lz & 15, lz >> 4); }
        if (!has_next) break;
#pragma unroll
        for (int a = 0; a < 2; ++a)
#pragma unroll
            for (int b = 0; b < 2; ++b)
#pragma unroll
                for (int m = 0; m < 4; ++m)
#pragma unroll
                    for (int n = 0; n < 2; ++n) acc[a][b][m][n] = (f32x4){0.f, 0.f, 0.f, 0.f};
        cur = nxt; cA = nA; cB = nB; ++ui;
        if constexpr (Sched::GATHER) {
#pragma unroll
            for (int i = 0; i < 2; ++i) { voffA[0][i] = nvoffA[0][i]; voffA[1][i] = nvoffA[1][i]; }
        }
        if (wr == 1) PG8_BAR;
    }
    PG8_WAIT_V(0);
    PG8_BAR;
    if constexpr (Epi::AFTER_DRAIN) {
        int tz = tid; asm volatile("" : "+v"(tz)); tz &= 511;
        const int wz = __builtin_amdgcn_readfirstlane(tz >> 6), lz = tz & 63; E.fused(acc, cur, wz >> 2, wz & 3, lz & 15, lz >> 4, lds, tz);
    }
#undef PG8_SA
#undef PG8_SB
#undef PG8_STAGE
#undef PG8_LDA
#undef PG8_LDB
#undef PG8_MMA
#undef PG8_WAIT_V
#undef PG8_WAIT_L
#undef PG8_BAR
#undef PG8_SCHED
}


struct EpiInProj {
    static constexpr bool PERM = true, MIDSCALE = false, FP8 = false, AFTER_DRAIN = false;
    bf16_t* zb; bf16_t* AS5;
    DI void operator()(const f32x4 (&acc)[2][2][4][2], const Unit& u, int wr, int wc, int fr, int fq) const {
        const int row0 = u.pm * BM + wr * 64 + fr, col0 = u.pn * BM + wc * 32 + 8 * fq;
#pragma unroll
        for (int ai = 0; ai < 2; ++ai)
#pragma unroll
            for (int m = 0; m < 4; ++m) { const int row = row0 + ai * HALF + m * 16;
#pragma unroll
                for (int bj = 0; bj < 2; ++bj) { const f32x4 v0 = acc[ai][bj][m][0], v1 = acc[ai][bj][m][1]; const int col = col0 + bj * HALF;
                    u32x4 o; o.x = cvt_pk_bf16(v0[0], v0[1]); o.y = cvt_pk_bf16(v0[2], v0[3]); o.z = cvt_pk_bf16(v1[0], v1[1]); o.w = cvt_pk_bf16(v1[2], v1[3]);
                    if (u.pn < 6) *(u32x4*)(zb + (size_t)row * ZLD_ + col) = o;
                    else { const int cs = col - 1536; *(u32x4*)(AS5 + ((size_t)(cs >> 4) * S5R_ + (row >> 4)) * S5K_ + (row & 15) * 16 + (cs & 15)) = o; } } }
    }
};
struct EpiS5E {
    static constexpr bool PERM = false, MIDSCALE = false, FP8 = false, AFTER_DRAIN = false;
    bf16_t* E;
    DI void operator()(const f32x4 (&acc)[2][2][4][2], const Unit& u, int wr, int wc, int fr, int fq) const {
        const int row0 = u.pm * BM + wr * 64 + fr, col0 = wc * 32 + 4 * fq;
#pragma unroll
        for (int ai = 0; ai < 2; ++ai)
#pragma unroll
            for (int m = 0; m < 4; ++m) { bf16_t* rowp = E + ((size_t)u.aux * S5R_ + row0 + ai * HALF + m * 16) * 128 + col0;
#pragma unroll
                for (int n = 0; n < 2; ++n) { const f32x4 v = acc[ai][0][m][n]; u32x2 o; o.x = cvt_pk_bf16(v[0], v[1]); o.y = cvt_pk_bf16(v[2], v[3]); *(u32x2*)(rowp + n * 16) = o; } }
    }
};
struct EpiS5Y {
    static constexpr bool PERM = false, MIDSCALE = false, FP8 = false, AFTER_DRAIN = false;
    bf16_t* gy;
    DI void operator()(const f32x4 (&acc)[2][2][4][2], const Unit& u, int wr, int wc, int fr, int fq) const {
        const int row0 = u.pm * BM + wr * 64 + fr;
#pragma unroll
        for (int ai = 0; ai < 2; ++ai)
#pragma unroll
            for (int m = 0; m < 4; ++m) { const int row = row0 + ai * HALF + m * 16;
#pragma unroll
                for (int bj = 0; bj < 2; ++bj)
#pragma unroll
                    for (int n = 0; n < 2; ++n) { const int j = 8 * bj + 2 * wc + n; const f32x4 v = acc[ai][bj][m][n];
                        u32x2 o; o.x = cvt_pk_bf16(fast_gelu_tanh(v[0]), fast_gelu_tanh(v[1])); o.y = cvt_pk_bf16(fast_gelu_tanh(v[2]), fast_gelu_tanh(v[3]));
                        *(u32x2*)(gy + (size_t)(16 * row + j) * DM_ + 16 * u.aux + 4 * fq) = o; } }
    }
};
struct EpiGlu {
    static constexpr bool PERM = false, MIDSCALE = false, FP8 = false, AFTER_DRAIN = false;
    const bf16_t* gy; const float* b_glu; bf16_t* yb; float* ssqS;
    DI void operator()(const f32x4 (&acc)[2][2][4][2], const Unit& u, int wr, int wc, int fr, int fq) const {
        const int row0 = u.pm * BM + wr * 64 + fr, col0 = u.pn * BM + wc * 32 + 4 * fq;
#pragma unroll
        for (int ai = 0; ai < 2; ++ai)
#pragma unroll
            for (int m = 0; m < 4; ++m) { const int row = row0 + ai * HALF + m * 16; float ss = 0.f;
#pragma unroll
                for (int bj = 0; bj < 2; ++bj)
#pragma unroll
                    for (int n = 0; n < 2; ++n) { const int col = col0 + bj * HALF + n * 16; const f32x4 a = acc[ai][bj][m][n]; const f32x4 bb = *(const f32x4*)(b_glu + col);
                        const u32x2 gv = *(const u32x2*)(gy + (size_t)row * DM_ + col);
                        const float y0 = bflo(gv.x) * fast_sigmoid(a[0] + bb[0]), y1 = bfhi(gv.x) * fast_sigmoid(a[1] + bb[1]), y2 = bflo(gv.y) * fast_sigmoid(a[2] + bb[2]), y3 = bfhi(gv.y) * fast_sigmoid(a[3] + bb[3]);
                        ss += (y0 * y0 + y1 * y1) + (y2 * y2 + y3 * y3);
                        u32x2 o; o.x = cvt_pk_bf16(y0, y1); o.y = cvt_pk_bf16(y2, y3); *(u32x2*)(yb + (size_t)row * D_ + col) = o; }
                ss += __shfl_xor(ss, 16); ss += __shfl_xor(ss, 32);
                if (fq == 0) ssqS[(size_t)row * 8 + u.pn * 4 + wc] = ss; }
    }
};
struct EpiOutProj {
    static constexpr bool PERM = true, MIDSCALE = true, FP8 = false, AFTER_DRAIN = false;
    const bf16_t* xres; const float* ssqS; bf16_t* r1;
    DI void mid(f32x4 (&acc)[2][2][4][2], const Unit& u, int wr, int fr) const {
        const int row0 = u.pm * BM + wr * 64 + fr;
#pragma unroll
        for (int ai = 0; ai < 2; ++ai)
#pragma unroll
            for (int m = 0; m < 4; ++m) { const int row = row0 + ai * HALF + m * 16; const f32x4 s0 = *(const f32x4*)(ssqS + (size_t)row * 8), s1 = *(const f32x4*)(ssqS + (size_t)row * 8 + 4);
                const float rstd = rsqrtf(((s0[0] + s0[1]) + (s0[2] + s0[3]) + (s1[0] + s1[1]) + (s1[2] + s1[3])) * (1.f / DM_) + EPS_);
#pragma unroll
                for (int bj = 0; bj < 2; ++bj)
#pragma unroll
                    for (int n = 0; n < 2; ++n) acc[ai][bj][m][n] = acc[ai][bj][m][n] * rstd; }
    }
    DI void operator()(const f32x4 (&acc)[2][2][4][2], const Unit& u, int wr, int wc, int fr, int fq) const {
        const int row0 = u.pm * BM + wr * 64 + fr, col0 = u.pn * BM + wc * 32 + 8 * fq;
#pragma unroll
        for (int ai = 0; ai < 2; ++ai)
#pragma unroll
            for (int m = 0; m < 4; ++m) { const size_t rb = (size_t)(row0 + ai * HALF + m * 16) * D_ + col0;
#pragma unroll
                for (int bj = 0; bj < 2; ++bj) { const u32x4 xv = *(const u32x4*)(xres + rb + bj * HALF); const f32x4 v0 = acc[ai][bj][m][0], v1 = acc[ai][bj][m][1];
                    u32x4 o; o.x = cvt_pk_bf16(ALPHA_ * bflo(xv.x) + v0[0], ALPHA_ * bfhi(xv.x) + v0[1]); o.y = cvt_pk_bf16(ALPHA_ * bflo(xv.y) + v0[2], ALPHA_ * bfhi(xv.y) + v0[3]);
                    o.z = cvt_pk_bf16(ALPHA_ * bflo(xv.z) + v1[0], ALPHA_ * bfhi(xv.z) + v1[1]); o.w = cvt_pk_bf16(ALPHA_ * bflo(xv.w) + v1[2], ALPHA_ * bfhi(xv.w) + v1[3]);
                    *(u32x4*)(r1 + rb + bj * HALF) = o; } }
    }
};
struct EpiOutLn {
    static constexpr bool PERM = true, MIDSCALE = true, FP8 = false, AFTER_DRAIN = true;
    const bf16_t* xres; const float* ssqS; const bf16_t* ghl; const float* rtc; const float* ln_g; const float* ln_b;
    float* xch; unsigned* cnt; bf16_t* x1b; unsigned char* x1q; unsigned* cur; int* buf_t; float* buf_w; int* slot_of;
    DI void mid(f32x4 (&acc)[2][2][4][2], const Unit& u, int wr, int fr) const {
        const int row0 = u.pm * BM + wr * 64 + fr;
#pragma unroll
        for (int ai = 0; ai < 2; ++ai)
#pragma unroll
            for (int m = 0; m < 4; ++m) { const int row = row0 + ai * HALF + m * 16; const f32x4 s0 = *(const f32x4*)(ssqS + (size_t)row * 8), s1 = *(const f32x4*)(ssqS + (size_t)row * 8 + 4);
                const float rstd = rsqrtf(((s0[0] + s0[1]) + (s0[2] + s0[3]) + (s1[0] + s1[1]) + (s1[2] + s1[3])) * (1.f / DM_) + EPS_);
#pragma unroll
                for (int bj = 0; bj < 2; ++bj)
#pragma unroll
                    for (int n = 0; n < 2; ++n) acc[ai][bj][m][n] = acc[ai][bj][m][n] * rstd; }
    }
    DI void operator()(const f32x4 (&)[2][2][4][2], const Unit&, int, int, int, int) const {}
    DI void fused(f32x4 (&acc)[2][2][4][2], const Unit& u, int wr, int wc, int fr, int fq, LAS unsigned char* lds, int tid) const {
        LAS float* PT4 = (LAS float*)lds;
        LAS float* MS = (LAS float*)(lds + 81920);
        const int row0 = u.pm * BM + wr * 64 + fr, col0 = u.pn * BM + wc * 32 + 8 * fq;
        u32x4 gtv[6];
#pragma unroll
        for (int i = 0; i < 6; ++i) { const int idx = tid + i * NT_; gtv[i] = *(const u32x4*)(ghl + (size_t)(idx >> 5) * D_ + u.pn * BM + (idx & 31) * 8); }
#pragma unroll
        for (int ai = 0; ai < 2; ++ai) {
#pragma unroll
            for (int m = 0; m < 4; ++m) { const size_t rb = (size_t)(row0 + ai * HALF + m * 16) * D_ + col0;
#pragma unroll
                for (int bj = 0; bj < 2; ++bj) { const u32x4 xv = *(const u32x4*)(xres + rb + bj * HALF); f32x4 v0 = acc[ai][bj][m][0], v1 = acc[ai][bj][m][1];
                    v0[0] += ALPHA_ * bflo(xv.x); v0[1] += ALPHA_ * bfhi(xv.x); v0[2] += ALPHA_ * bflo(xv.y); v0[3] += ALPHA_ * bfhi(xv.y);
                    v1[0] += ALPHA_ * bflo(xv.z); v1[1] += ALPHA_ * bfhi(xv.z); v1[2] += ALPHA_ * bflo(xv.w); v1[3] += ALPHA_ * bfhi(xv.w);
                    acc[ai][bj][m][0] = v0; acc[ai][bj][m][1] = v1; } } }
        asm volatile("" ::: "memory");
        LAS unsigned char* GT = lds + 83968;
        LAS float* LG = (LAS float*)(lds + 134656);
        LAS int* cntL = (LAS int*)(lds + 144896); LAS int* baseL = cntL + 32; LAS int* tokE = baseL + 32; LAS float* tokW = (LAS float*)(tokE + 128);
        if (tid < 32) cntL[tid] = 0;
#pragma unroll
        for (int i = 0; i < 6; ++i) { const int idx = tid + i * NT_; *(LAS u32x4*)(GT + (idx >> 5) * 528 + (idx & 31) * 16) = gtv[i]; }
        __syncthreads();
        const LAS unsigned char* gfrag = GT + fr * 528 + (wc * 32 + 8 * fq) * 2;
        float* xq = xch + (size_t)(u.pm * 4 + u.pn) * 256 * 40;
#pragma unroll
        for (int ai = 0; ai < 2; ++ai) {
#pragma unroll
            for (int m = 0; m < 4; ++m) {
                f32x4 d[3]; d[0] = (f32x4){0.f, 0.f, 0.f, 0.f}; d[1] = d[0]; d[2] = d[0]; float s2 = 0.f;
#pragma unroll
                for (int bj = 0; bj < 2; ++bj) { const f32x4 v0 = acc[ai][bj][m][0], v1 = acc[ai][bj][m][1];
                    u32x4 h, lo; h.x = cvt_pk_bf16(v0[0], v0[1]); h.y = cvt_pk_bf16(v0[2], v0[3]); h.z = cvt_pk_bf16(v1[0], v1[1]); h.w = cvt_pk_bf16(v1[2], v1[3]);
                    lo.x = cvt_pk_bf16(v0[0] - bflo(h.x), v0[1] - bfhi(h.x)); lo.y = cvt_pk_bf16(v0[2] - bflo(h.y), v0[3] - bfhi(h.y));
                    lo.z = cvt_pk_bf16(v1[0] - bflo(h.z), v1[1] - bfhi(h.z)); lo.w = cvt_pk_bf16(v1[2] - bflo(h.w), v1[3] - bfhi(h.w));
                    const bf16x8 ah = __builtin_bit_cast(bf16x8, h), al = __builtin_bit_cast(bf16x8, lo);
#pragma unroll
                    for (int ob = 0; ob < 3; ++ob) { const bf16x8 gh = *(const LAS bf16x8*)(gfrag + ob * 16 * 528 + bj * 256), gl = *(const LAS bf16x8*)(gfrag + (48 + ob * 16) * 528 + bj * 256);
                        d[ob] = mfma16(gh, ah, d[ob]); d[ob] = mfma16(gl, ah, d[ob]); d[ob] = mfma16(gh, al, d[ob]); }
                    s2 += ((v0[0] * v0[0] + v0[1] * v0[1]) + (v0[2] * v0[2] + v0[3] * v0[3])) + ((v1[0] * v1[0] + v1[1] * v1[1]) + (v1[2] * v1[2] + v1[3] * v1[3])); }
                s2 += __shfl_xor(s2, 16); s2 += __shfl_xor(s2, 32);
                if (fq == 1) d[2][1] = s2;
                LAS float* rp = PT4 + (wc * 128 + wr * 64 + m * 16 + fr) * 40;
                *(LAS f32x4*)(rp + 4 * fq) = d[0]; *(LAS f32x4*)(rp + 16 + 4 * fq) = d[1]; if (fq < 2) *(LAS f32x4*)(rp + 32 + 4 * fq) = d[2];
            }
            __syncthreads();
            for (int idx = tid; idx < 1280; idx += NT_) { const LAS f32x4* q4 = (const LAS f32x4*)PT4 + idx; const f32x4 s = ((q4[0] + q4[1280]) + q4[2560]) + q4[3840];
                unsigned long long* dst = (unsigned long long*)(xq + (size_t)ai * 5120 + (size_t)idx * 4);
                __hip_atomic_store(dst, ((unsigned long long)__float_as_uint(s[1]) << 32) | __float_as_uint(s[0]), __ATOMIC_RELAXED, __HIP_MEMORY_SCOPE_AGENT);
                __hip_atomic_store(dst + 1, ((unsigned long long)__float_as_uint(s[3]) << 32) | __float_as_uint(s[2]), __ATOMIC_RELAXED, __HIP_MEMORY_SCOPE_AGENT); }
            __syncthreads();
        }
        f32x4 gg[2][2], bb[2][2];
#pragma unroll
        for (int bj = 0; bj < 2; ++bj)
#pragma unroll
            for (int n = 0; n < 2; ++n) { gg[bj][n] = *(const f32x4*)(ln_g + col0 + bj * HALF + 4 * n); bb[bj][n] = *(const f32x4*)(ln_b + col0 + bj * HALF + 4 * n); }
        asm volatile("s_waitcnt vmcnt(0)" ::: "memory");
        if (fr == 0 && fq == 0) __hip_atomic_fetch_add(cnt + 16 * u.pm, 1u, __ATOMIC_RELAXED, __HIP_MEMORY_SCOPE_AGENT);
        if (tid < 64) {
            unsigned spins = 0;
            while ((unsigned)__builtin_amdgcn_readfirstlane(__hip_atomic_load(cnt + 16 * u.pm, __ATOMIC_RELAXED, __HIP_MEMORY_SCOPE_AGENT)) < 32u) { __builtin_amdgcn_s_sleep(2); if (++spins > (1u << 22)) break; }
            __builtin_amdgcn_fence(__ATOMIC_ACQUIRE, "agent");
            asm volatile("s_waitcnt vmcnt(0)" ::: "memory");
        }
        __syncthreads();
        const float* xp = xch + (size_t)u.pm * 4 * 256 * 40;
        {
            const int rl = tid >> 3, rr = u.pn * 64 + rl, q = tid & 7;
            f32x4 pa[4], pb[4]; f32x2_ st[4], sm[4];
#pragma unroll
            for (int t = 0; t < 4; ++t) { const float* rec = xp + ((size_t)t * 256 + rr) * 40; pa[t] = *(const f32x4*)(rec + 4 * q); st[t] = *(const f32x2_*)(rec + 36);
                pb[t] = (f32x4){0.f, 0.f, 0.f, 0.f}; if (q == 0) pb[t] = *(const f32x4*)(rec + 32);
                sm[t] = (f32x2_){0.f, 0.f}; if (tid < 256) sm[t] = *(const f32x2_*)(xp + ((size_t)t * 256 + tid) * 40 + 36); }
            const f32x4 cs = *(const f32x4*)(rtc + 4 * q), bw = *(const f32x4*)(rtc + 40 + 4 * q), cs8 = *(const f32x4*)(rtc + 32), bw8 = *(const f32x4*)(rtc + 72);
            const f32x2_ sr = ((st[0] + st[1]) + st[2]) + st[3], sq = ((sm[0] + sm[1]) + sm[2]) + sm[3];
            const float mean = sr[0] * (1.f / D_), rstd = rsqrtf(fmaxf(sr[1] * (1.f / D_) - mean * mean, 0.f) + EPS_);
            const f32x4 sa = ((pa[0] + pa[1]) + pa[2]) + pa[3], sb = ((pb[0] + pb[1]) + pb[2]) + pb[3];
            *(LAS f32x4*)(LG + rl * 40 + 4 * q) = (sa - cs * mean) * rstd + bw;
            if (q == 0) *(LAS f32x4*)(LG + rl * 40 + 32) = (sb - cs8 * mean) * rstd + bw8;
            if (tid < 256) { const float mq = sq[0] * (1.f / D_); MS[2 * tid] = mq; MS[2 * tid + 1] = rsqrtf(fmaxf(sq[1] * (1.f / D_) - mq * mq, 0.f) + EPS_); }
        }
        __syncthreads();
        if (tid < 64) { const LAS float* lg = LG + tid * 40;
            const f32x4 gl = *(const LAS f32x4*)lg; float mx = gl[0]; int gi = 0;
#pragma unroll
            for (int i = 1; i < 4; ++i) if (gl[i] > mx) { mx = gl[i]; gi = i; }
            float se = 0.f;
#pragma unroll
            for (int i = 0; i < 4; ++i) se += expf(gl[i] - mx);
            const float pg = 1.0f / se;
            const f32x4 e0 = *(const LAS f32x4*)(lg + 4 + gi * 8), e1 = *(const LAS f32x4*)(lg + 8 + gi * 8);
            float ev[8];
#pragma unroll
            for (int i = 0; i < 4; ++i) { ev[i] = e0[i]; ev[4 + i] = e1[i]; }
            int i0 = 0;
#pragma unroll
            for (int i = 1; i < 8; ++i) if (ev[i] > ev[i0]) i0 = i;
            int i1 = (i0 == 0) ? 1 : 0;
#pragma unroll
            for (int i = 0; i < 8; ++i) if (i != i0 && ev[i] > ev[i1]) i1 = i;
            const float e1x = expf(ev[i1] - ev[i0]); const float w0 = 1.f / (1.f + e1x), w1 = e1x / (1.f + e1x);
            const int ea = gi * 8 + i0, eb = gi * 8 + i1;
            const int ra = atomicAdd((int*)&cntL[ea], 1), rb = atomicAdd((int*)&cntL[eb], 1);
            tokE[tid * 2] = (ea << 16) | ra; tokE[tid * 2 + 1] = (eb << 16) | rb; tokW[tid * 2] = pg * w0; tokW[tid * 2 + 1] = pg * w1;
        }
        __syncthreads();
        int basev = 0;
        if (tid < 32) { const int cl = cntL[tid]; basev = cl ? (int)atomicAdd(&cur[tid * 16], (unsigned)cl) : 0; }
#pragma unroll
        for (int ai = 0; ai < 2; ++ai)
#pragma unroll
            for (int m = 0; m < 4; ++m) { const int rl = ai * HALF + wr * 64 + m * 16 + fr; const float mean = MS[2 * rl], rstd = MS[2 * rl + 1]; const size_t rb = (size_t)(u.pm * BM + rl) * D_ + col0;
#pragma unroll
                for (int bj = 0; bj < 2; ++bj) { const f32x4 y0 = (acc[ai][bj][m][0] - mean) * rstd * gg[bj][0] + bb[bj][0], y1 = (acc[ai][bj][m][1] - mean) * rstd * gg[bj][1] + bb[bj][1];
                    u32x4 o; o.x = cvt_pk_bf16(y0[0], y0[1]); o.y = cvt_pk_bf16(y0[2], y0[3]); o.z = cvt_pk_bf16(y1[0], y1[1]); o.w = cvt_pk_bf16(y1[2], y1[3]);
                    *(u32x4*)(x1b + rb + bj * HALF) = o;
                    u32x2 q8; q8.x = pack4_fp8(y0[0], y0[1], y0[2], y0[3]); q8.y = pack4_fp8(y1[0], y1[1], y1[2], y1[3]); *(u32x2*)(x1q + rb + bj * HALF) = q8; } }
        if (tid < 32) baseL[tid] = basev;
        __syncthreads();
        if (tid < 128) { const int v = tokE[tid]; const int e = v >> 16, r = baseL[e] + (v & 0xffff); const int token = u.pm * BM + u.pn * 64 + (tid >> 1);
            buf_t[(size_t)e * ECAP_ + r] = token; buf_w[(size_t)e * ECAP_ + r] = tokW[tid]; slot_of[token * 2 + (tid & 1)] = (e << 16) | r; }
    }
};
struct EpiSiluMul {
    static constexpr bool PERM = true, MIDSCALE = false, FP8 = true, AFTER_DRAIN = false;
    unsigned char* Hb; unsigned* done;
    DI void operator()(const f32x4 (&acc)[2][2][4][2], const Unit& u, int wr, int wc, int fr, int fq) const {
        const int row0 = u.pm * BM + wr * 64 + fr, hu0 = u.pn * 128 + wc * 32 + 8 * fq;
#pragma unroll
        for (int ai = 0; ai < 2; ++ai)
#pragma unroll
            for (int m = 0; m < 4; ++m) { unsigned char* rowp = Hb + (size_t)(row0 + ai * HALF + m * 16) * DE_ + hu0;
                const f32x4 g0 = acc[ai][0][m][0] * W8_INV, g1 = acc[ai][0][m][1] * W8_INV, u0 = acc[ai][1][m][0] * W8_INV, u1 = acc[ai][1][m][1] * W8_INV;
                const unsigned lo = pack4_fp8(fast_silu(g0[0]) * u0[0], fast_silu(g0[1]) * u0[1], fast_silu(g0[2]) * u0[2], fast_silu(g0[3]) * u0[3]);
                const unsigned hi = pack4_fp8(fast_silu(g1[0]) * u1[0], fast_silu(g1[1]) * u1[1], fast_silu(g1[2]) * u1[2], fast_silu(g1[3]) * u1[3]);
                __hip_atomic_store((unsigned long long*)rowp, ((unsigned long long)hi << 32) | lo, __ATOMIC_RELAXED, __HIP_MEMORY_SCOPE_AGENT); }
        asm volatile("s_waitcnt vmcnt(0)" ::: "memory");
        if (fr == 0 && fq == 0) __hip_atomic_fetch_add(done + 16 * u.pm, 1u, __ATOMIC_RELAXED, __HIP_MEMORY_SCOPE_AGENT);
    }
};
struct EpiDown {
    static constexpr bool PERM = true, MIDSCALE = false, FP8 = true, AFTER_DRAIN = false;
    unsigned char* O; const float* buf_w; const LAS int* cnt;
    DI void operator()(const f32x4 (&acc)[2][2][4][2], const Unit& u, int wr, int wc, int fr, int fq) const {
        const int e = u.aux >> 7, kb = (u.aux & 127) * 256, ce = cnt[e];
        const int rl0 = wr * 64 + fr, col0 = u.pn * BM + wc * 32 + 8 * fq;
#pragma unroll
        for (int ai = 0; ai < 2; ++ai)
#pragma unroll
            for (int m = 0; m < 4; ++m) { const int rl = rl0 + ai * HALF + m * 16; const float sc = (kb + rl < ce) ? buf_w[(size_t)e * ECAP_ + kb + rl] * (W8_INV * YE_SCALE) : 0.f;
                unsigned char* rowp = O + (size_t)(u.pm * BM + rl) * D_ + col0;
#pragma unroll
                for (int bj = 0; bj < 2; ++bj) { const f32x4 v0 = acc[ai][bj][m][0] * sc, v1 = acc[ai][bj][m][1] * sc;
                    u32x2 o; o.x = pack4_fp8(v0[0], v0[1], v0[2], v0[3]); o.y = pack4_fp8(v1[0], v1[1], v1[2], v1[3]);
                    *(u32x2*)(rowp + bj * HALF) = o; } }
    }
};
struct EpiT {
    static constexpr bool PERM = false, MIDSCALE = false, FP8 = false, AFTER_DRAIN = false;
    bf16_t* Tb; float* ssqT;
    DI void operator()(const f32x4 (&acc)[2][2][4][2], const Unit& u, int wr, int wc, int fr, int fq) const {
        const int row0 = u.pm * BM + wr * 64 + fr, col0 = u.pn * BM + wc * 32 + 4 * fq;
#pragma unroll
        for (int ai = 0; ai < 2; ++ai)
#pragma unroll
            for (int m = 0; m < 4; ++m) { const int row = row0 + ai * HALF + m * 16; float ss = 0.f;
#pragma unroll
                for (int bj = 0; bj < 2; ++bj)
#pragma unroll
                    for (int n = 0; n < 2; ++n) { const f32x4 a = acc[ai][bj][m][n]; ss += (a[0] * a[0] + a[1] * a[1]) + (a[2] * a[2] + a[3] * a[3]);
                        u32x2 o; o.x = cvt_pk_bf16(a[0], a[1]); o.y = cvt_pk_bf16(a[2], a[3]); *(u32x2*)(Tb + (size_t)row * D_ + col0 + bj * HALF + n * 16) = o; }
                ss += __shfl_xor(ss, 16); ss += __shfl_xor(ss, 32);
                if (fq == 0) ssqT[(size_t)row * 16 + u.pn * 4 + wc] = ss; }
    }
};
struct EpiPle {
    static constexpr bool PERM = true, MIDSCALE = false, FP8 = false, AFTER_DRAIN = false;
    const bf16_t* x2b; const bf16_t* Tb; const float* rstdT; const float* b_pg; const float* ple_g; float* xout; bf16_t* xb;
    DI void operator()(const f32x4 (&acc)[2][2][4][2], const Unit& u, int wr, int wc, int fr, int fq) const {
        const int row0 = u.pm * BM + wr * 64 + fr, col0 = u.pn * BM + wc * 32 + 8 * fq;
        f32x4 bp[2][2], pg[2][2];
#pragma unroll
        for (int bj = 0; bj < 2; ++bj)
#pragma unroll
            for (int n = 0; n < 2; ++n) { bp[bj][n] = *(const f32x4*)(b_pg + col0 + bj * HALF + 4 * n); pg[bj][n] = *(const f32x4*)(ple_g + col0 + bj * HALF + 4 * n); }
#pragma unroll
        for (int ai = 0; ai < 2; ++ai)
#pragma unroll
            for (int m = 0; m < 4; ++m) { const int row = row0 + ai * HALF + m * 16; const float rstd = rstdT[row];
#pragma unroll
                for (int bj = 0; bj < 2; ++bj) { const size_t o = (size_t)row * D_ + col0 + bj * HALF;
                    const u32x4 xv = *(const u32x4*)(x2b + o), tv = *(const u32x4*)(Tb + o);
                    const f32x4 a0 = acc[ai][bj][m][0], a1 = acc[ai][bj][m][1];
                    f32x4 r0, r1;
                    r0[0] = bflo(xv.x) + fast_sigmoid(a0[0] + bp[bj][0][0]) * bflo(tv.x) * rstd * pg[bj][0][0]; r0[1] = bfhi(xv.x) + fast_sigmoid(a0[1] + bp[bj][0][1]) * bfhi(tv.x) * rstd * pg[bj][0][1];
                    r0[2] = bflo(xv.y) + fast_sigmoid(a0[2] + bp[bj][0][2]) * bflo(tv.y) * rstd * pg[bj][0][2]; r0[3] = bfhi(xv.y) + fast_sigmoid(a0[3] + bp[bj][0][3]) * bfhi(tv.y) * rstd * pg[bj][0][3];
                    r1[0] = bflo(xv.z) + fast_sigmoid(a1[0] + bp[bj][1][0]) * bflo(tv.z) * rstd * pg[bj][1][0]; r1[1] = bfhi(xv.z) + fast_sigmoid(a1[1] + bp[bj][1][1]) * bfhi(tv.z) * rstd * pg[bj][1][1];
                    r1[2] = bflo(xv.w) + fast_sigmoid(a1[2] + bp[bj][1][2]) * bflo(tv.w) * rstd * pg[bj][1][2]; r1[3] = bfhi(xv.w) + fast_sigmoid(a1[3] + bp[bj][1][3]) * bfhi(tv.w) * rstd * pg[bj][1][3];
                    if (xout) { *(f32x4*)(xout + o) = r0; *(f32x4*)(xout + o + 4) = r1; }
                    else { u32x4 ob; ob.x = cvt_pk_bf16(r0[0], r0[1]); ob.y = cvt_pk_bf16(r0[2], r0[3]); ob.z = cvt_pk_bf16(r1[0], r1[1]); ob.w = cvt_pk_bf16(r1[2], r1[3]); *(u32x4*)(xb + o) = ob; } } }
    }
};

struct Ctx { int G, bid, tid, lane, w; };
DI const float* IN(PR p, int i) { return p.in[i]; }
template <class T> DI T* WSP(PR p, size_t off) { return (T*)(p.ws + off); }

struct TJob { const float* src0; const float* src1; bf16_t* dst; int ldw, K, N, mode, nmat, krot, kscale_n, fp8; size_t sstr, dstr, kstr; float scale; const float* kscale; };
DI void transpose_job(const TJob& j, int gwave, int nwaves, LAS float* scr, int lane) {
    const int nkb = j.K / 64, nnb = j.N / 32; const long per = (long)nkb * nnb, total = per * j.nmat;
    for (long it = gwave; it < total; it += nwaves) {
        const int mat = (int)(it / per); const int r = (int)(it % per); const int kb = r / nnb, nb = r % nnb, k0 = kb * 64, n0 = nb * 32;
        const int n = n0 + (lane & 31);
        const float* sp; int col;
        if (j.mode == 2) { const int blk = n >> 7; sp = (const float*)((const char*)j.src0 + (ptrdiff_t)(blk & 1) * ((const char*)j.src1 - (const char*)j.src0)); col = 128 * (blk >> 1) + (n & 127); }
        else { sp = j.src0; col = n + ((j.mode == 1 && n >= 1536) ? 8 : 0); }
        sp += (size_t)mat * j.sstr + col;
#pragma unroll
        for (int i = 0; i < 32; ++i) { const int kk = 2 * i + (lane >> 5); const int kd = k0 + kk; const int ksrc = (kd + j.krot) & (j.K - 1);
            float v = sp[(size_t)ksrc * j.ldw] * j.scale; if (j.kscale && kd < j.kscale_n) v *= j.kscale[(size_t)mat * j.kstr + kd];
            scr[kk * 33 + (lane & 31)] = v; }
        __builtin_amdgcn_s_waitcnt(0xC07F); __builtin_amdgcn_wave_barrier();
        const int c = lane & 7;
        bf16_t* d = j.dst + (size_t)mat * j.dstr;
#pragma unroll
        for (int jj = 0; jj < 4; ++jj) { const int nn = (lane >> 3) + 8 * jj; const LAS float* s = scr + (8 * c) * 33 + nn;
            if (j.fp8) { u32x2 o8; o8.x = pack4_fp8(s[0 * 33], s[1 * 33], s[2 * 33], s[3 * 33]); o8.y = pack4_fp8(s[4 * 33], s[5 * 33], s[6 * 33], s[7 * 33]);
                *(u32x2*)((unsigned char*)j.dst + (size_t)mat * j.dstr + (size_t)(n0 + nn) * j.K + k0 + 8 * c) = o8; }
            else { u32x4 o; o.x = cvt_pk_bf16(s[0 * 33], s[1 * 33]); o.y = cvt_pk_bf16(s[2 * 33], s[3 * 33]); o.z = cvt_pk_bf16(s[4 * 33], s[5 * 33]); o.w = cvt_pk_bf16(s[6 * 33], s[7 * 33]);
                *(u32x4*)(d + (size_t)(n0 + nn) * j.K + k0 + 8 * c) = o; } }
        __builtin_amdgcn_s_waitcnt(0xC07F); __builtin_amdgcn_wave_barrier();
    }
}
DI TJob mk_job(const float* s0, const float* s1, int ldw, int K, int N, bf16_t* dst, int mode, int nmat, size_t sstr, size_t dstr, float scale = 1.f) {
    TJob j; j.src0 = s0; j.src1 = s1; j.dst = dst; j.ldw = ldw; j.K = K; j.N = N; j.mode = mode; j.nmat = nmat; j.krot = 0; j.kscale_n = 0; j.fp8 = 0; j.sstr = sstr; j.dstr = dstr; j.kstr = 0; j.scale = scale; j.kscale = nullptr; return j;
}
DI void cvt_rows(const float* __restrict__ src, bf16_t* __restrict__ dst, size_t n8, size_t gt, size_t nthreads) {
    for (size_t i = gt; i < n8; i += nthreads) { const f32x4 a = ((const f32x4*)src)[2 * i], b = ((const f32x4*)src)[2 * i + 1];
        u32x4 o; o.x = cvt_pk_bf16(a[0], a[1]); o.y = cvt_pk_bf16(a[2], a[3]); o.z = cvt_pk_bf16(b[0], b[1]); o.w = cvt_pk_bf16(b[2], b[3]); ((u32x4*)dst)[i] = o; }
}
DI void moe_weight_jobs(PR p, const Ctx& c, int l, LAS unsigned char* lds, bool probe_dummy = false) {
    LAS float* scr = (LAS float*)(lds + c.w * 8448);
    const int gwave = c.bid * 4 + (c.w - 4), nwaves = c.G * 4;
    { TJob j = mk_job(IN(p, 28) + (size_t)l * NE_ * D_ * DE_, IN(p, 29) + (size_t)l * NE_ * D_ * DE_, DE_, D_, D_, probe_dummy ? WSP<bf16_t>(p, WS_YE) : WSP<bf16_t>(p, WS_WGU), 2, NE_, (size_t)D_ * DE_, (size_t)D_ * D_, W8_SCALE); j.fp8 = 1;
      transpose_job(j, gwave, nwaves, scr, c.lane); }
    { TJob j = mk_job(IN(p, 30) + (size_t)l * NE_ * DE_ * D_, nullptr, D_, DE_, D_, probe_dummy ? WSP<bf16_t>(p, WS_YE) + (size_t)NE_ * D_ * D_ / 2 : WSP<bf16_t>(p, WS_WED), 0, NE_, (size_t)DE_ * D_, (size_t)D_ * DE_, W8_SCALE); j.fp8 = 1;
      transpose_job(j, gwave, nwaves, scr, c.lane); }
}

DI void s5_prep_job(PR p, int lg, LAS unsigned char* lds, int tid) {
    LAS float* apr = (LAS float*)lds;
    LAS float* api = apr + 17 * 64;
    LAS float* bbr = api + 17 * 64;
    LAS float* bbi = bbr + 1024;
    LAS float* ccr = bbi + 1024;
    LAS float* cci = ccr + 16 * 68;
    LAS float* kd = cci + 16 * 68;
    const float* lam_re = IN(p, 10); const float* lam_im = IN(p, 11); const float* b_re = IN(p, 13); const float* b_im = IN(p, 14); const float* c_re = IN(p, 15); const float* c_im = IN(p, 16);
    const float dt = expf(IN(p, 12)[lg]);
    __syncthreads();
    for (int idx = tid; idx < 17 * 64; idx += NT_) { const int pp = idx & 63, d = idx >> 6; const float lr = lam_re[lg * 64 + pp], li = lam_im[lg * 64 + pp];
        const float er = expf((float)d * lr * dt), ang = (float)d * li * dt; apr[d * 64 + pp] = er * cosf(ang); api[d * 64 + pp] = er * sinf(ang); }
    for (int idx = tid; idx < 1024; idx += NT_) { const int pp = idx >> 4, ci = idx & 15; const float lr = lam_re[lg * 64 + pp], li = lam_im[lg * 64 + pp];
        const float er = expf(lr * dt), ar = er * cosf(li * dt), ai = er * sinf(li * dt); const float mag2 = lr * lr + li * li, xr0 = ar - 1.f, xi0 = ai;
        const float cr = (xr0 * lr + xi0 * li) / mag2, cim = (xi0 * lr - xr0 * li) / mag2; const float br = b_re[(size_t)(lg * 64 + pp) * 16 + ci], bi = b_im[(size_t)(lg * 64 + pp) * 16 + ci];
        bbr[pp * 16 + ci] = cr * br - cim * bi; bbi[pp * 16 + ci] = cr * bi + cim * br; }
    for (int idx = tid; idx < 1024; idx += NT_) { ccr[(idx >> 6) * 68 + (idx & 63)] = c_re[(size_t)lg * 1024 + idx]; cci[(idx >> 6) * 68 + (idx & 63)] = c_im[(size_t)lg * 1024 + idx]; }
    __syncthreads();
    {
        const int d = tid >> 5, co = (tid >> 1) & 15, hf = tid & 1; f32x4 v0 = (f32x4){0.f, 0.f, 0.f, 0.f}, v1 = v0;
        for (int pp = 0; pp < 64; ++pp) { const float ar = apr[d * 64 + pp], ai = api[d * 64 + pp], cr = ccr[co * 68 + pp], ci_ = cci[co * 68 + pp];
            const float wr_ = cr * ar - ci_ * ai, wi_ = cr * ai + ci_ * ar;
            const f32x4 r0 = *(const LAS f32x4*)(bbr + pp * 16 + hf * 8), r1 = *(const LAS f32x4*)(bbr + pp * 16 + hf * 8 + 4), i0 = *(const LAS f32x4*)(bbi + pp * 16 + hf * 8), i1 = *(const LAS f32x4*)(bbi + pp * 16 + hf * 8 + 4);
            v0 = v0 + r0 * wr_ - i0 * wi_; v1 = v1 + r1 * wr_ - i1 * wi_; }
        if (d == 0) { const float dsk = IN(p, 17)[lg * 16 + co];
#pragma unroll
            for (int e = 0; e < 4; ++e) { if (co == hf * 8 + e) v0[e] += dsk; if (co == hf * 8 + 4 + e) v1[e] += dsk; } }
        *(LAS f32x4*)(kd + (d * 16 + co) * 16 + hf * 8) = v0; *(LAS f32x4*)(kd + (d * 16 + co) * 16 + hf * 8 + 4) = v1; }
    __syncthreads();
    bf16_t* wy = WSP<bf16_t>(p, WS_WYT) + (size_t)lg * 256 * S5K_;
    for (int idx = tid; idx < 256 * 48; idx += NT_) { const int n = idx / 48, kc = idx % 48, j = n >> 4, co = n & 15; f32x4 v0 = (f32x4){0.f, 0.f, 0.f, 0.f}, v1 = v0;
        if (kc < 32) { const int i = kc >> 1, ci0 = (kc & 1) * 8; if (i <= j) { v0 = *(const LAS f32x4*)(kd + ((j - i) * 16 + co) * 16 + ci0); v1 = *(const LAS f32x4*)(kd + ((j - i) * 16 + co) * 16 + ci0 + 4); } }
        else { const int kk0 = (kc - 32) * 8, pp0 = kk0 & 63;
            const f32x4 c0r = *(const LAS f32x4*)(ccr + co * 68 + pp0), c1r = *(const LAS f32x4*)(ccr + co * 68 + pp0 + 4), c0i = *(const LAS f32x4*)(cci + co * 68 + pp0), c1i = *(const LAS f32x4*)(cci + co * 68 + pp0 + 4);
            const f32x4 a0r = *(const LAS f32x4*)(apr + (j + 1) * 64 + pp0), a1r = *(const LAS f32x4*)(apr + (j + 1) * 64 + pp0 + 4), a0i = *(const LAS f32x4*)(api + (j + 1) * 64 + pp0), a1i = *(const LAS f32x4*)(api + (j + 1) * 64 + pp0 + 4);
            if (kk0 < 64) { v0 = c0r * a0r - c0i * a0i; v1 = c1r * a1r - c1i * a1i; } else { v0 = -(c0r * a0i + c0i * a0r); v1 = -(c1r * a1i + c1i * a1r); } }
        u32x4 o; o.x = cvt_pk_bf16(v0[0], v0[1]); o.y = cvt_pk_bf16(v0[2], v0[3]); o.z = cvt_pk_bf16(v1[0], v1[1]); o.w = cvt_pk_bf16(v1[2], v1[3]);
        *(u32x4*)(wy + (size_t)n * S5K_ + kc * 8) = o; }
    bf16_t* we = WSP<bf16_t>(p, WS_WET) + (size_t)lg * 256 * 256;
    for (int idx = tid; idx < 256 * 32; idx += NT_) { const int n = idx >> 5, kc = idx & 31; f32x4 v0 = (f32x4){0.f, 0.f, 0.f, 0.f}, v1 = v0;
        if (n < 128) { const int pp = n & 63, i = kc >> 1, ci0 = (kc & 1) * 8; const float ar = apr[(15 - i) * 64 + pp], ai = api[(15 - i) * 64 + pp];
            const f32x4 r0 = *(const LAS f32x4*)(bbr + pp * 16 + ci0), r1 = *(const LAS f32x4*)(bbr + pp * 16 + ci0 + 4), i0 = *(const LAS f32x4*)(bbi + pp * 16 + ci0), i1 = *(const LAS f32x4*)(bbi + pp * 16 + ci0 + 4);
            if (n < 64) { v0 = r0 * ar - i0 * ai; v1 = r1 * ar - i1 * ai; } else { v0 = i0 * ar + r0 * ai; v1 = i1 * ar + r1 * ai; } }
        u32x4 o; o.x = cvt_pk_bf16(v0[0], v0[1]); o.y = cvt_pk_bf16(v0[2], v0[3]); o.z = cvt_pk_bf16(v1[0], v1[1]); o.w = cvt_pk_bf16(v1[2], v1[3]);
        *(u32x4*)(we + (size_t)n * 256 + kc * 8) = o; }
    if (tid < 64) { float* A16 = WSP<float>(p, WS_A16); A16[(size_t)lg * 128 + tid] = apr[16 * 64 + tid]; A16[(size_t)lg * 128 + 64 + tid] = api[16 * 64 + tid]; }
}

DI void ph_prologue(PR p, const Ctx& c, LAS unsigned char* lds, int sel = 15) {
    const size_t gt = (size_t)c.bid * NT_ + c.tid, nth = (size_t)c.G * NT_;
    if (sel & 1) {
    cvt_rows(IN(p, 0), WSP<bf16_t>(p, WS_XB), (size_t)M_ * D_ / 8, gt, nth);
    cvt_rows(IN(p, 1), WSP<bf16_t>(p, WS_PBF), (size_t)L_ * M_ * PLE_ / 8, gt, nth);
    }
    if (sel & 2) {
    { bf16_t* wg = WSP<bf16_t>(p, WS_WGATE); const float* w_in = IN(p, 2);
      for (size_t i = gt; i < (size_t)L_ * 16 * D_; i += nth) { const int k = (int)(i % D_), n = (int)((i / D_) % 16), l = (int)(i / (16 * D_));
          wg[i] = (n < 8) ? f2bf(w_in[((size_t)l * D_ + k) * DIN_ + 1536 + n]) : (bf16_t)0; } }
    { bf16_t* ghl = WSP<bf16_t>(p, WS_GHL); const float* w_grp = IN(p, 24); const float* w_rt = IN(p, 26); const float* lng = IN(p, 22);
      for (size_t i = gt; i < (size_t)L_ * 48 * D_; i += nth) { const int k = (int)(i % D_), o = (int)((i / D_) % 48), l = (int)(i / (48 * D_));
          const float gk = lng[(size_t)l * D_ + k];
          const float v = (o < 4) ? w_grp[((size_t)l * D_ + k) * 4 + o] * gk : (o < 36) ? w_rt[((size_t)l * D_ + k) * 32 + (o - 4)] * gk : (o == 36 ? 1.f : 0.f);
          const bf16_t h = f2bf(v); ghl[((size_t)(l * 2) * 48 + o) * D_ + k] = h; ghl[((size_t)(l * 2 + 1) * 48 + o) * D_ + k] = f2bf(v - bf2f(h)); } }
    { float* rtc = WSP<float>(p, WS_RTC); const float* w_grp = IN(p, 24); const float* w_rt = IN(p, 26); const float* lng = IN(p, 22); const float* lnb = IN(p, 23);
      for (int job = c.bid * 8 + c.w; job < L_ * 40; job += c.G * 8) { const int l = job / 40, o = job % 40; float cs = 0.f, bw = 0.f;
          if (o < 36) { for (int k = c.lane; k < D_; k += 64) { const float wv = (o < 4) ? w_grp[((size_t)l * D_ + k) * 4 + o] : w_rt[((size_t)l * D_ + k) * 32 + (o - 4)];
                  cs += wv * lng[(size_t)l * D_ + k]; bw += wv * lnb[(size_t)l * D_ + k]; }
              cs = wave_sum(cs); bw = wave_sum(bw) + ((o < 4) ? IN(p, 25)[l * 4 + o] : IN(p, 27)[l * 32 + o - 4]); }
          if (c.lane == 0) { rtc[(l * 2) * 40 + o] = cs; rtc[(l * 2 + 1) * 40 + o] = bw; } } }
    }
    LAS float* scr = (LAS float*)(lds + c.w * 8448);
    const int gwave = c.bid * 8 + c.w, nwaves = c.G * 8;
    const bool split = (sel == 15) && (c.G >= 2 * L_ * G5_);
    if (split) {
        if (c.bid < L_ * G5_) { s5_prep_job(p, c.bid, lds, c.tid); __syncthreads(); }
        else transpose_job(mk_job(IN(p, 2), nullptr, DIN_, D_, 2048, WSP<bf16_t>(p, WS_WIN), 1, L_, (size_t)D_ * DIN_, (size_t)2048 * D_), (c.bid - L_ * G5_) * 8 + c.w, (c.G - L_ * G5_) * 8, scr, c.lane);
    }
    if (sel & 4) {
    if (!split) transpose_job(mk_job(IN(p, 2), nullptr, DIN_, D_, 2048, WSP<bf16_t>(p, WS_WIN), 1, L_, (size_t)D_ * DIN_, (size_t)2048 * D_), gwave, nwaves, scr, c.lane);
    { TJob j = mk_job(IN(p, 21), nullptr, D_, D_, D_, WSP<bf16_t>(p, WS_WOUT), 0, L_, (size_t)D_ * D_, (size_t)D_ * D_); j.krot = 512; j.kscale = IN(p, 20); j.kscale_n = 512; j.kstr = DM_;
      transpose_job(j, gwave, nwaves, scr, c.lane); }
    transpose_job(mk_job(IN(p, 33), nullptr, D_, D_, D_, WSP<bf16_t>(p, WS_WPG), 0, L_, (size_t)D_ * D_, (size_t)D_ * D_), gwave, nwaves, scr, c.lane);
    transpose_job(mk_job(IN(p, 35), nullptr, D_, PLE_, D_, WSP<bf16_t>(p, WS_WPP), 0, L_, (size_t)PLE_ * D_, (size_t)D_ * PLE_), gwave, nwaves, scr, c.lane);
    transpose_job(mk_job(IN(p, 18), nullptr, DM_, DM_, DM_, WSP<bf16_t>(p, WS_WGLU), 0, L_, (size_t)DM_ * DM_, (size_t)DM_ * DM_), gwave, nwaves, scr, c.lane);
    transpose_job(mk_job(IN(p, 5), nullptr, DH_, DH_, DH_, WSP<bf16_t>(p, WS_WQK), 0, L_ * H_, (size_t)DH_ * DH_, (size_t)256 * DH_), gwave, nwaves, scr, c.lane);
    transpose_job(mk_job(IN(p, 6), nullptr, DH_, DH_, DH_, WSP<bf16_t>(p, WS_WQK) + (size_t)DH_ * DH_, 0, L_ * H_, (size_t)DH_ * DH_, (size_t)256 * DH_, 0.08838834764831845f), gwave, nwaves, scr, c.lane);
    }
    if ((sel & 8) && !split) { for (int job = c.bid; job < L_ * G5_; job += c.G) { s5_prep_job(p, job, lds, c.tid); __syncthreads(); } }
}

DI void ph_inproj(PR p, const Ctx& c, int l, LAS unsigned char* lds) {
    DenseOrder S; S.init(WSP<bf16_t>(p, WS_XB), WSP<bf16_t>(p, WS_WIN) + (size_t)l * 2048 * D_, D_ * 2, D_ * 2, M_, 2048, c.G, c.bid);
    EpiInProj E{WSP<bf16_t>(p, WS_ZB), WSP<bf16_t>(p, WS_AS5)};
    gemm_phase<EpiInProj, DenseOrder>(lds, Gemm{(unsigned)(D_ * 2), (unsigned)(D_ * 2), D_}, S, E);
}

DI void mlstm_sum_unit(PR p, const Ctx& c, int l, int unit, LAS unsigned char* lds) {
    LAS unsigned char* ctile = lds;
    LAS unsigned char* ktile = lds + 32768;
    LAS unsigned char* vtile = lds + 65536;
    LAS float* wsS = (LAS float*)(lds + 98304);
    LAS float* gred = wsS + 256;
    const bf16_t* zb = WSP<bf16_t>(p, WS_ZB); const bf16_t* xb = WSP<bf16_t>(p, WS_XB); const bf16_t* wgate = WSP<bf16_t>(p, WS_WGATE) + (size_t)l * 16 * D_;
    const bf16_t* wqkT = WSP<bf16_t>(p, WS_WQK) + (size_t)l * H_ * 256 * DH_;
    const float* cw = IN(p, 3) + (size_t)l * 4 * DM_; const float* cb = IN(p, 4) + (size_t)l * DM_; const float* b_i = IN(p, 7) + l * H_; const float* b_f = IN(p, 8) + l * H_;
    bf16_t* cvb = WSP<bf16_t>(p, WS_QB); bf16_t* Csum = WSP<bf16_t>(p, WS_CSUM); float* nsum = WSP<float>(p, WS_NSUM);
    float* gG = WSP<float>(p, WS_GG); float* mlG = WSP<float>(p, WS_MLG); float* igG = WSP<float>(p, WS_IGG); float* bcumG = WSP<float>(p, WS_BCUM);
    const int tid = c.tid, lane = c.lane, w = c.w, fr = lane & 15, fq = lane >> 4, hh = w >> 2, wq = w & 3;
    const int b = unit / (S_ / 64), cc = unit % (S_ / 64); const int tok0 = b * S_ + cc * 64;
    __syncthreads();
    {
        f32x4 ga[4];
#pragma unroll
        for (int ms = 0; ms < 4; ++ms) ga[ms] = (f32x4){0.f, 0.f, 0.f, 0.f};
#pragma unroll
        for (int kk = 0; kk < 4; ++kk) { const int ks = 4 * w + kk; const bf16x8 bw = ld_frag_g(wgate + (size_t)fr * D_ + 32 * ks + 8 * fq);
#pragma unroll
            for (int ms = 0; ms < 4; ++ms) { const bf16x8 af = ld_frag_g(xb + (size_t)(tok0 + 16 * ms + fr) * D_ + 32 * ks + 8 * fq); ga[ms] = mfma16(af, bw, ga[ms]); } }
#pragma unroll
        for (int ms = 0; ms < 4; ++ms)
#pragma unroll
            for (int r = 0; r < 4; ++r) gred[(w * 64 + 16 * ms + 4 * fq + r) * 16 + fr] = ga[ms][r];
    }
    __syncthreads();
    if (w < 4) {
        const int h = w; const int tok = tok0 + lane; float ip = 0.f, fp = 0.f;
#pragma unroll
        for (int ww = 0; ww < 8; ++ww) { ip += gred[(ww * 64 + lane) * 16 + h]; fp += gred[(ww * 64 + lane) * 16 + 4 + h]; }
        const float ig = ip + b_i[h]; const float lf = log_sigmoid_(fp + b_f[h]);
        float cum = lf;
#pragma unroll
        for (int o = 1; o < 64; o <<= 1) { const float t = __shfl_up(cum, o); if (lane >= o) cum += t; }
        const float g = __shfl(cum, 63); const float a = g - cum + ig;
        float mx = a;
#pragma unroll
        for (int o = 32; o > 0; o >>= 1) mx = fmaxf(mx, __shfl_xor(mx, o));
        wsS[h * 64 + lane] = __expf(a - mx);
        igG[(size_t)tok * 4 + h] = ig; bcumG[(size_t)tok * 4 + h] = cum;
        if (lane == 0) { gG[(b * H_ + h) * 32 + cc] = g; mlG[(b * H_ + h) * 32 + cc] = mx; }
    }
    for (int rd = 0; rd < 2; ++rd) {
        for (int it = tid; it < 2048; it += NT_) { const int hq = it >> 10, sr = (it >> 4) & 63, cg = it & 15; const int t = cc * 64 + sr; const int ch0 = (2 * rd + hq) * DH_ + cg * 8;
            float a[8];
#pragma unroll
            for (int e = 0; e < 8; ++e) a[e] = cb[ch0 + e];
#pragma unroll
            for (int j = 0; j < 4; ++j) { if (t - 3 + j >= 0) { const u32x4 uv = *(const u32x4*)(zb + (size_t)(tok0 + sr - 3 + j) * ZLD_ + ch0);
                    const float* wj = cw + j * DM_ + ch0;
                    a[0] += wj[0] * bflo(uv.x); a[1] += wj[1] * bfhi(uv.x); a[2] += wj[2] * bflo(uv.y); a[3] += wj[3] * bfhi(uv.y);
                    a[4] += wj[4] * bflo(uv.z); a[5] += wj[5] * bfhi(uv.z); a[6] += wj[6] * bflo(uv.w); a[7] += wj[7] * bfhi(uv.w); } }
            u32x4 o; o.x = cvt_pk_bf16(fast_silu(a[0]), fast_silu(a[1])); o.y = cvt_pk_bf16(fast_silu(a[2]), fast_silu(a[3])); o.z = cvt_pk_bf16(fast_silu(a[4]), fast_silu(a[5])); o.w = cvt_pk_bf16(fast_silu(a[6]), fast_silu(a[7]));
            *(LAS u32x4*)(ctile + hq * 16384 + off_b(sr, cg)) = o; *(u32x4*)(cvb + (size_t)(tok0 + sr) * DM_ + ch0) = o;
            *(LAS u32x4*)(vtile + hq * 16384 + off_b(sr, cg)) = *(const u32x4*)(zb + (size_t)(tok0 + sr) * ZLD_ + 512 + ch0);
        }
        __syncthreads();
        const int h = 2 * rd + hh;
        const LAS unsigned char* ct = ctile + hh * 16384; LAS unsigned char* kt = ktile + hh * 16384; const LAS unsigned char* vt = vtile + hh * 16384;
        if (wq >= 2) {
            f32x4 acc[4][4];
#pragma unroll
            for (int ms = 0; ms < 4; ++ms)
#pragma unroll
                for (int i = 0; i < 4; ++i) acc[ms][i] = (f32x4){0.f, 0.f, 0.f, 0.f};
#pragma unroll
            for (int ks = 0; ks < 4; ++ks) {
                bf16x8 wf[4];
#pragma unroll
                for (int i = 0; i < 4; ++i) wf[i] = ld_frag_g(wqkT + ((size_t)(h * 256 + 16 * (4 * wq + i) + fr)) * DH_ + 32 * ks + 8 * fq);
#pragma unroll
                for (int ms = 0; ms < 4; ++ms) { const bf16x8 cf = tile_row_read(ct, lane, ms, ks);
#pragma unroll
                    for (int i = 0; i < 4; ++i) acc[ms][i] = mfma16(wf[i], cf, acc[ms][i]); }
            }
#pragma unroll
            for (int ms = 0; ms < 4; ++ms) { const int sr = 16 * ms + fr; const float wsv = wsS[h * 64 + sr];
#pragma unroll
                for (int i = 0; i < 4; ++i) { const int nf = 4 * wq + i; const f32x4 v = acc[ms][i];
                    u32x2 o; o.x = cvt_pk_bf16(v[0], v[1]); o.y = cvt_pk_bf16(v[2], v[3]);
                    const f32x4 kr = (f32x4){bflo(o.x), bfhi(o.x), bflo(o.y), bfhi(o.y)};
                    { const int col = 16 * (nf - 8) + 4 * fq;
                        u32x2 o2; o2.x = cvt_pk_bf16(v[0] * wsv, v[1] * wsv); o2.y = cvt_pk_bf16(v[2] * wsv, v[3] * wsv); (void)kr;
                        *(LAS u32x2*)(kt + off_b(sr, col >> 3) + 2 * (col & 7)) = o2; } } }
        }
        __syncthreads();
        {
            f32x4 acc[2][8];
#pragma unroll
            for (int i = 0; i < 2; ++i)
#pragma unroll
                for (int nd = 0; nd < 8; ++nd) acc[i][nd] = (f32x4){0.f, 0.f, 0.f, 0.f};
#pragma unroll
            for (int ks = 0; ks < 2; ++ks) {
                s16x4 va[2][2], kbq[8][2];
                tile_tr_read4(tr_addr(vt, lane, 32 * ks + 8 * fq, 2 * wq), tr_addr(vt, lane, 32 * ks + 8 * fq + 4, 2 * wq), tr_addr(vt, lane, 32 * ks + 8 * fq, 2 * wq + 1), tr_addr(vt, lane, 32 * ks + 8 * fq + 4, 2 * wq + 1),
                              va[0][0], va[0][1], va[1][0], va[1][1]);
#pragma unroll
                for (int nd = 0; nd < 8; nd += 2)
                    tile_tr_read4(tr_addr(kt, lane, 32 * ks + 8 * fq, nd), tr_addr(kt, lane, 32 * ks + 8 * fq + 4, nd), tr_addr(kt, lane, 32 * ks + 8 * fq, nd + 1), tr_addr(kt, lane, 32 * ks + 8 * fq + 4, nd + 1),
                                  kbq[nd][0], kbq[nd][1], kbq[nd + 1][0], kbq[nd + 1][1]);
#pragma unroll
                for (int nd = 0; nd < 8; ++nd) { const bf16x8 kf = cat8(kbq[nd][0], kbq[nd][1]);
#pragma unroll
                    for (int i = 0; i < 2; ++i) acc[i][nd] = mfma16(kf, cat8(va[i][0], va[i][1]), acc[i][nd]); }
            }
            bf16_t* Cp = Csum + ((size_t)((b * H_ + h) * 32 + cc)) * DH_ * DH_;
#pragma unroll
            for (int i = 0; i < 2; ++i)
#pragma unroll
                for (int nd = 0; nd < 8; ++nd) { u32x2 o; o.x = cvt_pk_bf16(acc[i][nd][0], acc[i][nd][1]); o.y = cvt_pk_bf16(acc[i][nd][2], acc[i][nd][3]); *(u32x2*)(Cp + (size_t)(16 * (2 * wq + i) + fr) * DH_ + 16 * nd + 4 * fq) = o; }
            if ((tid & 255) < DH_) { float sacc = 0.f; const int d = tid & 255;
                for (int sr = 0; sr < 64; ++sr) sacc += bf2f(*(const LAS bf16_t*)(kt + off_b(sr, d >> 3) + 2 * (d & 7)));
                nsum[((size_t)((b * H_ + h) * 32 + cc)) * DH_ + d] = sacc; }
        }
        __syncthreads();
    }
}
DI void ph_mix1(PR p, const Ctx& c, int l, LAS unsigned char* lds) {
    for (int unit = c.bid; unit < NB_ * (S_ / 64); unit += c.G) mlstm_sum_unit(p, c, l, unit, lds);
    __syncthreads();
    GroupOrder S; S.A = (const char*)WSP<bf16_t>(p, WS_AS5); S.B = (const char*)(WSP<bf16_t>(p, WS_WET) + (size_t)l * G5_ * 256 * 256); S.astride = (size_t)S5R_ * S5K_ * 2; S.bstride = (size_t)256 * 256 * 2;
    S.lda = S5K_ * 2; S.nunits = G5_ * 4; S.G = c.G; S.c = (c.bid + c.G / 2) % c.G;
    EpiS5E E{WSP<bf16_t>(p, WS_ESUM)};
    gemm_phase<EpiS5E, GroupOrder>(lds, Gemm{(unsigned)(S5K_ * 2), 512u, 256}, S, E);
}

DI void ph_scan(PR p, const Ctx& c, int l, LAS unsigned char* lds) {
    const bf16_t* Csum = WSP<bf16_t>(p, WS_CSUM); const float* nsum = WSP<float>(p, WS_NSUM); const float* gG = WSP<float>(p, WS_GG); const float* mlG = WSP<float>(p, WS_MLG);
    bf16_t* CprevT = WSP<bf16_t>(p, WS_CPREV); float* nprev = WSP<float>(p, WS_NPREV); float* mprev = WSP<float>(p, WS_MPREV);
    const bf16_t* Esum = WSP<bf16_t>(p, WS_ESUM); const float* A16 = WSP<float>(p, WS_A16) + (size_t)l * G5_ * 128; bf16_t* AS5 = WSP<bf16_t>(p, WS_AS5);
    constexpr int NC1 = NB_ * H_ * DH_ * (DH_ / 4), NC2 = NC1 + NB_ * H_ * DH_, NC3 = NC2 + NB_ * G5_ * P5_;
    if (c.w < 4) for (int gid = c.bid * 256 + c.tid; gid < NC3; gid += c.G * 256) {
        if (gid < NC1) {
            const int bh = gid / (DH_ * DH_ / 4), r = gid % (DH_ * DH_ / 4);
            f32x4 C = (f32x4){0.f, 0.f, 0.f, 0.f}; float m = 0.f;
            const size_t base0 = ((size_t)bh * 32) * DH_ * DH_ + (size_t)r * 4;
#pragma unroll 1
            for (int c8 = 0; c8 < 32; c8 += 8) {
                f32x4 cv[8]; float gv[8], mv[8];
#pragma unroll
                for (int k = 0; k < 8; ++k) { const u32x2 cq = *(const u32x2*)(Csum + base0 + (size_t)(c8 + k) * DH_ * DH_); cv[k] = (f32x4){bflo(cq.x), bfhi(cq.x), bflo(cq.y), bfhi(cq.y)}; gv[k] = gG[bh * 32 + c8 + k]; mv[k] = mlG[bh * 32 + c8 + k]; }
#pragma unroll
                for (int k = 0; k < 8; ++k) {
                    u32x2 o; o.x = cvt_pk_bf16(C[0], C[1]); o.y = cvt_pk_bf16(C[2], C[3]); *(u32x2*)(CprevT + base0 + (size_t)(c8 + k) * DH_ * DH_) = o;
                    if (r == 0) mprev[bh * 32 + c8 + k] = m;
                    const float mn = fmaxf(gv[k] + m, mv[k]), so = __expf(gv[k] + m - mn), sn = __expf(mv[k] - mn);
                    C = C * so + cv[k] * sn; m = mn;
                }
            }
        } else if (gid < NC2) {
            const int i = gid - NC1; const int bh = i / DH_, d = i % DH_;
            float n = 0.f, m = 0.f;
#pragma unroll 1
            for (int c8 = 0; c8 < 32; c8 += 8) {
                float nv[8], gv[8], mv[8];
#pragma unroll
                for (int k = 0; k < 8; ++k) { nv[k] = nsum[(size_t)(bh * 32 + c8 + k) * DH_ + d]; gv[k] = gG[bh * 32 + c8 + k]; mv[k] = mlG[bh * 32 + c8 + k]; }
#pragma unroll
                for (int k = 0; k < 8; ++k) {
                    nprev[(size_t)(bh * 32 + c8 + k) * DH_ + d] = n;
                    const float mn = fmaxf(gv[k] + m, mv[k]), so = __expf(gv[k] + m - mn), sn = __expf(mv[k] - mn);
                    n = so * n + sn * nv[k]; m = mn;
                }
            }
        } else {
            const int i = gid - NC2; const int pp = i & 63, g = (i >> 6) & 31, b = i >> 11;
            const float ar = A16[(size_t)g * 128 + pp], ai = A16[(size_t)g * 128 + 64 + pp];
            float xr = 0.f, xi = 0.f;
            const size_t row0 = (size_t)g * S5R_ + b * (S_ / 16);
#pragma unroll 1
            for (int c16 = 0; c16 < S_ / 16; c16 += 16) {
                float er[16], ei[16];
#pragma unroll
                for (int k = 0; k < 16; ++k) { er[k] = bf2f(Esum[(row0 + c16 + k) * 128 + pp]); ei[k] = bf2f(Esum[(row0 + c16 + k) * 128 + 64 + pp]); }
#pragma unroll
                for (int k = 0; k < 16; ++k) { const size_t row = row0 + c16 + k;
                    AS5[row * S5K_ + 256 + pp] = f2bf(xr); AS5[row * S5K_ + 320 + pp] = f2bf(xi);
                    const float nr = ar * xr - ai * xi + er[k], ni = ar * xi + ai * xr + ei[k]; xr = nr; xi = ni; }
            }
        }
    }
    else { moe_weight_jobs(p, c, l, lds); if (MK_REP == 97) moe_weight_jobs(p, c, (l + 2) & 3, lds, true); }
    if (MK_REP == 98) { const size_t gt = (size_t)c.bid * NT_ + c.tid, nth = (size_t)c.G * NT_; bf16_t* dmy = WSP<bf16_t>(p, WS_HB);
        cvt_rows(IN(p, 28) + (size_t)l * NE_ * D_ * DE_, dmy, (size_t)NE_ * D_ * DE_ / 8, gt, nth); cvt_rows(IN(p, 29) + (size_t)l * NE_ * D_ * DE_, dmy + (size_t)NE_ * D_ * DE_, (size_t)NE_ * D_ * DE_ / 8, gt, nth);
        cvt_rows(IN(p, 30) + (size_t)l * NE_ * DE_ * D_, dmy + (size_t)2 * NE_ * D_ * DE_, (size_t)NE_ * DE_ * D_ / 8, gt, nth); }
}

DI void mlstm_out_unit(PR p, const Ctx& c, int l, int unit, LAS unsigned char* lds) {
    LAS unsigned char* vt0 = lds;
    LAS unsigned char* kt0 = lds + 32768;
    LAS unsigned char* ct0 = lds + 65536;
    LAS float* RT = (LAS float*)(lds + 131072);
    LAS float* CT = RT + 128;
    LAS float* INr = CT + 128;
    LAS float* EM = INr + 128;
    LAS float* NP = EM + 128;
    LAS unsigned char* cv0 = ct0;
    LAS unsigned char* qt0 = ct0 + 32768;
    const bf16_t* zb = WSP<bf16_t>(p, WS_ZB); const bf16_t* CprevT = WSP<bf16_t>(p, WS_CPREV);
    const bf16_t* wqkT = WSP<bf16_t>(p, WS_WQK) + (size_t)l * H_ * 256 * DH_; const bf16_t* cvb = WSP<bf16_t>(p, WS_QB);
    const float* nprev = WSP<float>(p, WS_NPREV); const float* mprev = WSP<float>(p, WS_MPREV); const float* igG = WSP<float>(p, WS_IGG); const float* bcumG = WSP<float>(p, WS_BCUM);
    const float* mh_g = IN(p, 9) + (size_t)l * DM_; bf16_t* yb = WSP<bf16_t>(p, WS_YB);
    const int tid = c.tid, lane = c.lane, w = c.w, fr = lane & 15, fq = lane >> 4, hh = w >> 2, nt = w & 3;
    const int b = unit / (S_ / 64), cc = unit % (S_ / 64); const int tok0 = b * S_ + cc * 64;
    u32x4 cp[8], vv[4], cvv[4];
#define MX2_LOADC(rdv) do { _Pragma("unroll") for (int i = 0; i < 8; ++i) { const int it = tid + i * NT_; const int hq = it >> 11, er = (it >> 4) & 127, cg = it & 15; const int bh = b * H_ + 2 * (rdv) + hq; \
            cp[i] = *(const u32x4*)(CprevT + ((size_t)(bh * 32 + cc) * DH_ + er) * DH_ + cg * 8); } } while (0)
#define MX2_LOAD(rdv) do { \
        _Pragma("unroll") for (int i = 0; i < 4; ++i) { const int it = tid + i * NT_; const int hq = it >> 10, sr = (it >> 4) & 63, cg = it & 15; const int ch0 = (2 * (rdv) + hq) * DH_ + cg * 8; \
            cvv[i] = *(const u32x4*)(cvb + (size_t)(tok0 + sr) * DM_ + ch0); } } while (0)
    MX2_LOAD(0);
    for (int rd = 0; rd < 2; ++rd) {
        int tq_ = c.tid; asm volatile("" : "+v"(tq_));
        const int tid = tq_ & 511, lane = tid & 63, fr = lane & 15, fq = lane >> 4;
        __syncthreads();
        MX2_LOADC(rd);
#pragma unroll
        for (int i = 0; i < 4; ++i) { const int it = tid + i * NT_; const int hq = it >> 10, sr = (it >> 4) & 63, cg = it & 15; const int ch0 = (2 * rd + hq) * DH_ + cg * 8;
            vv[i] = *(const u32x4*)(zb + (size_t)(tok0 + sr) * ZLD_ + 512 + ch0); *(LAS u32x4*)(cv0 + hq * 16384 + off_b(sr, cg)) = cvv[i]; }
        if (w < 2) { const int h = 2 * rd + w; const int tok = tok0 + lane; const int bh = b * H_ + h;
            const float ig = igG[(size_t)tok * 4 + h], bc = bcumG[(size_t)tok * 4 + h]; const float rt = ig - bc;
            float pm = rt;
#pragma unroll
            for (int o = 1; o < 64; o <<= 1) { const float t = __shfl_up(pm, o); if (lane >= o) pm = fmaxf(pm, t); }
            const float mp = mprev[bh * 32 + cc]; const float li = bc + mp; const float mt = fmaxf(li, bc + pm);
            RT[w * 64 + lane] = rt; CT[w * 64 + lane] = bc - mt; INr[w * 64 + lane] = __expf(li - mt); EM[w * 64 + lane] = __expf(-mt);
            NP[w * 128 + lane] = nprev[(size_t)(bh * 32 + cc) * DH_ + lane]; NP[w * 128 + 64 + lane] = nprev[(size_t)(bh * 32 + cc) * DH_ + 64 + lane];
        }
        __syncthreads();
        {
            const int h = 2 * rd + hh; const LAS unsigned char* cv = cv0 + hh * 16384; LAS unsigned char* qt = qt0 + hh * 16384; LAS unsigned char* ktw = kt0 + hh * 16384;
            f32x4 acc[4][4];
#pragma unroll
            for (int ms = 0; ms < 4; ++ms)
#pragma unroll
                for (int i = 0; i < 4; ++i) acc[ms][i] = (f32x4){0.f, 0.f, 0.f, 0.f};
#pragma unroll
            for (int ks = 0; ks < 4; ++ks) {
                bf16x8 wf[4];
#pragma unroll
                for (int i = 0; i < 4; ++i) wf[i] = ld_frag_g(wqkT + ((size_t)(h * 256 + 16 * (4 * nt + i) + fr)) * DH_ + 32 * ks + 8 * fq);
#pragma unroll
                for (int ms = 0; ms < 4; ++ms) { const bf16x8 cf = tile_row_read(cv, lane, ms, ks);
#pragma unroll
                    for (int i = 0; i < 4; ++i) acc[ms][i] = mfma16(wf[i], cf, acc[ms][i]); }
            }
#pragma unroll
            for (int ms = 0; ms < 4; ++ms) { const int sr = 16 * ms + fr;
#pragma unroll
                for (int i = 0; i < 4; ++i) { const int nf = 4 * nt + i; const f32x4 v = acc[ms][i];
                    u32x2 o; o.x = cvt_pk_bf16(v[0], v[1]); o.y = cvt_pk_bf16(v[2], v[3]);
                    const int col = 16 * (nf & 7) + 4 * fq;
                    *(LAS u32x2*)((nf < 8 ? qt : ktw) + off_b(sr, col >> 3) + 2 * (col & 7)) = o; } }
        }
        __syncthreads();
        {
            const int h = 2 * rd + hh; const LAS unsigned char* vt = vt0 + hh * 16384; const LAS unsigned char* kt = kt0 + hh * 16384; const LAS unsigned char* ct = ct0 + hh * 32768;
            const int trow = 16 * nt + fr;
            bf16x8 qf[4];
#pragma unroll
            for (int ks = 0; ks < 4; ++ks) qf[ks] = tile_row_read(qt0 + hh * 16384, lane, nt, ks);
            __syncthreads();
#pragma unroll
            for (int i = 0; i < 8; ++i) { const int it = tid + i * NT_; const int hq = it >> 11, er = (it >> 4) & 127, cg = it & 15; *(LAS u32x4*)(ct0 + hq * 32768 + off_b(er, cg)) = cp[i]; }
#pragma unroll
            for (int i = 0; i < 4; ++i) { const int it = tid + i * NT_; const int hq = it >> 10, sr = (it >> 4) & 63, cg = it & 15; *(LAS u32x4*)(vt0 + hq * 16384 + off_b(sr, cg)) = vv[i]; }
            if (rd == 0) MX2_LOAD(1);
            __syncthreads();
            f32x4 Sf[4];
#pragma unroll
            for (int ms = 0; ms < 4; ++ms) { Sf[ms] = (f32x4){0.f, 0.f, 0.f, 0.f};
                if (ms <= nt) {
#pragma unroll
                    for (int ks = 0; ks < 4; ++ks) Sf[ms] = mfma16(tile_row_read(kt, lane, ms, ks), qf[ks], Sf[ms]);
                } }
            const float ct_ = CT[hh * 64 + trow];
            float dsum = 0.f;
#pragma unroll
            for (int ms = 0; ms < 4; ++ms)
#pragma unroll
                for (int r = 0; r < 4; ++r) { const int sr = 16 * ms + 4 * fq + r; float v = 0.f;
                    if (ms <= nt && sr <= trow) v = Sf[ms][r] * __expf(RT[hh * 64 + sr] + ct_);
                    Sf[ms][r] = v; dsum += v; }
            dsum += __shfl_xor(dsum, 16); dsum += __shfl_xor(dsum, 32);
            float qn = 0.f;
#pragma unroll
            for (int ks = 0; ks < 4; ++ks)
#pragma unroll
                for (int j = 0; j < 8; ++j) qn += bf2f((bf16_t)qf[ks][j]) * NP[hh * 128 + 32 * ks + 8 * fq + j];
            qn += __shfl_xor(qn, 16); qn += __shfl_xor(qn, 32);
            const float inter = INr[hh * 64 + trow];
            float den = dsum + inter * qn; den = fmaxf(fabsf(den), EM[hh * 64 + trow]); const float rden = __builtin_amdgcn_rcpf(den);
            bf16x8 Pf[2];
#pragma unroll
            for (int k2 = 0; k2 < 2; ++k2) { u32x4 pk; pk.x = cvt_pk_bf16(Sf[2 * k2][0], Sf[2 * k2][1]); pk.y = cvt_pk_bf16(Sf[2 * k2][2], Sf[2 * k2][3]);
                pk.z = cvt_pk_bf16(Sf[2 * k2 + 1][0], Sf[2 * k2 + 1][1]); pk.w = cvt_pk_bf16(Sf[2 * k2 + 1][2], Sf[2 * k2 + 1][3]); Pf[k2] = __builtin_bit_cast(bf16x8, pk); }
            float hv[8][4]; float ssum = 0.f;
#pragma unroll
            for (int me = 0; me < 8; ++me) {
                f32x4 a1 = (f32x4){0.f, 0.f, 0.f, 0.f}, a2 = (f32x4){0.f, 0.f, 0.f, 0.f};
                s16x4 v0, v1, v2, v3;
                tile_tr_read4(tr_addr(vt, lane, 4 * fq, me), tr_addr(vt, lane, 16 + 4 * fq, me), tr_addr(vt, lane, 32 + 4 * fq, me), tr_addr(vt, lane, 48 + 4 * fq, me), v0, v1, v2, v3);
#pragma unroll
                for (int ks = 0; ks < 4; ++ks) a2 = mfma16(tile_row_read(ct, lane, me, ks), qf[ks], a2);
                a1 = mfma16(cat8(v0, v1), Pf[0], a1);
                if (nt >= 2) a1 = mfma16(cat8(v2, v3), Pf[1], a1);
                const u32x2 og = *(const u32x2*)(zb + (size_t)(tok0 + trow) * ZLD_ + 1024 + h * DH_ + 16 * me + 4 * fq);
                hv[me][0] = (a1[0] + inter * a2[0]) * rden * fast_sigmoid(bflo(og.x)); hv[me][1] = (a1[1] + inter * a2[1]) * rden * fast_sigmoid(bfhi(og.x));
                hv[me][2] = (a1[2] + inter * a2[2]) * rden * fast_sigmoid(bflo(og.y)); hv[me][3] = (a1[3] + inter * a2[3]) * rden * fast_sigmoid(bfhi(og.y));
                ssum += (hv[me][0] + hv[me][1]) + (hv[me][2] + hv[me][3]);
            }
            ssum += __shfl_xor(ssum, 16); ssum += __shfl_xor(ssum, 32);
            const float mu = ssum * (1.f / DH_); float qv = 0.f;
#pragma unroll
            for (int me = 0; me < 8; ++me)
#pragma unroll
                for (int r = 0; r < 4; ++r) { const float d0 = hv[me][r] - mu; qv += d0 * d0; }
            qv += __shfl_xor(qv, 16); qv += __shfl_xor(qv, 32);
            const float rstd = rsqrtf(qv * (1.f / DH_) + EPS_);
#pragma unroll
            for (int me = 0; me < 8; ++me) { const int e0 = h * DH_ + 16 * me + 4 * fq; const f32x4 gg = *(const f32x4*)(mh_g + e0);
                u32x2 o; o.x = cvt_pk_bf16((hv[me][0] - mu) * rstd * gg[0], (hv[me][1] - mu) * rstd * gg[1]); o.y = cvt_pk_bf16((hv[me][2] - mu) * rstd * gg[2], (hv[me][3] - mu) * rstd * gg[3]);
                *(u32x2*)(yb + (size_t)(tok0 + trow) * D_ + DM_ + e0) = o; }
        }
    }
}
#undef MX2_LOAD
#undef MX2_LOADC
DI void ph_mix2(PR p, const Ctx& c, int l, LAS unsigned char* lds) {
    for (int unit = c.bid; unit < NB_ * (S_ / 64); unit += c.G) mlstm_out_unit(p, c, l, unit, lds);
    __syncthreads();
    GroupOrder S; S.A = (const char*)WSP<bf16_t>(p, WS_AS5); S.B = (const char*)(WSP<bf16_t>(p, WS_WYT) + (size_t)l * G5_ * 256 * S5K_); S.astride = (size_t)S5R_ * S5K_ * 2; S.bstride = (size_t)256 * S5K_ * 2;
    S.lda = S5K_ * 2; S.nunits = G5_ * 4; S.G = c.G; S.c = (c.bid + c.G / 2) % c.G;
    EpiS5Y E{WSP<bf16_t>(p, WS_GYB)};
    gemm_phase<EpiS5Y, GroupOrder>(lds, Gemm{(unsigned)(S5K_ * 2), (unsigned)(S5K_ * 2), S5K_}, S, E);
}

DI void ph_glu(PR p, const Ctx& c, int l, LAS unsigned char* lds) {
    const int hg = c.G / 2;
    if (c.bid < hg) {
        DenseOrder S; S.init(WSP<bf16_t>(p, WS_GYB), WSP<bf16_t>(p, WS_WGLU) + (size_t)l * DM_ * DM_, DM_ * 2, DM_ * 2, M_, DM_, hg, c.bid);
        EpiGlu E{WSP<bf16_t>(p, WS_GYB), IN(p, 19) + (size_t)l * DM_, WSP<bf16_t>(p, WS_YB), WSP<float>(p, WS_SSQS)};
        gemm_phase<EpiGlu, DenseOrder>(lds, Gemm{(unsigned)(DM_ * 2), (unsigned)(DM_ * 2), DM_}, S, E);
    } else {
        DenseOrder S2; S2.init(WSP<bf16_t>(p, WS_PBF) + (size_t)l * M_ * PLE_, WSP<bf16_t>(p, WS_WPP) + (size_t)l * D_ * PLE_, PLE_ * 2, PLE_ * 2, M_, D_, c.G - hg, c.bid - hg);
        EpiT E2{WSP<bf16_t>(p, WS_TB), WSP<float>(p, WS_SSQT)};
        gemm_phase<EpiT, DenseOrder>(lds, Gemm{(unsigned)(PLE_ * 2), (unsigned)(PLE_ * 2), PLE_}, S2, E2);
    }
}
DI void ph_outproj(PR p, const Ctx& c, int l, LAS unsigned char* lds) {
    DenseOrder S; S.init(WSP<bf16_t>(p, WS_YB), WSP<bf16_t>(p, WS_WOUT) + (size_t)l * D_ * D_, D_ * 2, D_ * 2, M_, D_, c.G, c.bid);
    EpiOutLn E{WSP<bf16_t>(p, WS_XB), WSP<float>(p, WS_SSQS), WSP<bf16_t>(p, WS_GHL) + (size_t)l * 2 * 48 * D_, WSP<float>(p, WS_RTC) + l * 80, IN(p, 22) + (size_t)l * D_, IN(p, 23) + (size_t)l * D_,
               WSP<float>(p, WS_XCH), WSP<unsigned>(p, WS_LNC) + (size_t)l * 64 * 16, WSP<bf16_t>(p, WS_X1B), WSP<unsigned char>(p, WS_X1Q),
               WSP<unsigned>(p, WS_CUR) + (size_t)l * NE_ * 16, WSP<int>(p, WS_BUFT), WSP<float>(p, WS_BUFW), WSP<int>(p, WS_SLOT)};
    gemm_phase<EpiOutLn, DenseOrder>(lds, Gemm{(unsigned)(D_ * 2), (unsigned)(D_ * 2), D_}, S, E);
}
DI void ph_route(PR p, const Ctx& c, int l, LAS unsigned char* lds, bool dry = false) {
    LAS int* cntL = (LAS int*)lds; LAS int* baseL = cntL + 32; LAS int* tokE = baseL + 32; LAS float* tokW = (LAS float*)(tokE + 128);
    const float* logits = WSP<float>(p, WS_LOGIT);
    unsigned* cur = WSP<unsigned>(p, WS_CUR) + (size_t)(l + (dry ? L_ : 0)) * NE_ * 16; int* buf_t = WSP<int>(p, WS_BUFT); float* buf_w = WSP<float>(p, WS_BUFW); int* slot_of = WSP<int>(p, WS_SLOT);
    const int tid = c.tid;
    __syncthreads();
    if (tid < 32) cntL[tid] = 0;
    __syncthreads();
    for (int unit = c.bid; unit < M_ / 64; unit += c.G) {
        if (tid < 64) { const float* lg = logits + (size_t)(unit * 64 + tid) * 40;
            const f32x4 gl = *(const f32x4*)lg; float mx = gl[0]; int gi = 0;
#pragma unroll
            for (int i = 1; i < 4; ++i) if (gl[i] > mx) { mx = gl[i]; gi = i; }
            float se = 0.f;
#pragma unroll
            for (int i = 0; i < 4; ++i) se += expf(gl[i] - mx);
            const float pg = 1.0f / se;
            const f32x4 e0 = *(const f32x4*)(lg + 4 + gi * 8), e1 = *(const f32x4*)(lg + 8 + gi * 8);
            float ev[8];
#pragma unroll
            for (int i = 0; i < 4; ++i) { ev[i] = e0[i]; ev[4 + i] = e1[i]; }
            int i0 = 0;
#pragma unroll
            for (int i = 1; i < 8; ++i) if (ev[i] > ev[i0]) i0 = i;
            int i1 = (i0 == 0) ? 1 : 0;
#pragma unroll
            for (int i = 0; i < 8; ++i) if (i != i0 && ev[i] > ev[i1]) i1 = i;
            const float e1x = expf(ev[i1] - ev[i0]); const float w0 = 1.f / (1.f + e1x), w1 = e1x / (1.f + e1x);
            const int ea = gi * 8 + i0, eb = gi * 8 + i1;
            const int ra = atomicAdd((int*)&cntL[ea], 1), rb = atomicAdd((int*)&cntL[eb], 1);
            tokE[tid * 2] = (ea << 16) | ra; tokE[tid * 2 + 1] = (eb << 16) | rb; tokW[tid * 2] = pg * w0; tokW[tid * 2 + 1] = pg * w1;
        }
        __syncthreads();
        if (tid < 32) baseL[tid] = cntL[tid] ? (int)atomicAdd(&cur[tid * 16], (unsigned)cntL[tid]) : 0;
        __syncthreads();
        if (tid < 128 && !dry) { const int v = tokE[tid]; const int e = v >> 16, r = baseL[e] + (v & 0xffff); const int token = unit * 64 + (tid >> 1);
            buf_t[(size_t)e * ECAP_ + r] = token; buf_w[(size_t)e * ECAP_ + r] = tokW[tid]; slot_of[token * 2 + (tid & 1)] = (e << 16) | r; }
        __syncthreads();
        if (tid < 32) cntL[tid] = 0;
        __syncthreads();
    }
}

DI void treduce16(float (&a)[16], int lane) {
#pragma unroll
    for (int i = 0; i < 8; ++i) { const bool hi = lane & 32; const float send = hi ? a[i] : a[i + 8], keep = hi ? a[i + 8] : a[i]; a[i] = keep + __shfl_xor(send, 32); }
#pragma unroll
    for (int i = 0; i < 4; ++i) { const bool hi = lane & 16; const float send = hi ? a[i] : a[i + 4], keep = hi ? a[i + 4] : a[i]; a[i] = keep + __shfl_xor(send, 16); }
#pragma unroll
    for (int i = 0; i < 2; ++i) { const bool hi = lane & 8; const float send = hi ? a[i] : a[i + 2], keep = hi ? a[i + 2] : a[i]; a[i] = keep + __shfl_xor(send, 8); }
    { const bool hi = lane & 4; const float send = hi ? a[0] : a[1], keep = hi ? a[1] : a[0]; a[0] = keep + __shfl_xor(send, 4); }
    a[0] += __shfl_xor(a[0], 2); a[0] += __shfl_xor(a[0], 1);
}
DI void ph_router(PR p, const Ctx& c, int l, LAS unsigned char* lds, bool dry = false) {
    LAS float* W = (LAS float*)lds;
    LAS float* LG = (LAS float*)(lds + 147456);
    LAS int* cntL = (LAS int*)(lds + 147456 + 9216);
    LAS int* baseL = cntL + 32;
    LAS int* tokE = baseL + 32;
    LAS float* tokW = (LAS float*)(tokE + 128);
    const float* b_grp = IN(p, 25) + l * 4; const float* b_rt = IN(p, 27) + l * 32;
    const float* ln_g = IN(p, 22) + (size_t)l * D_; const float* ln_b = IN(p, 23) + (size_t)l * D_;
    const bf16_t* r1 = WSP<bf16_t>(p, WS_X2B); bf16_t* x1b = WSP<bf16_t>(p, WS_X1B); unsigned char* x1q = WSP<unsigned char>(p, WS_X1Q);
    unsigned* cur = WSP<unsigned>(p, WS_CUR) + (size_t)(l + (dry ? L_ : 0)) * NE_ * 16; int* buf_t = WSP<int>(p, WS_BUFT); float* buf_w = WSP<float>(p, WS_BUFW); int* slot_of = WSP<int>(p, WS_SLOT);
    const int tid = c.tid, lane = c.lane, w = c.w;
    __syncthreads();
    { const f32x4* wsrc = (const f32x4*)(WSP<float>(p, WS_WRT) + (size_t)l * 36 * D_); for (int idx = tid; idx < 36 * D_ / 4; idx += NT_) ((LAS f32x4*)W)[idx] = wsrc[idx]; }
    if (tid < 32) cntL[tid] = 0;
    __syncthreads();
    for (int unit = c.bid; unit < M_ / 64; unit += c.G) {
#pragma unroll 1
        for (int half = 0; half < 2; ++half) {
        const int tokb = unit * 64 + w * 8 + half * 4;
        f32x4 xv[4][4];
#pragma unroll
        for (int tk = 0; tk < 4; ++tk) { const bf16_t* rin = r1 + (size_t)(tokb + tk) * D_; float s = 0.f;
#pragma unroll
            for (int j = 0; j < 4; ++j) { const u32x2 rv = ((const u32x2*)rin)[lane + 64 * j]; xv[tk][j] = (f32x4){bflo(rv.x), bfhi(rv.x), bflo(rv.y), bfhi(rv.y)}; s += (xv[tk][j][0] + xv[tk][j][1]) + (xv[tk][j][2] + xv[tk][j][3]); }
            const float mu = wave_sum(s) * (1.f / D_); float qv = 0.f;
#pragma unroll
            for (int j = 0; j < 4; ++j) { xv[tk][j] = xv[tk][j] - mu; qv += (xv[tk][j][0] * xv[tk][j][0] + xv[tk][j][1] * xv[tk][j][1]) + (xv[tk][j][2] * xv[tk][j][2] + xv[tk][j][3] * xv[tk][j][3]); }
            const float rstd = rsqrtf(wave_sum(qv) * (1.f / D_) + EPS_);
#pragma unroll
            for (int j = 0; j < 4; ++j) { const f32x4 gg = ((const f32x4*)ln_g)[lane + 64 * j], bb = ((const f32x4*)ln_b)[lane + 64 * j];
                xv[tk][j] = xv[tk][j] * rstd * gg + bb;
                u32x2 o; o.x = cvt_pk_bf16(xv[tk][j][0], xv[tk][j][1]); o.y = cvt_pk_bf16(xv[tk][j][2], xv[tk][j][3]); ((u32x2*)(x1b + (size_t)(tokb + tk) * D_))[lane + 64 * j] = o;
                ((unsigned*)(x1q + (size_t)(tokb + tk) * D_))[lane + 64 * j] = pack4_fp8(xv[tk][j][0], xv[tk][j][1], xv[tk][j][2], xv[tk][j][3]); }
        }
        f32x2_ xq[2][4][4];
#pragma unroll
        for (int tp = 0; tp < 2; ++tp)
#pragma unroll
            for (int j = 0; j < 4; ++j)
#pragma unroll
                for (int e = 0; e < 4; ++e) xq[tp][j][e] = (f32x2_){xv[2 * tp][j][e], xv[2 * tp + 1][j][e]};
#pragma unroll 1
        for (int ob = 0; ob < 9; ++ob) {
            f32x2_ a2[2][4];
#pragma unroll
            for (int tp = 0; tp < 2; ++tp)
#pragma unroll
                for (int oo = 0; oo < 4; ++oo) a2[tp][oo] = (f32x2_){0.f, 0.f};
#pragma unroll
            for (int oo = 0; oo < 4; ++oo)
#pragma unroll
                for (int j = 0; j < 4; ++j) { const f32x4 wv = ((const LAS f32x4*)W)[(4 * ob + oo) * 256 + lane + 64 * j];
#pragma unroll
                    for (int e = 0; e < 4; ++e) { const f32x2_ wb = (f32x2_){wv[e], wv[e]};
                        a2[0][oo] = __builtin_elementwise_fma(xq[0][j][e], wb, a2[0][oo]); a2[1][oo] = __builtin_elementwise_fma(xq[1][j][e], wb, a2[1][oo]); } }
            float part[16];
#pragma unroll
            for (int tp = 0; tp < 2; ++tp)
#pragma unroll
                for (int oo = 0; oo < 4; ++oo) { part[(2 * tp) * 4 + oo] = a2[tp][oo][0]; part[(2 * tp + 1) * 4 + oo] = a2[tp][oo][1]; }
            treduce16(part, lane);
            if ((lane & 3) == 0) { const int idx = lane >> 2; LG[(w * 8 + half * 4 + (idx >> 2)) * 36 + 4 * ob + (idx & 3)] = part[0]; }
        }
        }
        __builtin_amdgcn_s_waitcnt(0xC07F); __builtin_amdgcn_wave_barrier();
        if (lane < 8) { const LAS float* lg = LG + (w * 8 + lane) * 36;
            float gl[4]; float mx = -1e30f; int gi = 0;
#pragma unroll
            for (int i = 0; i < 4; ++i) { gl[i] = lg[i] + b_grp[i]; if (gl[i] > mx) { mx = gl[i]; gi = i; } }
            float se = 0.f;
#pragma unroll
            for (int i = 0; i < 4; ++i) se += expf(gl[i] - mx);
            const float pg = 1.0f / se;
            float ev[8];
#pragma unroll
            for (int i = 0; i < 8; ++i) ev[i] = lg[4 + gi * 8 + i] + b_rt[gi * 8 + i];
            int i0 = 0;
#pragma unroll
            for (int i = 1; i < 8; ++i) if (ev[i] > ev[i0]) i0 = i;
            int i1 = (i0 == 0) ? 1 : 0;
#pragma unroll
            for (int i = 0; i < 8; ++i) if (i != i0 && ev[i] > ev[i1]) i1 = i;
            const float e1 = expf(ev[i1] - ev[i0]); const float w0 = 1.f / (1.f + e1), w1 = e1 / (1.f + e1);
            const int ea = gi * 8 + i0, eb = gi * 8 + i1;
            const int ra = atomicAdd((int*)&cntL[ea], 1), rb = atomicAdd((int*)&cntL[eb], 1);
            tokE[(w * 8 + lane) * 2] = (ea << 16) | ra; tokE[(w * 8 + lane) * 2 + 1] = (eb << 16) | rb; tokW[(w * 8 + lane) * 2] = pg * w0; tokW[(w * 8 + lane) * 2 + 1] = pg * w1;
        }
        __syncthreads();
        if (tid < 32) baseL[tid] = cntL[tid] ? (int)atomicAdd(&cur[tid * 16], (unsigned)cntL[tid]) : 0;
        __syncthreads();
        if (tid < 128 && !dry) { const int v = tokE[tid]; const int e = v >> 16, r = baseL[e] + (v & 0xffff); const int token = unit * 64 + (tid >> 1);
            buf_t[(size_t)e * ECAP_ + r] = token; buf_w[(size_t)e * ECAP_ + r] = tokW[tid]; slot_of[token * 2 + (tid & 1)] = (e << 16) | r; }
        __syncthreads();
        if (tid < 32) cntL[tid] = 0;
        __syncthreads();
    }
}

DI void moe_tables(PR p, const Ctx& c, int l, LAS int* cnt, LAS int* tbase) {
    unsigned* cur = WSP<unsigned>(p, WS_CUR) + (size_t)l * NE_ * 16;
    __syncthreads();
    if (c.tid < 32) cnt[c.tid] = (int)xb_ld(&cur[c.tid * 16]);
    __syncthreads();
    if (c.tid == 0) { int run = 0; for (int e = 0; e < 32; ++e) { tbase[e] = run; run += (cnt[e] + 255) >> 8; } tbase[32] = run; }
    __syncthreads();
}
DI void ph_moe(PR p, const Ctx& c, int l, LAS unsigned char* lds, bool dry = false) {
    LAS int* cnt = (LAS int*)(lds + STAGE_BYTES); LAS int* tbase = cnt + 32;
    moe_tables(p, c, l, cnt, tbase);
    unsigned* done = WSP<unsigned>(p, WS_DONE) + (size_t)(l + (dry ? L_ : 0)) * MT_ * 16;
    const int nu = tbase[32] * 4;
    {
        MoeOrder<true> S; S.A = (const char*)WSP<unsigned char>(p, WS_X1Q); S.B = (const char*)WSP<unsigned char>(p, WS_WGU); S.lda = D_; S.ldb = D_; S.bstride = (size_t)D_ * D_;
        S.tbase = tbase; S.cnt = cnt; S.buf_t = WSP<int>(p, WS_BUFT); S.done = done; S.nunits = nu; S.G = c.G; S.c = c.bid; S.n3 = 0; S.nb = 0;
        EpiSiluMul E{WSP<unsigned char>(p, WS_HB), done};
        gemm_phase<EpiSiluMul, MoeOrder<true>>(lds, Gemm{(unsigned)D_, (unsigned)D_, D_ / 2}, S, E);
    }
    __syncthreads();
    {
        MoeOrder<false> S; S.A = (const char*)WSP<unsigned char>(p, WS_HB); S.B = (const char*)WSP<unsigned char>(p, WS_WED); S.lda = DE_; S.ldb = DE_; S.bstride = (size_t)D_ * DE_;
        S.tbase = tbase; S.cnt = cnt; S.buf_t = WSP<int>(p, WS_BUFT); S.done = done; S.nunits = nu; S.G = c.G; S.c = c.bid;
        { const int maxups = (nu + c.G - 1) / c.G; S.n3 = (nu % c.G) ? nu - (maxups - 1) * c.G : c.G; S.nb = (c.G - S.n3) < nu ? (c.G - S.n3) : nu; }
        EpiDown E{WSP<unsigned char>(p, WS_YE), WSP<float>(p, WS_BUFW), cnt};
        gemm_phase<EpiDown, MoeOrder<false>>(lds, Gemm{(unsigned)DE_, (unsigned)DE_, DE_ / 2}, S, E);
    }
}
DI void ph_ln2(PR p, const Ctx& c, int l, LAS unsigned char* lds) {
    LAS int* cnt = (LAS int*)(lds + STAGE_BYTES); LAS int* tbase = cnt + 32;
    moe_tables(p, c, l, cnt, tbase);
    const bf16_t* x1b = WSP<bf16_t>(p, WS_X1B); const unsigned char* ye = WSP<unsigned char>(p, WS_YE); const int* slot_of = WSP<int>(p, WS_SLOT);
    const float* ln_g = IN(p, 31) + (size_t)l * D_; const float* ln_b = IN(p, 32) + (size_t)l * D_; bf16_t* x2b = WSP<bf16_t>(p, WS_X2B);
    const int lane = c.lane;
    const float* ssqT = WSP<float>(p, WS_SSQT); float* rstdT = WSP<float>(p, WS_RSTDT);
    for (int tok = c.bid * 8 + c.w; tok < M_; tok += c.G * 8) {
        { float tq = (lane < 16) ? ssqT[(size_t)tok * 16 + lane] : 0.f; tq += __shfl_xor(tq, 8); tq += __shfl_xor(tq, 4); tq += __shfl_xor(tq, 2); tq += __shfl_xor(tq, 1);
          if (lane == 0) rstdT[tok] = rsqrtf(tq * (1.f / D_) + EPS_); }
        const int s0 = slot_of[tok * 2], s1 = slot_of[tok * 2 + 1];
        const size_t r0 = ((size_t)(tbase[s0 >> 16] + ((s0 & 0xffff) >> 8)) * 256 + (s0 & 255)) * D_, r1 = ((size_t)(tbase[s1 >> 16] + ((s1 & 0xffff) >> 8)) * 256 + (s1 & 255)) * D_;
        f32x4 v[4]; float s = 0.f;
#pragma unroll
        for (int j = 0; j < 4; ++j) { const u32x2 xr = ((const u32x2*)(x1b + (size_t)tok * D_))[lane + 64 * j]; const f32x4 xv = (f32x4){bflo(xr.x), bfhi(xr.x), bflo(xr.y), bfhi(xr.y)};
            const int a = ((const int*)(ye + r0))[lane + 64 * j], bq = ((const int*)(ye + r1))[lane + 64 * j];
            v[j][0] = ALPHA_ * xv[0] + YE_INV * (__builtin_amdgcn_cvt_f32_fp8(a, 0) + __builtin_amdgcn_cvt_f32_fp8(bq, 0)); v[j][1] = ALPHA_ * xv[1] + YE_INV * (__builtin_amdgcn_cvt_f32_fp8(a, 1) + __builtin_amdgcn_cvt_f32_fp8(bq, 1));
            v[j][2] = ALPHA_ * xv[2] + YE_INV * (__builtin_amdgcn_cvt_f32_fp8(a, 2) + __builtin_amdgcn_cvt_f32_fp8(bq, 2)); v[j][3] = ALPHA_ * xv[3] + YE_INV * (__builtin_amdgcn_cvt_f32_fp8(a, 3) + __builtin_amdgcn_cvt_f32_fp8(bq, 3));
            s += (v[j][0] + v[j][1]) + (v[j][2] + v[j][3]); }
        const float mu = wave_sum(s) * (1.f / D_); float qv = 0.f;
#pragma unroll
        for (int j = 0; j < 4; ++j) { v[j] = v[j] - mu; qv += (v[j][0] * v[j][0] + v[j][1] * v[j][1]) + (v[j][2] * v[j][2] + v[j][3] * v[j][3]); }
        const float rstd = rsqrtf(wave_sum(qv) * (1.f / D_) + EPS_);
#pragma unroll
        for (int j = 0; j < 4; ++j) { const f32x4 gg = ((const f32x4*)ln_g)[lane + 64 * j], bb = ((const f32x4*)ln_b)[lane + 64 * j]; const f32x4 o = v[j] * rstd * gg + bb;
            u32x2 ob; ob.x = cvt_pk_bf16(o[0], o[1]); ob.y = cvt_pk_bf16(o[2], o[3]); ((u32x2*)(x2b + (size_t)tok * D_))[lane + 64 * j] = ob; }
    }
}
DI void ph_ple(PR p, const Ctx& c, int l, LAS unsigned char* lds) {
    DenseOrder S; S.init(WSP<bf16_t>(p, WS_X2B), WSP<bf16_t>(p, WS_WPG) + (size_t)l * D_ * D_, D_ * 2, D_ * 2, M_, D_, c.G, c.bid);
    EpiPle E{WSP<bf16_t>(p, WS_X2B), WSP<bf16_t>(p, WS_TB), WSP<float>(p, WS_RSTDT), IN(p, 34) + (size_t)l * D_, IN(p, 36) + (size_t)l * D_, (l == L_ - 1) ? p.out : (float*)nullptr, WSP<bf16_t>(p, WS_XB)};
    gemm_phase<EpiPle, DenseOrder>(lds, Gemm{(unsigned)(D_ * 2), (unsigned)(D_ * 2), D_}, S, E);
}

DI Ctx mk_ctx() { Ctx c; int t = threadIdx.x; asm volatile("" : "+v"(t)); t &= 511; int g = gridDim.x, b = blockIdx.x; asm volatile("" : "+s"(g), "+s"(b)); c.G = g; c.bid = b; c.tid = t; c.lane = t & 63; c.w = __builtin_amdgcn_readfirstlane(t >> 6); return c; }

DI PR getP() { const __attribute__((address_space(4))) P* q = (const __attribute__((address_space(4))) P*)__builtin_amdgcn_kernarg_segment_ptr(); asm volatile("" : "+s"(q)); return *q; }
template <int PH> DI void run_phase(int l, LAS unsigned char* lds0) {
    unsigned la = (unsigned)(size_t)lds0; asm volatile("" : "+s"(la)); LAS unsigned char* lds = (LAS unsigned char*)(size_t)la;
    PR p = getP(); const Ctx c = mk_ctx();
    if constexpr (PH == 0) ph_prologue(p, c, lds);
    if constexpr (PH >= 200 && PH < 216) ph_prologue(p, c, lds, PH - 200);
    if constexpr (PH == 1) ph_inproj(p, c, l, lds);
    if constexpr (PH == 2) ph_mix1(p, c, l, lds);
    if constexpr (PH == 3) ph_scan(p, c, l, lds);
    if constexpr (PH == 4) ph_mix2(p, c, l, lds);
    if constexpr (PH == 5) ph_glu(p, c, l, lds);
    if constexpr (PH == 6) ph_outproj(p, c, l, lds);
    if constexpr (PH == 7) ph_route(p, c, l, lds, false);
    if constexpr (PH == 107) ph_route(p, c, l, lds, true);
    if constexpr (PH == 8) ph_moe(p, c, l, lds, false);
    if constexpr (PH == 108) ph_moe(p, c, l, lds, true);
    if constexpr (PH == 10) ph_ln2(p, c, l, lds);
    if constexpr (PH == 11) ph_ple(p, c, l, lds);
}
DI void grid_bar(LAS unsigned char* lds) {
    PR p = getP();
    XcdBarrier b; b.bar = WSP<unsigned>(p, WS_BAR); b.x = xb_xcc_id(); b.st = (volatile LAS unsigned*)(lds + LDS_BYTES - 16);
    xcd_barrier(b);
}

#if MK_MULTI
template <int PH> __global__ __launch_bounds__(512, 2) void k_phase(P p, int l) {
    extern __shared__ __attribute__((aligned(16))) unsigned char smem[];
    (void)p;
    run_phase<PH>(l, (LAS unsigned char*)smem);
}
#else
__global__ __launch_bounds__(512, 2) void k_fwd(P p) {
    extern __shared__ __attribute__((aligned(16))) unsigned char smem[];
    LAS unsigned char* lds = (LAS unsigned char*)smem;
    volatile LAS unsigned* bst = (volatile LAS unsigned*)(lds + LDS_BYTES - 16);
    if (threadIdx.x < 4) bst[threadIdx.x] = 0u;
    __syncthreads();
    (void)xcd_barrier_post((unsigned*)(p.ws + WS_BAR), bst);
    run_phase<0>(0, lds); grid_bar(lds);
    if (MK_REP == 0) { run_phase<0>(0, lds); grid_bar(lds); }
    if (MK_REP >= 200 && MK_REP < 216) { run_phase<(MK_REP >= 200 && MK_REP < 216) ? MK_REP : 200>(0, lds); grid_bar(lds); }
#define MK_PH(k, l) do { run_phase<k>(l, lds); if (MK_REP == k) { grid_bar(lds); run_phase<(k == 7 ? 107 : k == 8 ? 108 : k)>(l, lds); } } while (0)
#define MK_LAYER(l, lastbar) do { MK_PH(1, l); grid_bar(lds); MK_PH(2, l); grid_bar(lds); MK_PH(3, l); grid_bar(lds); MK_PH(4, l); grid_bar(lds); \
        MK_PH(5, l); grid_bar(lds); MK_PH(6, l); grid_bar(lds); MK_PH(8, l); grid_bar(lds); \
        MK_PH(10, l); grid_bar(lds); MK_PH(11, l); if (lastbar) grid_bar(lds); if (MK_REP == 99) { for (int q_ = 0; q_ < 10; ++q_) grid_bar(lds); } } while (0)
    MK_LAYER(0, true); MK_LAYER(1, true); MK_LAYER(2, true); MK_LAYER(3, false);
#undef MK_LAYER
#undef MK_PH
}
#endif
}

#if MK_MULTI
template <int PH> static void launch_phase(const P& p, int l, int grid, hipStream_t st) {
    static bool attr_set = false;
    if (!attr_set) { (void)hipFuncSetAttribute((const void*)k_phase<PH>, hipFuncAttributeMaxDynamicSharedMemorySize, LDS_BYTES); attr_set = true; }
    hipLaunchKernelGGL(k_phase<PH>, dim3(grid), dim3(NT_), LDS_BYTES, st, p, l);
}
#endif

extern "C" void kernel_launch(void* const* d_in, const int* in_sizes, int n_in, void* d_out, int out_size, void* d_ws, size_t ws_size, hipStream_t stream) {
    (void)in_sizes; (void)n_in; (void)out_size; (void)ws_size;
    static int grid = 0;
    if (grid == 0) { int dev = 0, cus = 0; (void)hipGetDevice(&dev); (void)hipDeviceGetAttribute(&cus, hipDeviceAttributeMultiprocessorCount, dev); grid = cus > 0 ? cus : 256; }
    P p{};
    for (int i = 0; i < 37; ++i) p.in[i] = (const float*)d_in[i];
    p.out = (float*)d_out; p.ws = (unsigned char*)d_ws;
    (void)hipMemsetAsync(d_ws, 0, WS_CTL_END, stream);
#if MK_MULTI
    launch_phase<0>(p, 0, grid, stream);
    for (int l = 0; l < L_; ++l) {
        launch_phase<1>(p, l, grid, stream); launch_phase<2>(p, l, grid, stream); launch_phase<3>(p, l, grid, stream); launch_phase<4>(p, l, grid, stream);
        launch_phase<5>(p, l, grid, stream); launch_phase<6>(p, l, grid, stream); launch_phase<8>(p, l, grid, stream);
        launch_phase<10>(p, l, grid, stream); launch_phase<11>(p, l, grid, stream);
    }
#else
    static bool attr_set = false;
    if (!attr_set) { (void)hipFuncSetAttribute((const void*)k_fwd, hipFuncAttributeMaxDynamicSharedMemorySize, LDS_BYTES); attr_set = true; }
    hipLaunchKernelGGL(k_fwd, dim3(grid), dim3(NT_), LDS_BYTES, stream, p);
#endif
}
```

```cpp
#include <hip/hip_runtime.h>
#include <math.h>
#include <stdint.h>

#ifndef MK_MULTI
#define MK_MULTI 0
#endif

#ifndef MK_REP
#define MK_REP -1
#endif

namespace {
#define LAS __attribute__((address_space(3)))
#define DI __device__ __forceinline__
typedef unsigned short bf16_t;
typedef short bf16x8 __attribute__((ext_vector_type(8)));
typedef short s16x4 __attribute__((ext_vector_type(4)));
typedef float f32x4 __attribute__((ext_vector_type(4)));
typedef unsigned u32x4 __attribute__((ext_vector_type(4)));
typedef unsigned u32x2 __attribute__((ext_vector_type(2)));
typedef int v8i __attribute__((ext_vector_type(8)));
typedef int v4i __attribute__((ext_vector_type(4)));

constexpr int NB_ = 8, S_ = 2048, D_ = 1024, M_ = NB_ * S_, L_ = 4;
constexpr int DM_ = 512, H_ = 4, DH_ = 128, DIN_ = 2056, ZLD_ = 1536;
constexpr int G5_ = 32, P5_ = 64;
constexpr int PLE_ = 256, NE_ = 32, DE_ = 512;
constexpr int MT_ = 160, PS2_ = MT_ * 256, ECAP_ = 32768;
constexpr int S5K_ = 384, S5R_ = M_ / 16;
constexpr float ALPHA_ = 1.681792830507429f, EPS_ = 1e-5f;
constexpr int NT_ = 512;
constexpr int LDS_BYTES = 163840;

constexpr size_t al256(size_t x) { return (x + 255) & ~(size_t)255; }
constexpr int XCD_BAR_WORDS = 3456;
constexpr size_t WS_BAR = 0;
constexpr size_t WS_CUR = al256(WS_BAR + XCD_BAR_WORDS * 4);
constexpr size_t WS_DONE = al256(WS_CUR + (size_t)2 * L_ * NE_ * 64);
constexpr size_t WS_LNC = al256(WS_DONE + (size_t)2 * L_ * MT_ * 64);
constexpr size_t WS_CTL_END = al256(WS_LNC + (size_t)L_ * 64 * 64);
constexpr size_t WS_XB = WS_CTL_END;
constexpr size_t WS_XC = al256(WS_XB + (size_t)M_ * D_ * 2);
constexpr size_t WS_XCH = WS_XC;
constexpr size_t WS_LOGIT = WS_XC + ((size_t)16 << 20);
constexpr size_t WS_GHL = WS_XC + ((size_t)24 << 20);
constexpr size_t WS_RTC = WS_XC + ((size_t)26 << 20);
constexpr size_t WS_ZB = al256(WS_XC + (size_t)M_ * D_ * 4);
constexpr size_t WS_AS5 = al256(WS_ZB + (size_t)M_ * ZLD_ * 2);
constexpr size_t WS_ESUM = al256(WS_AS5 + (size_t)G5_ * S5R_ * S5K_ * 2);
constexpr size_t WS_QB = al256(WS_ESUM + (size_t)G5_ * S5R_ * 128 * 4);
constexpr size_t WS_KB = al256(WS_QB + (size_t)M_ * DM_ * 2);
constexpr size_t WS_CSUM = al256(WS_KB + (size_t)M_ * DM_ * 2);
constexpr size_t WS_CPREV = al256(WS_CSUM + (size_t)1024 * DH_ * DH_ * 4);
constexpr size_t WS_NSUM = al256(WS_CPREV + (size_t)1024 * DH_ * DH_ * 2);
constexpr size_t WS_NPREV = al256(WS_NSUM + (size_t)1024 * DH_ * 4);
constexpr size_t WS_GG = al256(WS_NPREV + (size_t)1024 * DH_ * 4);
constexpr size_t WS_MLG = al256(WS_GG + 4096);
constexpr size_t WS_MPREV = al256(WS_MLG + 4096);
constexpr size_t WS_IGG = al256(WS_MPREV + 4096);
constexpr size_t WS_BCUM = al256(WS_IGG + (size_t)M_ * 16);
constexpr size_t WS_YB = al256(WS_BCUM + (size_t)M_ * 16);
constexpr size_t WS_GYB = al256(WS_YB + (size_t)M_ * D_ * 2);
constexpr size_t WS_SSQS = al256(WS_GYB + (size_t)M_ * DM_ * 2);
constexpr size_t WS_X1 = al256(WS_SSQS + (size_t)M_ * 32);
constexpr size_t WS_X1B = al256(WS_X1 + (size_t)M_ * D_ * 4);
constexpr size_t WS_X1Q = al256(WS_X1B + (size_t)M_ * D_ * 2);
constexpr size_t WS_BUFT = al256(WS_X1Q + (size_t)M_ * D_);
constexpr size_t WS_BUFW = al256(WS_BUFT + (size_t)NE_ * ECAP_ * 4);
constexpr size_t WS_SLOT = al256(WS_BUFW + (size_t)NE_ * ECAP_ * 4);
constexpr size_t WS_HB = al256(WS_SLOT + (size_t)M_ * 8);
constexpr size_t WS_YE = al256(WS_HB + (size_t)PS2_ * DE_ * 2);
constexpr size_t WS_X2 = al256(WS_YE + (size_t)PS2_ * D_ * 2);
constexpr size_t WS_X2B = al256(WS_X2 + (size_t)M_ * D_ * 4);
constexpr size_t WS_TB = al256(WS_X2B + (size_t)M_ * D_ * 2);
constexpr size_t WS_SSQT = al256(WS_TB + (size_t)M_ * D_ * 2);
constexpr size_t WS_RSTDT = al256(WS_SSQT + (size_t)M_ * 64);
constexpr size_t WS_PBF = al256(WS_RSTDT + (size_t)M_ * 4);
constexpr size_t WS_WIN = al256(WS_PBF + (size_t)L_ * M_ * PLE_ * 2);
constexpr size_t WS_WOUT = al256(WS_WIN + (size_t)L_ * 2048 * D_ * 2);
constexpr size_t WS_WPG = al256(WS_WOUT + (size_t)L_ * D_ * D_ * 2);
constexpr size_t WS_WPP = al256(WS_WPG + (size_t)L_ * D_ * D_ * 2);
constexpr size_t WS_WGLU = al256(WS_WPP + (size_t)L_ * D_ * PLE_ * 2);
constexpr size_t WS_WQK = al256(WS_WGLU + (size_t)L_ * DM_ * DM_ * 2);
constexpr size_t WS_WGATE = al256(WS_WQK + (size_t)L_ * H_ * 256 * DH_ * 2);
constexpr size_t WS_WET = al256(WS_WGATE + (size_t)L_ * 16 * D_ * 2);
constexpr size_t WS_WYT = al256(WS_WET + (size_t)L_ * G5_ * 256 * 256 * 2);
constexpr size_t WS_A16 = al256(WS_WYT + (size_t)L_ * G5_ * 256 * S5K_ * 2);
constexpr size_t WS_WGU = al256(WS_A16 + (size_t)L_ * G5_ * 128 * 4);
constexpr size_t WS_WED = al256(WS_WGU + (size_t)NE_ * D_ * D_ * 2);
constexpr size_t WS_WRT = al256(WS_WED + (size_t)NE_ * D_ * DE_ * 2);
constexpr size_t WS_END = al256(WS_WRT + (size_t)L_ * 36 * D_ * 4);
static_assert(WS_END <= (size_t)1073741824, "workspace over 1 GiB");

struct P { const float* in[37]; float* out; unsigned char* ws; };
typedef const __attribute__((address_space(4))) P& PR;

typedef float f32x2_ __attribute__((ext_vector_type(2)));
typedef __bf16 bf16x2_ __attribute__((ext_vector_type(2)));
DI unsigned cvt_pk_bf16(float lo, float hi) { const f32x2_ v = {lo, hi}; return __builtin_bit_cast(unsigned, __builtin_convertvector(v, bf16x2_)); }
DI float bf2f(bf16_t v) { return __uint_as_float(((unsigned)v) << 16); }
DI float bflo(unsigned v) { return __uint_as_float(v << 16); }
DI float bfhi(unsigned v) { return __uint_as_float(v & 0xffff0000u); }
DI unsigned pack4_fp8(float a, float b, float c, float d) { int w = 0; w = __builtin_amdgcn_cvt_pk_fp8_f32(a, b, w, false); w = __builtin_amdgcn_cvt_pk_fp8_f32(c, d, w, true); return (unsigned)w; }
constexpr float W8_SCALE = 64.0f, W8_INV = 1.0f / 64.0f, YE_SCALE = 32.0f, YE_INV = 1.0f / 32.0f;
DI bf16_t f2bf(float f) { unsigned u = __float_as_uint(f); u += 0x7fffu + ((u >> 16) & 1u); return (bf16_t)(u >> 16); }
DI float wave_sum(float v) {
#pragma unroll
    for (int o = 32; o > 0; o >>= 1) v += __shfl_xor(v, o);
    return v;
}
DI float sigmoidf_(float x) { return 1.0f / (1.0f + expf(-x)); }
DI float siluf_(float x) { return x * sigmoidf_(x); }
DI float fast_sigmoid(float x) { return __builtin_amdgcn_rcpf(1.0f + __builtin_amdgcn_exp2f(-1.4426950408889634f * x)); }
DI float fast_silu(float x) { return x * fast_sigmoid(x); }
DI float fast_gelu_tanh(float x) { const float z2 = 1.5957691216057308f * (x + 0.044715f * x * x * x); return x * fast_sigmoid(z2); }
DI float log_sigmoid_(float x) { return (x >= 0.f) ? -log1pf(expf(-x)) : (x - log1pf(expf(x))); }
DI f32x4 mfma16(bf16x8 a, bf16x8 b, f32x4 c) { return __builtin_amdgcn_mfma_f32_16x16x32_bf16(a, b, c, 0, 0, 0); }
DI bf16x8 ld_frag_g(const bf16_t* p) { return *(const bf16x8*)p; }
DI bf16x8 cat8(s16x4 lo, s16x4 hi) { return __builtin_shufflevector(lo, hi, 0, 1, 2, 3, 4, 5, 6, 7); }
DI unsigned off_b(unsigned row, unsigned ch) { return 256u * row + 16u * (ch ^ (((row & 3u) << 2) | ((row >> 2) & 3u))); }
DI bf16x8 tile_row_read(const LAS unsigned char* tile, int lane, int rb, int s) {
    return *(const LAS bf16x8*)(tile + off_b((unsigned)((lane & 15) + 16 * rb), (unsigned)(4 * s + (lane >> 4))));
}
DI s16x4 tile_tr_read(const LAS unsigned char* tile, int lane, int row0, int c) {
    const unsigned q = (unsigned)(lane & 15) >> 2, p = (unsigned)lane & 3u;
    const unsigned addr = (unsigned)(size_t)tile + off_b((unsigned)row0 + q, (unsigned)(2 * c) + (p >> 1)) + 8u * (p & 1u);
    s16x4 r; asm volatile("ds_read_b64_tr_b16 %0, %1\n\ts_waitcnt lgkmcnt(0)" : "=&v"(r) : "v"(addr) : "memory"); return r;
}

DI unsigned tr_addr(const LAS unsigned char* tile, int lane, int row0, int c) {
    const unsigned q = (unsigned)(lane & 15) >> 2, p = (unsigned)lane & 3u;
    return (unsigned)(size_t)tile + off_b((unsigned)row0 + q, (unsigned)(2 * c) + (p >> 1)) + 8u * (p & 1u);
}
DI void tile_tr_read4(unsigned a0, unsigned a1, unsigned a2, unsigned a3, s16x4& r0, s16x4& r1, s16x4& r2, s16x4& r3) {
    asm volatile("ds_read_b64_tr_b16 %0, %4\n\tds_read_b64_tr_b16 %1, %5\n\tds_read_b64_tr_b16 %2, %6\n\tds_read_b64_tr_b16 %3, %7\n\ts_waitcnt lgkmcnt(0)"
                 : "=&v"(r0), "=&v"(r1), "=&v"(r2), "=&v"(r3) : "v"(a0), "v"(a1), "v"(a2), "v"(a3) : "memory");
}

#define XB_TMO      128
#define XB_XCNT(j)  (256  + 64 * (j))
#define XB_XSUB(j)  (1280 + 64 * (j))
#define XB_XGEN(j)  (2304 + 64 * (j))
#define XB_TOP      3328
#define XB_TOPGEN   3392
#define XB_SPIN_CAP (1u << 18)
DI unsigned xb_ld(unsigned* p)              { return __hip_atomic_load(p, __ATOMIC_RELAXED, __HIP_MEMORY_SCOPE_AGENT); }
DI unsigned xb_add(unsigned* p, unsigned v) { return __hip_atomic_fetch_add(p, v, __ATOMIC_RELAXED, __HIP_MEMORY_SCOPE_AGENT); }
DI unsigned xb_xcc_id() { return (unsigned)__builtin_amdgcn_s_getreg((3 << 11) | 20) & 0xFu; }
#define XB_SPIN(cond, bar) do { unsigned _sp = 0; while (cond) { __builtin_amdgcn_s_sleep(1); \
    if ((++_sp & 255u) == 0u) { if (xb_ld(&(bar)[XB_TMO])) break; if (_sp > XB_SPIN_CAP) { atomicAdd(&(bar)[XB_TMO], 1u); break; } } } } while (0)
struct XcdBarrier { unsigned* bar; unsigned x; volatile LAS unsigned* st; };
DI XcdBarrier xcd_barrier_post(unsigned* bar, volatile LAS unsigned* st) {
    XcdBarrier b; b.bar = bar; b.x = xb_xcc_id(); b.st = st;
    if (threadIdx.x == 0) (void)xb_add(&bar[XB_XCNT(b.x)], 1u);
    return b;
}
DI void xcd_barrier_complete(unsigned* bar, unsigned x, unsigned& nloc, unsigned& nx) {
    const unsigned G = gridDim.x * gridDim.y * gridDim.z;
    unsigned sum, cnt, mine, sp = 0u;
    for (;;) {
        sum = 0u; cnt = 0u; mine = 0u;
#pragma unroll
        for (unsigned j = 0; j < 16; ++j) { const unsigned c = xb_ld(&bar[XB_XCNT(j)]); sum += c; cnt += (c > 0u) ? 1u : 0u; mine = (j == x) ? c : mine; }
        if (sum == G) break;
        __builtin_amdgcn_s_sleep(1);
        if ((++sp & 255u) == 0u) { if (xb_ld(&bar[XB_TMO])) break; if (sp > XB_SPIN_CAP) { atomicAdd(&bar[XB_TMO], 1u); break; } }
    }
    nloc = mine > 0u ? mine : 1u; nx = cnt > 0u ? cnt : 1u;
}
DI void xcd_barrier(const XcdBarrier& b) {
    asm volatile("s_waitcnt vmcnt(0)" ::: "memory");
    __syncthreads();
    if (threadIdx.x == 0) {
        unsigned* bar = b.bar;
        __builtin_amdgcn_s_waitcnt(0);
        unsigned nloc = b.st[0], nx = b.st[1];
        if (nloc == 0u) { xcd_barrier_complete(bar, b.x, nloc, nx); b.st[0] = nloc; b.st[1] = nx; }
        const unsigned old = xb_add(&bar[XB_XSUB(b.x)], 1u);
        const unsigned gen = old / nloc;
        if (old + 1u == (gen + 1u) * nloc) {
            __builtin_amdgcn_fence(__ATOMIC_RELEASE, "agent");
            asm volatile("s_waitcnt vmcnt(0)" ::: "memory");
            const unsigned og = xb_add(&bar[XB_TOP], 1u);
            const unsigned tg = og / nx;
            if (og + 1u == (tg + 1u) * nx) xb_add(&bar[XB_TOPGEN], 1u);
            else XB_SPIN(xb_ld(&bar[XB_TOPGEN]) == tg, bar);
            __builtin_amdgcn_fence(__ATOMIC_ACQUIRE, "agent");
            xb_add(&bar[XB_XGEN(b.x)], 1u);
            asm volatile("s_waitcnt vmcnt(0)" ::: "memory");
        } else {
            XB_SPIN(xb_ld(&bar[XB_XGEN(b.x)]) == gen, bar);
            __builtin_amdgcn_fence(__ATOMIC_ACQUIRE, "agent");
            asm volatile("s_waitcnt vmcnt(0)" ::: "memory");
        }
    }
    __syncthreads();
}

constexpr int BM = 256, BK = 64, HALF = 128, HTB = HALF * BK * 2, STAGE_BYTES = 8 * HTB, NXCD = 8, WGM = 8;
DI int lds_byte(int r, int c) { const int st = (r >> 4) * 2 + (c >> 5), rr = r & 15, cc = c & 31, ob = rr * 64 + cc * 2; return st * 1024 + (ob ^ (((ob >> 9) & 1) << 5)); }
DI void stage_rc(int b, int& R, int& C) { const int st = b / 1024, sb = b % 1024, swz = sb ^ (((sb >> 9) & 1) << 5); R = (st >> 1) * 16 + swz / 64; C = (st & 1) * 32 + (swz % 64) / 2; }
DI int perm32(int rho) { const int n = rho >> 4, i = rho & 15; return 8 * (i >> 2) + 4 * n + (i & 3); }

struct Unit { const char* A; const char* B; int pm, pn, aux; };
struct Gemm { unsigned lda, ldb; int K; };

struct DenseOrder {
    static constexpr bool GATHER = false;
    const char* A; const char* B; unsigned lda, ldb; int nM, nN, nwg, G, c;
    DI void init(const void* A_, const void* B_, unsigned lda_, unsigned ldb_, int M, int N, int G_, int c_) { A = (const char*)A_; B = (const char*)B_; lda = lda_; ldb = ldb_; nM = M / BM; nN = N / BM; nwg = nM * nN; G = G_; c = c_; }
    DI bool next(int i, Unit& u) const {
        const long Lx = (long)i * G + c; if (Lx >= nwg) return false;
        int wgid = (int)Lx; { const int q = nwg / NXCD, r = nwg % NXCD, xcd = wgid % NXCD, off = wgid / NXCD; wgid = (xcd < r ? xcd * (q + 1) : r * (q + 1) + (xcd - r) * q) + off; }
        const int nig = WGM * nN, gid = wgid / nig, fm = gid * WGM, gsz = (nM - fm) < WGM ? (nM - fm) : WGM;
        u.pm = fm + ((wgid % nig) % gsz); u.pn = (wgid % nig) / gsz; u.aux = 0;
        u.A = A + (size_t)u.pm * BM * lda; u.B = B + (size_t)u.pn * BM * ldb; return true;
    }
    DI unsigned voff(const Unit&, int, int) const { return 0u; }
    DI void a_ready(const Unit&) const {}
};
struct GroupOrder {
    static constexpr bool GATHER = false;
    const char* A; const char* B; size_t astride, bstride; unsigned lda; int nunits, G, c;
    DI bool next(int i, Unit& u) const {
        const int Lx = i * G + c; if (Lx >= nunits) return false;
        const int g = Lx >> 2, pm = Lx & 3; u.pm = pm; u.pn = 0; u.aux = g; u.A = A + (size_t)g * astride + (size_t)pm * BM * lda; u.B = B + (size_t)g * bstride; return true;
    }
    DI unsigned voff(const Unit&, int, int) const { return 0u; }
    DI void a_ready(const Unit&) const {}
};
template <bool GATHER_>
struct MoeOrder {
    static constexpr bool GATHER = GATHER_;
    const char* A; const char* B; unsigned lda, ldb; size_t bstride; const LAS int* tbase; const LAS int* cnt; const int* buf_t; unsigned* done; int nunits, G, c, n3, nb;
    DI bool next(int i, Unit& u) const {
        int Lx;
        if constexpr (GATHER_) { Lx = i * G + c; }
        else { const int cr = (c - n3 + G) % G; const bool bonus = (c >= n3) && (c - n3 < nb); if (bonus && i == 0) Lx = c - n3; else Lx = nb + cr + (bonus ? i - 1 : i) * G; }
        if (Lx >= nunits) return false;
        const int T = Lx >> 2, pn = Lx & 3; int e = 0; while (e < NE_ - 1 && tbase[e + 1] <= T) ++e;
        const int k = T - tbase[e]; u.pm = T; u.pn = pn; u.aux = e * 128 + k;
        u.B = B + (size_t)e * bstride + (size_t)pn * BM * ldb; u.A = GATHER_ ? A : A + (size_t)T * BM * lda; return true;
    }
    DI unsigned voff(const Unit& u, int R, int C) const {
        const int e = u.aux >> 7, idx = (u.aux & 127) * 256 + R; const int tok = (idx < cnt[e]) ? buf_t[(size_t)e * ECAP_ + idx] : 0;
        return (unsigned)tok * lda + (unsigned)C * 2u;
    }
    DI void a_ready(const Unit& u) const {
        if constexpr (!GATHER_) {
            if (threadIdx.x < 64) {
                unsigned spins = 0;
                while ((unsigned)__builtin_amdgcn_readfirstlane(__hip_atomic_load(done + 16 * u.pm, __ATOMIC_RELAXED, __HIP_MEMORY_SCOPE_AGENT)) < 32u) { __builtin_amdgcn_s_sleep(2); if (++spins > (1u << 22)) break; }
                __builtin_amdgcn_fence(__ATOMIC_ACQUIRE, "agent");
                asm volatile("s_waitcnt vmcnt(0)" ::: "memory");
            }
            asm volatile("" ::: "memory"); __builtin_amdgcn_s_barrier(); asm volatile("" ::: "memory");
        }
    }
};

template <class Epi, class Sched>
DI void gemm_phase(LAS unsigned char* lds, const Gemm g, const Sched& S, const Epi& E) {
    int tid = threadIdx.x; asm volatile("" : "+v"(tid)); tid &= 511;
    const int wid = __builtin_amdgcn_readfirstlane(tid >> 6), lane = tid & 63, wr = wid >> 2, wc = wid & 3, fr = lane & 15, fq = lane >> 4;
    const int nt = g.K / BK;
    unsigned voffA[2][2], nvoffA[2][2], voffB[2];
#pragma unroll
    for (int i = 0; i < 2; ++i) { int R, C; stage_rc(tid * 16 + i * 8192, R, C); const int Rb = Epi::PERM ? ((R & ~31) + perm32(R & 31)) : R;
        voffB[i] = (unsigned)Rb * g.ldb + (unsigned)C * 2u;
        voffA[0][i] = (unsigned)R * g.lda + (unsigned)C * 2u; voffA[1][i] = (unsigned)(R + HALF) * g.lda + (unsigned)C * 2u;
        nvoffA[0][i] = voffA[0][i]; nvoffA[1][i] = voffA[1][i]; }
    const size_t kstep = (size_t)(BK * 2);
    const size_t hstepB = (size_t)HALF * g.ldb;
    const unsigned ldsw = (unsigned)wid * 1024u;
    const int aoff = lds_byte(wr * 64 + fr, fq * 8), boff = lds_byte(wc * 32 + fr, fq * 8);
#define PG8_SA(b, h) (((b) * 2 + (h)) * HTB)
#define PG8_SB(b, h) ((4 + (b) * 2 + (h)) * HTB)
#define PG8_STAGE(bufoff, gbase, voff) do { _Pragma("unroll") for (int _i = 0; _i < 2; ++_i) \
        __builtin_amdgcn_global_load_lds((const unsigned*)((const char*)(gbase) + (voff)[_i]), (LAS unsigned*)(lds + (bufoff) + ldsw + _i * 8192), 16, 0, 0); } while (0)
#define PG8_LDA(dst, b, h) do { if constexpr (Epi::FP8) { _Pragma("unroll") for (int m = 0; m < 4; ++m) dst##8[m] = __builtin_shufflevector(*(const LAS v4i*)(lds + PG8_SA(b, h) + aoff + m * 2048), *(const LAS v4i*)(lds + PG8_SA(b, h) + aoff + m * 2048 + 1024), 0, 1, 2, 3, 4, 5, 6, 7); } \
        else { _Pragma("unroll") for (int m = 0; m < 4; ++m) _Pragma("unroll") for (int k = 0; k < 2; ++k) dst[m][k] = *(const LAS bf16x8*)(lds + PG8_SA(b, h) + aoff + m * 2048 + k * 1024); } } while (0)
#define PG8_LDB(dst, b, h) do { if constexpr (Epi::FP8) { _Pragma("unroll") for (int n = 0; n < 2; ++n) dst##8[n] = __builtin_shufflevector(*(const LAS v4i*)(lds + PG8_SB(b, h) + boff + n * 2048), *(const LAS v4i*)(lds + PG8_SB(b, h) + boff + n * 2048 + 1024), 0, 1, 2, 3, 4, 5, 6, 7); } \
        else { _Pragma("unroll") for (int n = 0; n < 2; ++n) _Pragma("unroll") for (int k = 0; k < 2; ++k) dst[n][k] = *(const LAS bf16x8*)(lds + PG8_SB(b, h) + boff + n * 2048 + k * 1024); } } while (0)
#define PG8_MMA(ai, bj, At, Bt) do { __builtin_amdgcn_s_setprio(1); _Pragma("unroll") for (int m = 0; m < 4; ++m) _Pragma("unroll") for (int n = 0; n < 2; ++n) { \
        if constexpr (Epi::FP8)   \
            asm volatile("v_mfma_scale_f32_16x16x128_f8f6f4 %0, %1, %2, %0, %3, %3 op_sel_hi:[0,0,0]" : "+v"(acc[ai][bj][m][n]) : "v"(Bt##8[n]), "v"(At##8[m]), "v"(sc8));   \
        else { _Pragma("unroll") for (int k = 0; k < 2; ++k) acc[ai][bj][m][n] = __builtin_amdgcn_mfma_f32_16x16x32_bf16(Bt[n][k], At[m][k], acc[ai][bj][m][n], 0, 0, 0); } } \
        __builtin_amdgcn_s_setprio(0); } while (0)
#define PG8_WAIT_V(n) asm volatile("s_waitcnt vmcnt(" #n ")" ::: "memory")
#define PG8_WAIT_L(n) asm volatile("s_waitcnt lgkmcnt(" #n ")" ::: "memory")
#define PG8_BAR __builtin_amdgcn_s_barrier()
#define PG8_SCHED __builtin_amdgcn_sched_barrier(0)
    Unit cur, nxt; int ui = 0;
    if (!S.next(0, cur)) return;
    if constexpr (Sched::GATHER) {
#pragma unroll
        for (int i = 0; i < 2; ++i) { int R, C; stage_rc(tid * 16 + i * 8192, R, C); voffA[0][i] = S.voff(cur, R, C); voffA[1][i] = S.voff(cur, R + HALF, C); }
    }
    f32x4 acc[2][2][4][2];
#pragma unroll
    for (int a = 0; a < 2; ++a)
#pragma unroll
        for (int b = 0; b < 2; ++b)
#pragma unroll
            for (int m = 0; m < 4; ++m)
#pragma unroll
                for (int n = 0; n < 2; ++n) acc[a][b][m][n] = (f32x4){0.f, 0.f, 0.f, 0.f};
    const int sc8 = 0x7f7f7f7f;
    bf16x8 At[4][2], B0[2][2], B1[2][2]; v8i At8[4], B08[2], B18[2];
    const char* cA = cur.A; const char* cB = cur.B;
    S.a_ready(cur);
    PG8_STAGE(PG8_SB(0, 0), cB, voffB); PG8_STAGE(PG8_SB(0, 1), cB + hstepB, voffB); PG8_STAGE(PG8_SA(0, 0), cA, voffA[0]); PG8_STAGE(PG8_SA(0, 1), cA, voffA[1]);
    if (wr == 1) PG8_BAR;
    PG8_WAIT_V(2); PG8_BAR;
    PG8_STAGE(PG8_SB(1, 0), cB + kstep, voffB); PG8_STAGE(PG8_SA(1, 0), cA + kstep, voffA[0]); PG8_STAGE(PG8_SB(1, 1), cB + hstepB + kstep, voffB);
    PG8_WAIT_V(6); PG8_BAR;
    for (;;) {
        const bool has_next = S.next(ui + 1, nxt);
        const char* nA = has_next ? nxt.A : cA; const char* nB = has_next ? nxt.B : cB;
        if constexpr (Sched::GATHER) {
            if (has_next) {
#pragma unroll
                for (int i = 0; i < 2; ++i) { int R, C; stage_rc(tid * 16 + i * 8192, R, C); nvoffA[0][i] = S.voff(nxt, R, C); nvoffA[1][i] = S.voff(nxt, R + HALF, C); }
            } else {
#pragma unroll
                for (int i = 0; i < 2; ++i) { nvoffA[0][i] = voffA[0][i]; nvoffA[1][i] = voffA[1][i]; }
            }
        }
        for (int t = 0; t < nt; t += 2) {
            const bool last = (t == nt - 2);
            if constexpr (Epi::MIDSCALE) { if (t == nt / 2) E.mid(acc, cur, wr, fr); }
            if (last && has_next) S.a_ready(nxt);
            const char* a1 = cA + (size_t)(t + 1) * kstep;
            const char* a2 = last ? nA : cA + (size_t)(t + 2) * kstep; const char* b2 = last ? nB : cB + (size_t)(t + 2) * kstep;
            const char* a3 = a2 + kstep; const char* b3 = b2 + kstep;
            unsigned va0[2], va1[2];
#pragma unroll
            for (int i = 0; i < 2; ++i) { va0[i] = (Sched::GATHER && last) ? nvoffA[0][i] : voffA[0][i]; va1[i] = (Sched::GATHER && last) ? nvoffA[1][i] : voffA[1][i]; }
            PG8_LDB(B0, 0, 0); PG8_LDB(B1, 0, 1); PG8_SCHED; PG8_LDA(At, 0, 0); PG8_STAGE(PG8_SA(1, 1), a1, voffA[1]);
            PG8_WAIT_V(8); PG8_WAIT_L(0); PG8_BAR; PG8_MMA(0, 0, At, B0); PG8_MMA(0, 1, At, B1); PG8_BAR; PG8_SCHED;
            PG8_LDA(At, 0, 1); PG8_STAGE(PG8_SB(0, 0), b2, voffB); PG8_STAGE(PG8_SB(0, 1), b2 + hstepB, voffB); PG8_STAGE(PG8_SA(0, 0), a2, va0);
            PG8_WAIT_V(8); PG8_WAIT_L(0); PG8_BAR; PG8_MMA(1, 0, At, B0); PG8_MMA(1, 1, At, B1); PG8_BAR; PG8_SCHED;
            PG8_LDB(B0, 1, 0); PG8_LDB(B1, 1, 1); PG8_SCHED; PG8_LDA(At, 1, 0); PG8_STAGE(PG8_SA(0, 1), a2, va1);
            PG8_WAIT_V(8); PG8_WAIT_L(0); PG8_BAR; PG8_MMA(0, 0, At, B0); PG8_MMA(0, 1, At, B1); PG8_BAR; PG8_SCHED;
            PG8_LDA(At, 1, 1); PG8_STAGE(PG8_SB(1, 0), b3, voffB); PG8_STAGE(PG8_SB(1, 1), b3 + hstepB, voffB); PG8_STAGE(PG8_SA(1, 0), a3, va0);
            PG8_WAIT_V(8); PG8_WAIT_L(0); PG8_BAR; PG8_MMA(1, 0, At, B0); PG8_MMA(1, 1, At, B1); PG8_BAR; PG8_SCHED;
        }
        if (wr == 0) PG8_BAR;
        if constexpr (Epi::FP8) {
#define PG8_PIN8(a, b) asm volatile("s_nop 15\n\ts_nop 15" : "+v"(acc[a][b][0][0]), "+v"(acc[a][b][0][1]), "+v"(acc[a][b][1][0]), "+v"(acc[a][b][1][1]), "+v"(acc[a][b][2][0]), "+v"(acc[a][b][2][1]), "+v"(acc[a][b][3][0]), "+v"(acc[a][b][3][1]))
            PG8_PIN8(0, 0); PG8_PIN8(0, 1); PG8_PIN8(1, 0); PG8_PIN8(1, 1);
#undef PG8_PIN8
        }
        { int tz = tid; asm volatile("" : "+v"(tz)); tz &= 511;
          const int wz = __builtin_amdgcn_readfirstlane(tz >> 6), lz = tz & 63; if constexpr (!Epi::AFTER_DRAIN) E(acc, cur, wz >> 2, wz & 3, lz & 15, lz >> 4); }
        if (!has_next) break;
#pragma unroll
        for (int a = 0; a < 2; ++a)
#pragma unroll
            for (int b = 0; b < 2; ++b)
#pragma unroll
                for (int m = 0; m < 4; ++m)
#pragma unroll
                    for (int n = 0; n < 2; ++n) acc[a][b][m][n] = (f32x4){0.f, 0.f, 0.f, 0.f};
        cur = nxt; cA = nA; cB = nB; ++ui;
        if constexpr (Sched::GATHER) {
#pragma unroll
            for (int i = 0; i < 2; ++i) { voffA[0][i] = nvoffA[0][i]; voffA[1][i] = nvoffA[1][i]; }
        }
        if (wr == 1) PG8_BAR;
    }
    PG8_WAIT_V(0);
    PG8_BAR;
    if constexpr (Epi::AFTER_DRAIN) {
        int tz = tid; asm volatile("" : "+v"(tz)); tz &= 511;
        const int wz = __builtin_amdgcn_readfirstlane(tz >> 6), lz = tz & 63; E.fused(acc, cur, wz >> 2, wz & 3, lz & 15, lz >> 4, lds, tz);
    }
#undef PG8_SA
#undef PG8_SB
#undef PG8_STAGE
#undef PG8_LDA
#undef PG8_LDB
#undef PG8_MMA
#undef PG8_WAIT_V
#undef PG8_WAIT_L
#undef PG8_BAR
#undef PG8_SCHED
}


struct EpiInProj {
    static constexpr bool PERM = true, MIDSCALE = false, FP8 = false, AFTER_DRAIN = false;
    bf16_t* zb; bf16_t* AS5;
    DI void operator()(const f32x4 (&acc)[2][2][4][2], const Unit& u, int wr, int wc, int fr, int fq) const {
        const int row0 = u.pm * BM + wr * 64 + fr, col0 = u.pn * BM + wc * 32 + 8 * fq;
#pragma unroll
        for (int ai = 0; ai < 2; ++ai)
#pragma unroll
            for (int m = 0; m < 4; ++m) { const int row = row0 + ai * HALF + m * 16;
#pragma unroll
                for (int bj = 0; bj < 2; ++bj) { const f32x4 v0 = acc[ai][bj][m][0], v1 = acc[ai][bj][m][1]; const int col = col0 + bj * HALF;
                    u32x4 o; o.x = cvt_pk_bf16(v0[0], v0[1]); o.y = cvt_pk_bf16(v0[2], v0[3]); o.z = cvt_pk_bf16(v1[0], v1[1]); o.w = cvt_pk_bf16(v1[2], v1[3]);
                    if (u.pn < 6) *(u32x4*)(zb + (size_t)row * ZLD_ + col) = o;
                    else { const int cs = col - 1536; *(u32x4*)(AS5 + ((size_t)(cs >> 4) * S5R_ + (row >> 4)) * S5K_ + (row & 15) * 16 + (cs & 15)) = o; } } }
    }
};
struct EpiS5E {
    static constexpr bool PERM = false, MIDSCALE = false, FP8 = false, AFTER_DRAIN = false;
    bf16_t* E;
    DI void operator()(const f32x4 (&acc)[2][2][4][2], const Unit& u, int wr, int wc, int fr, int fq) const {
        const int row0 = u.pm * BM + wr * 64 + fr, col0 = wc * 32 + 4 * fq;
#pragma unroll
        for (int ai = 0; ai < 2; ++ai)
#pragma unroll
            for (int m = 0; m < 4; ++m) { bf16_t* rowp = E + ((size_t)u.aux * S5R_ + row0 + ai * HALF + m * 16) * 128 + col0;
#pragma unroll
                for (int n = 0; n < 2; ++n) { const f32x4 v = acc[ai][0][m][n]; u32x2 o; o.x = cvt_pk_bf16(v[0], v[1]); o.y = cvt_pk_bf16(v[2], v[3]); *(u32x2*)(rowp + n * 16) = o; } }
    }
};
struct EpiS5Y {
    static constexpr bool PERM = false, MIDSCALE = false, FP8 = false, AFTER_DRAIN = false;
    bf16_t* gy;
    DI void operator()(const f32x4 (&acc)[2][2][4][2], const Unit& u, int wr, int wc, int fr, int fq) const {
        const int row0 = u.pm * BM + wr * 64 + fr;
#pragma unroll
        for (int ai = 0; ai < 2; ++ai)
#pragma unroll
            for (int m = 0; m < 4; ++m) { const int row = row0 + ai * HALF + m * 16;
#pragma unroll
                for (int bj = 0; bj < 2; ++bj)
#pragma unroll
                    for (int n = 0; n < 2; ++n) { const int j = 8 * bj + 2 * wc + n; const f32x4 v = acc[ai][bj][m][n];
                        u32x2 o; o.x = cvt_pk_bf16(fast_gelu_tanh(v[0]), fast_gelu_tanh(v[1])); o.y = cvt_pk_bf16(fast_gelu_tanh(v[2]), fast_gelu_tanh(v[3]));
                        *(u32x2*)(gy + (size_t)(16 * row + j) * DM_ + 16 * u.aux + 4 * fq) = o; } }
    }
};
struct EpiGlu {
    static constexpr bool PERM = false, MIDSCALE = false, FP8 = false, AFTER_DRAIN = false;
    const bf16_t* gy; const float* b_glu; bf16_t* yb; float* ssqS;
    DI void operator()(const f32x4 (&acc)[2][2][4][2], const Unit& u, int wr, int wc, int fr, int fq) const {
        const int row0 = u.pm * BM + wr * 64 + fr, col0 = u.pn * BM + wc * 32 + 4 * fq;
#pragma unroll
        for (int ai = 0; ai < 2; ++ai)
#pragma unroll
            for (int m = 0; m < 4; ++m) { const int row = row0 + ai * HALF + m * 16; float ss = 0.f;
#pragma unroll
                for (int bj = 0; bj < 2; ++bj)
#pragma unroll
                    for (int n = 0; n < 2; ++n) { const int col = col0 + bj * HALF + n * 16; const f32x4 a = acc[ai][bj][m][n]; const f32x4 bb = *(const f32x4*)(b_glu + col);
                        const u32x2 gv = *(const u32x2*)(gy + (size_t)row * DM_ + col);
                        const float y0 = bflo(gv.x) * fast_sigmoid(a[0] + bb[0]), y1 = bfhi(gv.x) * fast_sigmoid(a[1] + bb[1]), y2 = bflo(gv.y) * fast_sigmoid(a[2] + bb[2]), y3 = bfhi(gv.y) * fast_sigmoid(a[3] + bb[3]);
                        ss += (y0 * y0 + y1 * y1) + (y2 * y2 + y3 * y3);
                        u32x2 o; o.x = cvt_pk_bf16(y0, y1); o.y = cvt_pk_bf16(y2, y3); *(u32x2*)(yb + (size_t)row * D_ + col) = o; }
                ss += __shfl_xor(ss, 16); ss += __shfl_xor(ss, 32);
                if (fq == 0) ssqS[(size_t)row * 8 + u.pn * 4 + wc] = ss; }
    }
};
struct EpiOutProj {
    static constexpr bool PERM = true, MIDSCALE = true, FP8 = false, AFTER_DRAIN = false;
    const bf16_t* xres; const float* ssqS; bf16_t* r1;
    DI void mid(f32x4 (&acc)[2][2][4][2], const Unit& u, int wr, int fr) const {
        const int row0 = u.pm * BM + wr * 64 + fr;
#pragma unroll
        for (int ai = 0; ai < 2; ++ai)
#pragma unroll
            for (int m = 0; m < 4; ++m) { const int row = row0 + ai * HALF + m * 16; const f32x4 s0 = *(const f32x4*)(ssqS + (size_t)row * 8), s1 = *(const f32x4*)(ssqS + (size_t)row * 8 + 4);
                const float rstd = rsqrtf(((s0[0] + s0[1]) + (s0[2] + s0[3]) + (s1[0] + s1[1]) + (s1[2] + s1[3])) * (1.f / DM_) + EPS_);
#pragma unroll
                for (int bj = 0; bj < 2; ++bj)
#pragma unroll
                    for (int n = 0; n < 2; ++n) acc[ai][bj][m][n] = acc[ai][bj][m][n] * rstd; }
    }
    DI void operator()(const f32x4 (&acc)[2][2][4][2], const Unit& u, int wr, int wc, int fr, int fq) const {
        const int row0 = u.pm * BM + wr * 64 + fr, col0 = u.pn * BM + wc * 32 + 8 * fq;
#pragma unroll
        for (int ai = 0; ai < 2; ++ai)
#pragma unroll
            for (int m = 0; m < 4; ++m) { const size_t rb = (size_t)(row0 + ai * HALF + m * 16) * D_ + col0;
#pragma unroll
                for (int bj = 0; bj < 2; ++bj) { const u32x4 xv = *(const u32x4*)(xres + rb + bj * HALF); const f32x4 v0 = acc[ai][bj][m][0], v1 = acc[ai][bj][m][1];
                    u32x4 o; o.x = cvt_pk_bf16(ALPHA_ * bflo(xv.x) + v0[0], ALPHA_ * bfhi(xv.x) + v0[1]); o.y = cvt_pk_bf16(ALPHA_ * bflo(xv.y) + v0[2], ALPHA_ * bfhi(xv.y) + v0[3]);
                    o.z = cvt_pk_bf16(ALPHA_ * bflo(xv.z) + v1[0], ALPHA_ * bfhi(xv.z) + v1[1]); o.w = cvt_pk_bf16(ALPHA_ * bflo(xv.w) + v1[2], ALPHA_ * bfhi(xv.w) + v1[3]);
                    *(u32x4*)(r1 + rb + bj * HALF) = o; } }
    }
};
struct EpiOutLn {
    static constexpr bool PERM = true, MIDSCALE = true, FP8 = false, AFTER_DRAIN = true;
    const bf16_t* xres; const float* ssqS; const bf16_t* ghl; const float* rtc; const float* ln_g; const float* ln_b;
    float* xch; unsigned* cnt; bf16_t* x1b; unsigned char* x1q; unsigned* cur; int* buf_t; float* buf_w; int* slot_of;
    DI void mid(f32x4 (&acc)[2][2][4][2], const Unit& u, int wr, int fr) const {
        const int row0 = u.pm * BM + wr * 64 + fr;
#pragma unroll
        for (int ai = 0; ai < 2; ++ai)
#pragma unroll
            for (int m = 0; m < 4; ++m) { const int row = row0 + ai * HALF + m * 16; const f32x4 s0 = *(const f32x4*)(ssqS + (size_t)row * 8), s1 = *(const f32x4*)(ssqS + (size_t)row * 8 + 4);
                const float rstd = rsqrtf(((s0[0] + s0[1]) + (s0[2] + s0[3]) + (s1[0] + s1[1]) + (s1[2] + s1[3])) * (1.f / DM_) + EPS_);
#pragma unroll
                for (int bj = 0; bj < 2; ++bj)
#pragma unroll
                    for (int n = 0; n < 2; ++n) acc[ai][bj][m][n] = acc[ai][bj][m][n] * rstd; }
    }
    DI void operator()(const f32x4 (&)[2][2][4][2], const Unit&, int, int, int, int) const {}
    DI void fused(f32x4 (&acc)[2][2][4][2], const Unit& u, int wr, int wc, int fr, int fq, LAS unsigned char* lds, int tid) const {
        LAS float* PT4 = (LAS float*)lds;
        LAS float* MS = (LAS float*)(lds + 81920);
        const int row0 = u.pm * BM + wr * 64 + fr, col0 = u.pn * BM + wc * 32 + 8 * fq;
        u32x4 gtv[6];
#pragma unroll
        for (int i = 0; i < 6; ++i) { const int idx = tid + i * NT_; gtv[i] = *(const u32x4*)(ghl + (size_t)(idx >> 5) * D_ + u.pn * BM + (idx & 31) * 8); }
#pragma unroll
        for (int ai = 0; ai < 2; ++ai) {
#pragma unroll
            for (int m = 0; m < 4; ++m) { const size_t rb = (size_t)(row0 + ai * HALF + m * 16) * D_ + col0;
#pragma unroll
                for (int bj = 0; bj < 2; ++bj) { const u32x4 xv = *(const u32x4*)(xres + rb + bj * HALF); f32x4 v0 = acc[ai][bj][m][0], v1 = acc[ai][bj][m][1];
                    v0[0] += ALPHA_ * bflo(xv.x); v0[1] += ALPHA_ * bfhi(xv.x); v0[2] += ALPHA_ * bflo(xv.y); v0[3] += ALPHA_ * bfhi(xv.y);
                    v1[0] += ALPHA_ * bflo(xv.z); v1[1] += ALPHA_ * bfhi(xv.z); v1[2] += ALPHA_ * bflo(xv.w); v1[3] += ALPHA_ * bfhi(xv.w);
                    acc[ai][bj][m][0] = v0; acc[ai][bj][m][1] = v1; } } }
        asm volatile("" ::: "memory");
        LAS unsigned char* GT = lds + 83968;
        LAS float* LG = (LAS float*)(lds + 134656);
        LAS int* cntL = (LAS int*)(lds + 144896); LAS int* baseL = cntL + 32; LAS int* tokE = baseL + 32; LAS float* tokW = (LAS float*)(tokE + 128);
        if (tid < 32) cntL[tid] = 0;
#pragma unroll
        for (int i = 0; i < 6; ++i) { const int idx = tid + i * NT_; *(LAS u32x4*)(GT + (idx >> 5) * 528 + (idx & 31) * 16) = gtv[i]; }
        __syncthreads();
        const LAS unsigned char* gfrag = GT + fr * 528 + (wc * 32 + 8 * fq) * 2;
        float* xq = xch + (size_t)(u.pm * 4 + u.pn) * 256 * 40;
#pragma unroll
        for (int ai = 0; ai < 2; ++ai) {
#pragma unroll
            for (int m = 0; m < 4; ++m) {
                f32x4 d[3]; d[0] = (f32x4){0.f, 0.f, 0.f, 0.f}; d[1] = d[0]; d[2] = d[0]; float s2 = 0.f;
#pragma unroll
                for (int bj = 0; bj < 2; ++bj) { const f32x4 v0 = acc[ai][bj][m][0], v1 = acc[ai][bj][m][1];
                    u32x4 h, lo; h.x = cvt_pk_bf16(v0[0], v0[1]); h.y = cvt_pk_bf16(v0[2], v0[3]); h.z = cvt_pk_bf16(v1[0], v1[1]); h.w = cvt_pk_bf16(v1[2], v1[3]);
                    lo.x = cvt_pk_bf16(v0[0] - bflo(h.x), v0[1] - bfhi(h.x)); lo.y = cvt_pk_bf16(v0[2] - bflo(h.y), v0[3] - bfhi(h.y));
                    lo.z = cvt_pk_bf16(v1[0] - bflo(h.z), v1[1] - bfhi(h.z)); lo.w = cvt_pk_bf16(v1[2] - bflo(h.w), v1[3] - bfhi(h.w));
                    const bf16x8 ah = __builtin_bit_cast(bf16x8, h), al = __builtin_bit_cast(bf16x8, lo);
#pragma unroll
                    for (int ob = 0; ob < 3; ++ob) { const bf16x8 gh = *(const LAS bf16x8*)(gfrag + ob * 16 * 528 + bj * 256), gl = *(const LAS bf16x8*)(gfrag + (48 + ob * 16) * 528 + bj * 256);
                        d[ob] = mfma16(gh, ah, d[ob]); d[ob] = mfma16(gl, ah, d[ob]); d[ob] = mfma16(gh, al, d[ob]); }
                    s2 += ((v0[0] * v0[0] + v0[1] * v0[1]) + (v0[2] * v0[2] + v0[3] * v0[3])) + ((v1[0] * v1[0] + v1[1] * v1[1]) + (v1[2] * v1[2] + v1[3] * v1[3])); }
                s2 += __shfl_xor(s2, 16); s2 += __shfl_xor(s2, 32);
                if (fq == 1) d[2][1] = s2;
                LAS float* rp = PT4 + (wc * 128 + wr * 64 + m * 16 + fr) * 40;
                *(LAS f32x4*)(rp + 4 * fq) = d[0]; *(LAS f32x4*)(rp + 16 + 4 * fq) = d[1]; if (fq < 2) *(LAS f32x4*)(rp + 32 + 4 * fq) = d[2];
            }
            __syncthreads();
            for (int idx = tid; idx < 1280; idx += NT_) { const LAS f32x4* q4 = (const LAS f32x4*)PT4 + idx; const f32x4 s = ((q4[0] + q4[1280]) + q4[2560]) + q4[3840];
                unsigned long long* dst = (unsigned long long*)(xq + (size_t)ai * 5120 + (size_t)idx * 4);
                __hip_atomic_store(dst, ((unsigned long long)__float_as_uint(s[1]) << 32) | __float_as_uint(s[0]), __ATOMIC_RELAXED, __HIP_MEMORY_SCOPE_AGENT);
                __hip_atomic_store(dst + 1, ((unsigned long long)__float_as_uint(s[3]) << 32) | __float_as_uint(s[2]), __ATOMIC_RELAXED, __HIP_MEMORY_SCOPE_AGENT); }
            __syncthreads();
        }
        f32x4 gg[2][2], bb[2][2];
#pragma unroll
        for (int bj = 0; bj < 2; ++bj)
#pragma unroll
            for (int n = 0; n < 2; ++n) { gg[bj][n] = *(const f32x4*)(ln_g + col0 + bj * HALF + 4 * n); bb[bj][n] = *(const f32x4*)(ln_b + col0 + bj * HALF + 4 * n); }
        asm volatile("s_waitcnt vmcnt(0)" ::: "memory");
        if (fr == 0 && fq == 0) __hip_atomic_fetch_add(cnt + 16 * u.pm, 1u, __ATOMIC_RELAXED, __HIP_MEMORY_SCOPE_AGENT);
        if (tid < 64) {
            unsigned spins = 0;
            while ((unsigned)__builtin_amdgcn_readfirstlane(__hip_atomic_load(cnt + 16 * u.pm, __ATOMIC_RELAXED, __HIP_MEMORY_SCOPE_AGENT)) < 32u) { __builtin_amdgcn_s_sleep(2); if (++spins > (1u << 22)) break; }
            __builtin_amdgcn_fence(__ATOMIC_ACQUIRE, "agent");
            asm volatile("s_waitcnt vmcnt(0)" ::: "memory");
        }
        __syncthreads();
        const float* xp = xch + (size_t)u.pm * 4 * 256 * 40;
        {
            const int rl = tid >> 3, rr = u.pn * 64 + rl, q = tid & 7;
            f32x4 pa[4], pb[4]; f32x2_ st[4], sm[4];
#pragma unroll
            for (int t = 0; t < 4; ++t) { const float* rec = xp + ((size_t)t * 256 + rr) * 40; pa[t] = *(const f32x4*)(rec + 4 * q); st[t] = *(const f32x2_*)(rec + 36);
                pb[t] = (f32x4){0.f, 0.f, 0.f, 0.f}; if (q == 0) pb[t] = *(const f32x4*)(rec + 32);
                sm[t] = (f32x2_){0.f, 0.f}; if (tid < 256) sm[t] = *(const f32x2_*)(xp + ((size_t)t * 256 + tid) * 40 + 36); }
            const f32x4 cs = *(const f32x4*)(rtc + 4 * q), bw = *(const f32x4*)(rtc + 40 + 4 * q), cs8 = *(const f32x4*)(rtc + 32), bw8 = *(const f32x4*)(rtc + 72);
            const f32x2_ sr = ((st[0] + st[1]) + st[2]) + st[3], sq = ((sm[0] + sm[1]) + sm[2]) + sm[3];
            const float mean = sr[0] * (1.f / D_), rstd = rsqrtf(fmaxf(sr[1] * (1.f / D_) - mean * mean, 0.f) + EPS_);
            const f32x4 sa = ((pa[0] + pa[1]) + pa[2]) + pa[3], sb = ((pb[0] + pb[1]) + pb[2]) + pb[3];
            *(LAS f32x4*)(LG + rl * 40 + 4 * q) = (sa - cs * mean) * rstd + bw;
            if (q == 0) *(LAS f32x4*)(LG + rl * 40 + 32) = (sb - cs8 * mean) * rstd + bw8;
            if (tid < 256) { const float mq = sq[0] * (1.f / D_); MS[2 * tid] = mq; MS[2 * tid + 1] = rsqrtf(fmaxf(sq[1] * (1.f / D_) - mq * mq, 0.f) + EPS_); }
        }
        __syncthreads();
        if (tid < 64) { const LAS float* lg = LG + tid * 40;
            const f32x4 gl = *(const LAS f32x4*)lg; float mx = gl[0]; int gi = 0;
#pragma unroll
            for (int i = 1; i < 4; ++i) if (gl[i] > mx) { mx = gl[i]; gi = i; }
            float se = 0.f;
#pragma unroll
            for (int i = 0; i < 4; ++i) se += expf(gl[i] - mx);
            const float pg = 1.0f / se;
            const f32x4 e0 = *(const LAS f32x4*)(lg + 4 + gi * 8), e1 = *(const LAS f32x4*)(lg + 8 + gi * 8);
            float ev[8];
#pragma unroll
            for (int i = 0; i < 4; ++i) { ev[i] = e0[i]; ev[4 + i] = e1[i]; }
            int i0 = 0;
#pragma unroll
            for (int i = 1; i < 8; ++i) if (ev[i] > ev[i0]) i0 = i;
            int i1 = (i0 == 0) ? 1 : 0;
#pragma unroll
            for (int i = 0; i < 8; ++i) if (i != i0 && ev[i] > ev[i1]) i1 = i;
            const float e1x = expf(ev[i1] - ev[i0]); const float w0 = 1.f / (1.f + e1x), w1 = e1x / (1.f + e1x);
            const int ea = gi * 8 + i0, eb = gi * 8 + i1;
            const int ra = atomicAdd((int*)&cntL[ea], 1), rb = atomicAdd((int*)&cntL[eb], 1);
            tokE[tid * 2] = (ea << 16) | ra; tokE[tid * 2 + 1] = (eb << 16) | rb; tokW[tid * 2] = pg * w0; tokW[tid * 2 + 1] = pg * w1;
        }
        __syncthreads();
        int basev = 0;
        if (tid < 32) { const int cl = cntL[tid]; basev = cl ? (int)atomicAdd(&cur[tid * 16], (unsigned)cl) : 0; }
#pragma unroll
        for (int ai = 0; ai < 2; ++ai)
#pragma unroll
            for (int m = 0; m < 4; ++m) { const int rl = ai * HALF + wr * 64 + m * 16 + fr; const float mean = MS[2 * rl], rstd = MS[2 * rl + 1]; const size_t rb = (size_t)(u.pm * BM + rl) * D_ + col0;
#pragma unroll
                for (int bj = 0; bj < 2; ++bj) { const f32x4 y0 = (acc[ai][bj][m][0] - mean) * rstd * gg[bj][0] + bb[bj][0], y1 = (acc[ai][bj][m][1] - mean) * rstd * gg[bj][1] + bb[bj][1];
                    u32x4 o; o.x = cvt_pk_bf16(y0[0], y0[1]); o.y = cvt_pk_bf16(y0[2], y0[3]); o.z = cvt_pk_bf16(y1[0], y1[1]); o.w = cvt_pk_bf16(y1[2], y1[3]);
                    *(u32x4*)(x1b + rb + bj * HALF) = o;
                    u32x2 q8; q8.x = pack4_fp8(y0[0], y0[1], y0[2], y0[3]); q8.y = pack4_fp8(y1[0], y1[1], y1[2], y1[3]); *(u32x2*)(x1q + rb + bj * HALF) = q8; } }
        if (tid < 32) baseL[tid] = basev;
        __syncthreads();
        if (tid < 128) { const int v = tokE[tid]; const int e = v >> 16, r = baseL[e] + (v & 0xffff); const int token = u.pm * BM + u.pn * 64 + (tid >> 1);
            buf_t[(size_t)e * ECAP_ + r] = token; buf_w[(size_t)e * ECAP_ + r] = tokW[tid]; slot_of[token * 2 + (tid & 1)] = (e << 16) | r; }
    }
};
struct EpiSiluMul {
    static constexpr bool PERM = true, MIDSCALE = false, FP8 = true, AFTER_DRAIN = false;
    unsigned char* Hb; unsigned* done;
    DI void operator()(const f32x4 (&acc)[2][2][4][2], const Unit& u, int wr, int wc, int fr, int fq) const {
        const int row0 = u.pm * BM + wr * 64 + fr, hu0 = u.pn * 128 + wc * 32 + 8 * fq;
#pragma unroll
        for (int ai = 0; ai < 2; ++ai)
#pragma unroll
            for (int m = 0; m < 4; ++m) { unsigned char* rowp = Hb + (size_t)(row0 + ai * HALF + m * 16) * DE_ + hu0;
                const f32x4 g0 = acc[ai][0][m][0] * W8_INV, g1 = acc[ai][0][m][1] * W8_INV, u0 = acc[ai][1][m][0] * W8_INV, u1 = acc[ai][1][m][1] * W8_INV;
                const unsigned lo = pack4_fp8(fast_silu(g0[0]) * u0[0], fast_silu(g0[1]) * u0[1], fast_silu(g0[2]) * u0[2], fast_silu(g0[3]) * u0[3]);
                const unsigned hi = pack4_fp8(fast_silu(g1[0]) * u1[0], fast_silu(g1[1]) * u1[1], fast_silu(g1[2]) * u1[2], fast_silu(g1[3]) * u1[3]);
                __hip_atomic_store((unsigned long long*)rowp, ((unsigned long long)hi << 32) | lo, __ATOMIC_RELAXED, __HIP_MEMORY_SCOPE_AGENT); }
        asm volatile("s_waitcnt vmcnt(0)" ::: "memory");
        if (fr == 0 && fq == 0) __hip_atomic_fetch_add(done + 16 * u.pm, 1u, __ATOMIC_RELAXED, __HIP_MEMORY_SCOPE_AGENT);
    }
};
struct EpiDown {
    static constexpr bool PERM = true, MIDSCALE = false, FP8 = true, AFTER_DRAIN = false;
    unsigned char* O; const float* buf_w; const LAS int* cnt;
    DI void operator()(const f32x4 (&acc)[2][2][4][2], const Unit& u, int wr, int wc, int fr, int fq) const {
        const int e = u.aux >> 7, kb = (u.aux & 127) * 256, ce = cnt[e];
        const int rl0 = wr * 64 + fr, col0 = u.pn * BM + wc * 32 + 8 * fq;
#pragma unroll
        for (int ai = 0; ai < 2; ++ai)
#pragma unroll
            for (int m = 0; m < 4; ++m) { const int rl = rl0 + ai * HALF + m * 16; const float sc = (kb + rl < ce) ? buf_w[(size_t)e * ECAP_ + kb + rl] * (W8_INV * YE_SCALE) : 0.f;
                unsigned char* rowp = O + (size_t)(u.pm * BM + rl) * D_ + col0;
#pragma unroll
                for (int bj = 0; bj < 2; ++bj) { const f32x4 v0 = acc[ai][bj][m][0] * sc, v1 = acc[ai][bj][m][1] * sc;
                    u32x2 o; o.x = pack4_fp8(v0[0], v0[1], v0[2], v0[3]); o.y = pack4_fp8(v1[0], v1[1], v1[2], v1[3]);
                    *(u32x2*)(rowp + bj * HALF) = o; } }
    }
};
struct EpiT {
    static constexpr bool PERM = false, MIDSCALE = false, FP8 = false, AFTER_DRAIN = false;
    bf16_t* Tb; float* ssqT;
    DI void operator()(const f32x4 (&acc)[2][2][4][2], const Unit& u, int wr, int wc, int fr, int fq) const {
        const int row0 = u.pm * BM + wr * 64 + fr, col0 = u.pn * BM + wc * 32 + 4 * fq;
#pragma unroll
        for (int ai = 0; ai < 2; ++ai)
#pragma unroll
            for (int m = 0; m < 4; ++m) { const int row = row0 + ai * HALF + m * 16; float ss = 0.f;
#pragma unroll
                for (int bj = 0; bj < 2; ++bj)
#pragma unroll
                    for (int n = 0; n < 2; ++n) { const f32x4 a = acc[ai][bj][m][n]; ss += (a[0] * a[0] + a[1] * a[1]) + (a[2] * a[2] + a[3] * a[3]);
                        u32x2 o; o.x = cvt_pk_bf16(a[0], a[1]); o.y = cvt_pk_bf16(a[2], a[3]); *(u32x2*)(Tb + (size_t)row * D_ + col0 + bj * HALF + n * 16) = o; }
                ss += __shfl_xor(ss, 16); ss += __shfl_xor(ss, 32);
                if (fq == 0) ssqT[(size_t)row * 16 + u.pn * 4 + wc] = ss; }
    }
};
struct EpiPle {
    static constexpr bool PERM = true, MIDSCALE = false, FP8 = false, AFTER_DRAIN = false;
    const bf16_t* x2b; const bf16_t* Tb; const float* rstdT; const float* b_pg; const float* ple_g; float* xout; bf16_t* xb;
    DI void operator()(const f32x4 (&acc)[2][2][4][2], const Unit& u, int wr, int wc, int fr, int fq) const {
        const int row0 = u.pm * BM + wr * 64 + fr, col0 = u.pn * BM + wc * 32 + 8 * fq;
        f32x4 bp[2][2], pg[2][2];
#pragma unroll
        for (int bj = 0; bj < 2; ++bj)
#pragma unroll
            for (int n = 0; n < 2; ++n) { bp[bj][n] = *(const f32x4*)(b_pg + col0 + bj * HALF + 4 * n); pg[bj][n] = *(const f32x4*)(ple_g + col0 + bj * HALF + 4 * n); }
#pragma unroll
        for (int ai = 0; ai < 2; ++ai)
#pragma unroll
            for (int m = 0; m < 4; ++m) { const int row = row0 + ai * HALF + m * 16; const float rstd = rstdT[row];
#pragma unroll
                for (int bj = 0; bj < 2; ++bj) { const size_t o = (size_t)row * D_ + col0 + bj * HALF;
                    const u32x4 xv = *(const u32x4*)(x2b + o), tv = *(const u32x4*)(Tb + o);
                    const f32x4 a0 = acc[ai][bj][m][0], a1 = acc[ai][bj][m][1];
                    f32x4 r0, r1;
                    r0[0] = bflo(xv.x) + fast_sigmoid(a0[0] + bp[bj][0][0]) * bflo(tv.x) * rstd * pg[bj][0][0]; r0[1] = bfhi(xv.x) + fast_sigmoid(a0[1] + bp[bj][0][1]) * bfhi(tv.x) * rstd * pg[bj][0][1];
                    r0[2] = bflo(xv.y) + fast_sigmoid(a0[2] + bp[bj][0][2]) * bflo(tv.y) * rstd * pg[bj][0][2]; r0[3] = bfhi(xv.y) + fast_sigmoid(a0[3] + bp[bj][0][3]) * bfhi(tv.y) * rstd * pg[bj][0][3];
                    r1[0] = bflo(xv.z) + fast_sigmoid(a1[0] + bp[bj][1][0]) * bflo(tv.z) * rstd * pg[bj][1][0]; r1[1] = bfhi(xv.z) + fast_sigmoid(a1[1] + bp[bj][1][1]) * bfhi(tv.z) * rstd * pg[bj][1][1];
                    r1[2] = bflo(xv.w) + fast_sigmoid(a1[2] + bp[bj][1][2]) * bflo(tv.w) * rstd * pg[bj][1][2]; r1[3] = bfhi(xv.w) + fast_sigmoid(a1[3] + bp[bj][1][3]) * bfhi(tv.w) * rstd * pg[bj][1][3];
                    if (xout) { *(f32x4*)(xout + o) = r0; *(f32x4*)(xout + o + 4) = r1; }
                    else { u32x4 ob; ob.x = cvt_pk_bf16(r0[0], r0[1]); ob.y = cvt_pk_bf16(r0[2], r0[3]); ob.z = cvt_pk_bf16(r1[0], r1[1]); ob.w = cvt_pk_bf16(r1[2], r1[3]); *(u32x4*)(xb + o) = ob; } } }
    }
};

struct Ctx { int G, bid, tid, lane, w; };
DI const float* IN(PR p, int i) { return p.in[i]; }
template <class T> DI T* WSP(PR p, size_t off) { return (T*)(p.ws + off); }

struct TJob { const float* src0; const float* src1; bf16_t* dst; int ldw, K, N, mode, nmat, krot, kscale_n, fp8; size_t sstr, dstr, kstr; float scale; const float* kscale; };
DI void transpose_job(const TJob& j, int gwave, int nwaves, LAS float* scr, int lane) {
    const int nkb = j.K / 64, nnb = j.N / 32; const long per = (long)nkb * nnb, total = per * j.nmat;
    for (long it = gwave; it < total; it += nwaves) {
        const int mat = (int)(it / per); const int r = (int)(it % per); const int kb = r / nnb, nb = r % nnb, k0 = kb * 64, n0 = nb * 32;
        const int n = n0 + (lane & 31);
        const float* sp; int col;
        if (j.mode == 2) { const int blk = n >> 7; sp = (const float*)((const char*)j.src0 + (ptrdiff_t)(blk & 1) * ((const char*)j.src1 - (const char*)j.src0)); col = 128 * (blk >> 1) + (n & 127); }
        else { sp = j.src0; col = n + ((j.mode == 1 && n >= 1536) ? 8 : 0); }
        sp += (size_t)mat * j.sstr + col;
#pragma unroll
        for (int i = 0; i < 32; ++i) { const int kk = 2 * i + (lane >> 5); const int kd = k0 + kk; const int ksrc = (kd + j.krot) & (j.K - 1);
            float v = sp[(size_t)ksrc * j.ldw] * j.scale; if (j.kscale && kd < j.kscale_n) v *= j.kscale[(size_t)mat * j.kstr + kd];
            scr[kk * 33 + (lane & 31)] = v; }
        __builtin_amdgcn_s_waitcnt(0xC07F); __builtin_amdgcn_wave_barrier();
        const int c = lane & 7;
        bf16_t* d = j.dst + (size_t)mat * j.dstr;
#pragma unroll
        for (int jj = 0; jj < 4; ++jj) { const int nn = (lane >> 3) + 8 * jj; const LAS float* s = scr + (8 * c) * 33 + nn;
            if (j.fp8) { u32x2 o8; o8.x = pack4_fp8(s[0 * 33], s[1 * 33], s[2 * 33], s[3 * 33]); o8.y = pack4_fp8(s[4 * 33], s[5 * 33], s[6 * 33], s[7 * 33]);
                *(u32x2*)((unsigned char*)j.dst + (size_t)mat * j.dstr + (size_t)(n0 + nn) * j.K + k0 + 8 * c) = o8; }
            else { u32x4 o; o.x = cvt_pk_bf16(s[0 * 33], s[1 * 33]); o.y = cvt_pk_bf16(s[2 * 33], s[3 * 33]); o.z = cvt_pk_bf16(s[4 * 33], s[5 * 33]); o.w = cvt_pk_bf16(s[6 * 33], s[7 * 33]);
                *(u32x4*)(d + (size_t)(n0 + nn) * j.K + k0 + 8 * c) = o; } }
        __builtin_amdgcn_s_waitcnt(0xC07F); __builtin_amdgcn_wave_barrier();
    }
}
DI TJob mk_job(const float* s0, const float* s1, int ldw, int K, int N, bf16_t* dst, int mode, int nmat, size_t sstr, size_t dstr, float scale = 1.f) {
    TJob j; j.src0 = s0; j.src1 = s1; j.dst = dst; j.ldw = ldw; j.K = K; j.N = N; j.mode = mode; j.nmat = nmat; j.krot = 0; j.kscale_n = 0; j.fp8 = 0; j.sstr = sstr; j.dstr = dstr; j.kstr = 0; j.scale = scale; j.kscale = nullptr; return j;
}
DI void cvt_rows(const float* __restrict__ src, bf16_t* __restrict__ dst, size_t n8, size_t gt, size_t nthreads) {
    for (size_t i = gt; i < n8; i += nthreads) { const f32x4 a = ((const f32x4*)src)[2 * i], b = ((const f32x4*)src)[2 * i + 1];
        u32x4 o; o.x = cvt_pk_bf16(a[0], a[1]); o.y = cvt_pk_bf16(a[2], a[3]); o.z = cvt_pk_bf16(b[0], b[1]); o.w = cvt_pk_bf16(b[2], b[3]); ((u32x4*)dst)[i] = o; }
}
DI void moe_weight_jobs(PR p, const Ctx& c, int l, LAS unsigned char* lds, bool probe_dummy = false) {
    LAS float* scr = (LAS float*)(lds + c.w * 8448);
    const int gwave = c.bid * 4 + (c.w - 4), nwaves = c.G * 4;
    { TJob j = mk_job(IN(p, 28) + (size_t)l * NE_ * D_ * DE_, IN(p, 29) + (size_t)l * NE_ * D_ * DE_, DE_, D_, D_, probe_dummy ? WSP<bf16_t>(p, WS_YE) : WSP<bf16_t>(p, WS_WGU), 2, NE_, (size_t)D_ * DE_, (size_t)D_ * D_, W8_SCALE); j.fp8 = 1;
      transpose_job(j, gwave, nwaves, scr, c.lane); }
    { TJob j = mk_job(IN(p, 30) + (size_t)l * NE_ * DE_ * D_, nullptr, D_, DE_, D_, probe_dummy ? WSP<bf16_t>(p, WS_YE) + (size_t)NE_ * D_ * D_ / 2 : WSP<bf16_t>(p, WS_WED), 0, NE_, (size_t)DE_ * D_, (size_t)D_ * DE_, W8_SCALE); j.fp8 = 1;
      transpose_job(j, gwave, nwaves, scr, c.lane); }
}

DI void s5_prep_job(PR p, int lg, LAS unsigned char* lds, int tid) {
    LAS float* apr = (LAS float*)lds;
    LAS float* api = apr + 17 * 64;
    LAS float* bbr = api + 17 * 64;
    LAS float* bbi = bbr + 1024;
    LAS float* ccr = bbi + 1024;
    LAS float* cci = ccr + 16 * 68;
    LAS float* kd = cci + 16 * 68;
    const float* lam_re = IN(p, 10); const float* lam_im = IN(p, 11); const float* b_re = IN(p, 13); const float* b_im = IN(p, 14); const float* c_re = IN(p, 15); const float* c_im = IN(p, 16);
    const float dt = expf(IN(p, 12)[lg]);
    __syncthreads();
    for (int idx = tid; idx < 17 * 64; idx += NT_) { const int pp = idx & 63, d = idx >> 6; const float lr = lam_re[lg * 64 + pp], li = lam_im[lg * 64 + pp];
        const float er = expf((float)d * lr * dt), ang = (float)d * li * dt; apr[d * 64 + pp] = er * cosf(ang); api[d * 64 + pp] = er * sinf(ang); }
    for (int idx = tid; idx < 1024; idx += NT_) { const int pp = idx >> 4, ci = idx & 15; const float lr = lam_re[lg * 64 + pp], li = lam_im[lg * 64 + pp];
        const float er = expf(lr * dt), ar = er * cosf(li * dt), ai = er * sinf(li * dt); const float mag2 = lr * lr + li * li, xr0 = ar - 1.f, xi0 = ai;
        const float cr = (xr0 * lr + xi0 * li) / mag2, cim = (xi0 * lr - xr0 * li) / mag2; const float br = b_re[(size_t)(lg * 64 + pp) * 16 + ci], bi = b_im[(size_t)(lg * 64 + pp) * 16 + ci];
        bbr[pp * 16 + ci] = cr * br - cim * bi; bbi[pp * 16 + ci] = cr * bi + cim * br; }
    for (int idx = tid; idx < 1024; idx += NT_) { ccr[(idx >> 6) * 68 + (idx & 63)] = c_re[(size_t)lg * 1024 + idx]; cci[(idx >> 6) * 68 + (idx & 63)] = c_im[(size_t)lg * 1024 + idx]; }
    __syncthreads();
    {
        const int d = tid >> 5, co = (tid >> 1) & 15, hf = tid & 1; f32x4 v0 = (f32x4){0.f, 0.f, 0.f, 0.f}, v1 = v0;
        for (int pp = 0; pp < 64; ++pp) { const float ar = apr[d * 64 + pp], ai = api[d * 64 + pp], cr = ccr[co * 68 + pp], ci_ = cci[co * 68 + pp];
            const float wr_ = cr * ar - ci_ * ai, wi_ = cr * ai + ci_ * ar;
            const f32x4 r0 = *(const LAS f32x4*)(bbr + pp * 16 + hf * 8), r1 = *(const LAS f32x4*)(bbr + pp * 16 + hf * 8 + 4), i0 = *(const LAS f32x4*)(bbi + pp * 16 + hf * 8), i1 = *(const LAS f32x4*)(bbi + pp * 16 + hf * 8 + 4);
            v0 = v0 + r0 * wr_ - i0 * wi_; v1 = v1 + r1 * wr_ - i1 * wi_; }
        if (d == 0) { const float dsk = IN(p, 17)[lg * 16 + co];
#pragma unroll
            for (int e = 0; e < 4; ++e) { if (co == hf * 8 + e) v0[e] += dsk; if (co == hf * 8 + 4 + e) v1[e] += dsk; } }
        *(LAS f32x4*)(kd + (d * 16 + co) * 16 + hf * 8) = v0; *(LAS f32x4*)(kd + (d * 16 + co) * 16 + hf * 8 + 4) = v1; }
    __syncthreads();
    bf16_t* wy = WSP<bf16_t>(p, WS_WYT) + (size_t)lg * 256 * S5K_;
    for (int idx = tid; idx < 256 * 48; idx += NT_) { const int n = idx / 48, kc = idx % 48, j = n >> 4, co = n & 15; f32x4 v0 = (f32x4){0.f, 0.f, 0.f, 0.f}, v1 = v0;
        if (kc < 32) { const int i = kc >> 1, ci0 = (kc & 1) * 8; if (i <= j) { v0 = *(const LAS f32x4*)(kd + ((j - i) * 16 + co) * 16 + ci0); v1 = *(const LAS f32x4*)(kd + ((j - i) * 16 + co) * 16 + ci0 + 4); } }
        else { const int kk0 = (kc - 32) * 8, pp0 = kk0 & 63;
            const f32x4 c0r = *(const LAS f32x4*)(ccr + co * 68 + pp0), c1r = *(const LAS f32x4*)(ccr + co * 68 + pp0 + 4), c0i = *(const LAS f32x4*)(cci + co * 68 + pp0), c1i = *(const LAS f32x4*)(cci + co * 68 + pp0 + 4);
            const f32x4 a0r = *(const LAS f32x4*)(apr + (j + 1) * 64 + pp0), a1r = *(const LAS f32x4*)(apr + (j + 1) * 64 + pp0 + 4), a0i = *(const LAS f32x4*)(api + (j + 1) * 64 + pp0), a1i = *(const LAS f32x4*)(api + (j + 1) * 64 + pp0 + 4);
            if (kk0 < 64) { v0 = c0r * a0r - c0i * a0i; v1 = c1r * a1r - c1i * a1i; } else { v0 = -(c0r * a0i + c0i * a0r); v1 = -(c1r * a1i + c1i * a1r); } }
        u32x4 o; o.x = cvt_pk_bf16(v0[0], v0[1]); o.y = cvt_pk_bf16(v0[2], v0[3]); o.z = cvt_pk_bf16(v1[0], v1[1]); o.w = cvt_pk_bf16(v1[2], v1[3]);
        *(u32x4*)(wy + (size_t)n * S5K_ + kc * 8) = o; }
    bf16_t* we = WSP<bf16_t>(p, WS_WET) + (size_t)lg * 256 * 256;
    for (int idx = tid; idx < 256 * 32; idx += NT_) { const int n = idx >> 5, kc = idx & 31; f32x4 v0 = (f32x4){0.f, 0.f, 0.f, 0.f}, v1 = v0;
        if (n < 128) { const int pp = n & 63, i = kc >> 1, ci0 = (kc & 1) * 8; const float ar = apr[(15 - i) * 64 + pp], ai = api[(15 - i) * 64 + pp];
            const f32x4 r0 = *(const LAS f32x4*)(bbr + pp * 16 + ci0), r1 = *(const LAS f32x4*)(bbr + pp * 16 + ci0 + 4), i0 = *(const LAS f32x4*)(bbi + pp * 16 + ci0), i1 = *(const LAS f32x4*)(bbi + pp * 16 + ci0 + 4);
            if (n < 64) { v0 = r0 * ar - i0 * ai; v1 = r1 * ar - i1 * ai; } else { v0 = i0 * ar + r0 * ai; v1 = i1 * ar + r1 * ai; } }
        u32x4 o; o.x = cvt_pk_bf16(v0[0], v0[1]); o.y = cvt_pk_bf16(v0[2], v0[3]); o.z = cvt_pk_bf16(v1[0], v1[1]); o.w = cvt_pk_bf16(v1[2], v1[3]);
        *(u32x4*)(we + (size_t)n * 256 + kc * 8) = o; }
    if (tid < 64) { float* A16 = WSP<float>(p, WS_A16); A16[(size_t)lg * 128 + tid] = apr[16 * 64 + tid]; A16[(size_t)lg * 128 + 64 + tid] = api[16 * 64 + tid]; }
}

DI void ph_prologue(PR p, const Ctx& c, LAS unsigned char* lds, int sel = 15) {
    const size_t gt = (size_t)c.bid * NT_ + c.tid, nth = (size_t)c.G * NT_;
    if (sel & 1) {
    cvt_rows(IN(p, 0), WSP<bf16_t>(p, WS_XB), (size_t)M_ * D_ / 8, gt, nth);
    cvt_rows(IN(p, 1), WSP<bf16_t>(p, WS_PBF), (size_t)L_ * M_ * PLE_ / 8, gt, nth);
    }
    if (sel & 2) {
    { bf16_t* wg = WSP<bf16_t>(p, WS_WGATE); const float* w_in = IN(p, 2);
      for (size_t i = gt; i < (size_t)L_ * 16 * D_; i += nth) { const int k = (int)(i % D_), n = (int)((i / D_) % 16), l = (int)(i / (16 * D_));
          wg[i] = (n < 8) ? f2bf(w_in[((size_t)l * D_ + k) * DIN_ + 1536 + n]) : (bf16_t)0; } }
    { bf16_t* ghl = WSP<bf16_t>(p, WS_GHL); const float* w_grp = IN(p, 24); const float* w_rt = IN(p, 26); const float* lng = IN(p, 22);
      for (size_t i = gt; i < (size_t)L_ * 48 * D_; i += nth) { const int k = (int)(i % D_), o = (int)((i / D_) % 48), l = (int)(i / (48 * D_));
          const float gk = lng[(size_t)l * D_ + k];
          const float v = (o < 4) ? w_grp[((size_t)l * D_ + k) * 4 + o] * gk : (o < 36) ? w_rt[((size_t)l * D_ + k) * 32 + (o - 4)] * gk : (o == 36 ? 1.f : 0.f);
          const bf16_t h = f2bf(v); ghl[((size_t)(l * 2) * 48 + o) * D_ + k] = h; ghl[((size_t)(l * 2 + 1) * 48 + o) * D_ + k] = f2bf(v - bf2f(h)); } }
    { float* rtc = WSP<float>(p, WS_RTC); const float* w_grp = IN(p, 24); const float* w_rt = IN(p, 26); const float* lng = IN(p, 22); const float* lnb = IN(p, 23);
      for (int job = c.bid * 8 + c.w; job < L_ * 40; job += c.G * 8) { const int l = job / 40, o = job % 40; float cs = 0.f, bw = 0.f;
          if (o < 36) { for (int k = c.lane; k < D_; k += 64) { const float wv = (o < 4) ? w_grp[((size_t)l * D_ + k) * 4 + o] : w_rt[((size_t)l * D_ + k) * 32 + (o - 4)];
                  cs += wv * lng[(size_t)l * D_ + k]; bw += wv * lnb[(size_t)l * D_ + k]; }
              cs = wave_sum(cs); bw = wave_sum(bw) + ((o < 4) ? IN(p, 25)[l * 4 + o] : IN(p, 27)[l * 32 + o - 4]); }
          if (c.lane == 0) { rtc[(l * 2) * 40 + o] = cs; rtc[(l * 2 + 1) * 40 + o] = bw; } } }
    }
    LAS float* scr = (LAS float*)(lds + c.w * 8448);
    const int gwave = c.bid * 8 + c.w, nwaves = c.G * 8;
    const bool split = (sel == 15) && (c.G >= 2 * L_ * G5_);
    if (split) {
        if (c.bid < L_ * G5_) { s5_prep_job(p, c.bid, lds, c.tid); __syncthreads(); }
        else transpose_job(mk_job(IN(p, 2), nullptr, DIN_, D_, 2048, WSP<bf16_t>(p, WS_WIN), 1, L_, (size_t)D_ * DIN_, (size_t)2048 * D_), (c.bid - L_ * G5_) * 8 + c.w, (c.G - L_ * G5_) * 8, scr, c.lane);
    }
    if (sel & 4) {
    if (!split) transpose_job(mk_job(IN(p, 2), nullptr, DIN_, D_, 2048, WSP<bf16_t>(p, WS_WIN), 1, L_, (size_t)D_ * DIN_, (size_t)2048 * D_), gwave, nwaves, scr, c.lane);
    { TJob j = mk_job(IN(p, 21), nullptr, D_, D_, D_, WSP<bf16_t>(p, WS_WOUT), 0, L_, (size_t)D_ * D_, (size_t)D_ * D_); j.krot = 512; j.kscale = IN(p, 20); j.kscale_n = 512; j.kstr = DM_;
      transpose_job(j, gwave, nwaves, scr, c.lane); }
    transpose_job(mk_job(IN(p, 33), nullptr, D_, D_, D_, WSP<bf16_t>(p, WS_WPG), 0, L_, (size_t)D_ * D_, (size_t)D_ * D_), gwave, nwaves, scr, c.lane);
    transpose_job(mk_job(IN(p, 35), nullptr, D_, PLE_, D_, WSP<bf16_t>(p, WS_WPP), 0, L_, (size_t)PLE_ * D_, (size_t)D_ * PLE_), gwave, nwaves, scr, c.lane);
    transpose_job(mk_job(IN(p, 18), nullptr, DM_, DM_, DM_, WSP<bf16_t>(p, WS_WGLU), 0, L_, (size_t)DM_ * DM_, (size_t)DM_ * DM_), gwave, nwaves, scr, c.lane);
    transpose_job(mk_job(IN(p, 5), nullptr, DH_, DH_, DH_, WSP<bf16_t>(p, WS_WQK), 0, L_ * H_, (size_t)DH_ * DH_, (size_t)256 * DH_), gwave, nwaves, scr, c.lane);
    transpose_job(mk_job(IN(p, 6), nullptr, DH_, DH_, DH_, WSP<bf16_t>(p, WS_WQK) + (size_t)DH_ * DH_, 0, L_ * H_, (size_t)DH_ * DH_, (size_t)256 * DH_, 0.08838834764831845f), gwave, nwaves, scr, c.lane);
    }
    if ((sel & 8) && !split) { for (int job = c.bid; job < L_ * G5_; job += c.G) { s5_prep_job(p, job, lds, c.tid); __syncthreads(); } }
}

DI void ph_inproj(PR p, const Ctx& c, int l, LAS unsigned char* lds) {
    DenseOrder S; S.init(WSP<bf16_t>(p, WS_XB), WSP<bf16_t>(p, WS_WIN) + (size_t)l * 2048 * D_, D_ * 2, D_ * 2, M_, 2048, c.G, c.bid);
    EpiInProj E{WSP<bf16_t>(p, WS_ZB), WSP<bf16_t>(p, WS_AS5)};
    gemm_phase<EpiInProj, DenseOrder>(lds, Gemm{(unsigned)(D_ * 2), (unsigned)(D_ * 2), D_}, S, E);
}

DI void mlstm_sum_unit(PR p, const Ctx& c, int l, int unit, LAS unsigned char* lds) {
    LAS unsigned char* ctile = lds;
    LAS unsigned char* ktile = lds + 32768;
    LAS unsigned char* vtile = lds + 65536;
    LAS float* wsS = (LAS float*)(lds + 98304);
    LAS float* gred = wsS + 256;
    const bf16_t* zb = WSP<bf16_t>(p, WS_ZB); const bf16_t* xb = WSP<bf16_t>(p, WS_XB); const bf16_t* wgate = WSP<bf16_t>(p, WS_WGATE) + (size_t)l * 16 * D_;
    const bf16_t* wqkT = WSP<bf16_t>(p, WS_WQK) + (size_t)l * H_ * 256 * DH_;
    const float* cw = IN(p, 3) + (size_t)l * 4 * DM_; const float* cb = IN(p, 4) + (size_t)l * DM_; const float* b_i = IN(p, 7) + l * H_; const float* b_f = IN(p, 8) + l * H_;
    bf16_t* cvb = WSP<bf16_t>(p, WS_QB); bf16_t* Csum = WSP<bf16_t>(p, WS_CSUM); float* nsum = WSP<float>(p, WS_NSUM);
    float* gG = WSP<float>(p, WS_GG); float* mlG = WSP<float>(p, WS_MLG); float* igG = WSP<float>(p, WS_IGG); float* bcumG = WSP<float>(p, WS_BCUM);
    const int tid = c.tid, lane = c.lane, w = c.w, fr = lane & 15, fq = lane >> 4, hh = w >> 2, wq = w & 3;
    const int b = unit / (S_ / 64), cc = unit % (S_ / 64); const int tok0 = b * S_ + cc * 64;
    __syncthreads();
    {
        f32x4 ga[4];
#pragma unroll
        for (int ms = 0; ms < 4; ++ms) ga[ms] = (f32x4){0.f, 0.f, 0.f, 0.f};
#pragma unroll
        for (int kk = 0; kk < 4; ++kk) { const int ks = 4 * w + kk; const bf16x8 bw = ld_frag_g(wgate + (size_t)fr * D_ + 32 * ks + 8 * fq);
#pragma unroll
            for (int ms = 0; ms < 4; ++ms) { const bf16x8 af = ld_frag_g(xb + (size_t)(tok0 + 16 * ms + fr) * D_ + 32 * ks + 8 * fq); ga[ms] = mfma16(af, bw, ga[ms]); } }
#pragma unroll
        for (int ms = 0; ms < 4; ++ms)
#pragma unroll
            for (int r = 0; r < 4; ++r) gred[(w * 64 + 16 * ms + 4 * fq + r) * 16 + fr] = ga[ms][r];
    }
    __syncthreads();
    if (w < 4) {
        const int h = w; const int tok = tok0 + lane; float ip = 0.f, fp = 0.f;
#pragma unroll
        for (int ww = 0; ww < 8; ++ww) { ip += gred[(ww * 64 + lane) * 16 + h]; fp += gred[(ww * 64 + lane) * 16 + 4 + h]; }
        const float ig = ip + b_i[h]; const float lf = log_sigmoid_(fp + b_f[h]);
        float cum = lf;
#pragma unroll
        for (int o = 1; o < 64; o <<= 1) { const float t = __shfl_up(cum, o); if (lane >= o) cum += t; }
        const float g = __shfl(cum, 63); const float a = g - cum + ig;
        float mx = a;
#pragma unroll
        for (int o = 32; o > 0; o >>= 1) mx = fmaxf(mx, __shfl_xor(mx, o));
        wsS[h * 64 + lane] = __expf(a - mx);
        igG[(size_t)tok * 4 + h] = ig; bcumG[(size_t)tok * 4 + h] = cum;
        if (lane == 0) { gG[(b * H_ + h) * 32 + cc] = g; mlG[(b * H_ + h) * 32 + cc] = mx; }
    }
    u32x4 uu[4][4], vv[4];
#define MX1_LOAD(rdv) do { _Pragma("unroll") for (int i = 0; i < 4; ++i) { const int it = tid + i * NT_; const int hq = it >> 10, sr = (it >> 4) & 63, cg = it & 15; const int t = cc * 64 + sr; const int ch0 = (2 * (rdv) + hq) * DH_ + cg * 8; \
            _Pragma("unroll") for (int j = 0; j < 4; ++j) { uu[i][j] = (u32x4){0u, 0u, 0u, 0u}; if (t - 3 + j >= 0) uu[i][j] = *(const u32x4*)(zb + (size_t)(tok0 + sr - 3 + j) * ZLD_ + ch0); } \
            vv[i] = *(const u32x4*)(zb + (size_t)(tok0 + sr) * ZLD_ + 512 + ch0); } } while (0)
    MX1_LOAD(0);
    for (int rd = 0; rd < 2; ++rd) {
        int tq_ = c.tid; asm volatile("" : "+v"(tq_));
        const int tid = tq_ & 511, lane = tid & 63, fr = lane & 15, fq = lane >> 4;
#pragma unroll
        for (int i = 0; i < 4; ++i) { const int it = tid + i * NT_; const int hq = it >> 10, sr = (it >> 4) & 63, cg = it & 15; const int ch0 = (2 * rd + hq) * DH_ + cg * 8;
            float a[8];
#pragma unroll
            for (int e = 0; e < 8; ++e) a[e] = cb[ch0 + e];
#pragma unroll
            for (int j = 0; j < 4; ++j) { const u32x4 uv = uu[i][j];
                    const float* wj = cw + j * DM_ + ch0;
                    a[0] += wj[0] * bflo(uv.x); a[1] += wj[1] * bfhi(uv.x); a[2] += wj[2] * bflo(uv.y); a[3] += wj[3] * bfhi(uv.y);
                    a[4] += wj[4] * bflo(uv.z); a[5] += wj[5] * bfhi(uv.z); a[6] += wj[6] * bflo(uv.w); a[7] += wj[7] * bfhi(uv.w); }
            u32x4 o; o.x = cvt_pk_bf16(fast_silu(a[0]), fast_silu(a[1])); o.y = cvt_pk_bf16(fast_silu(a[2]), fast_silu(a[3])); o.z = cvt_pk_bf16(fast_silu(a[4]), fast_silu(a[5])); o.w = cvt_pk_bf16(fast_silu(a[6]), fast_silu(a[7]));
            *(LAS u32x4*)(ctile + hq * 16384 + off_b(sr, cg)) = o; *(u32x4*)(cvb + (size_t)(tok0 + sr) * DM_ + ch0) = o;
            *(LAS u32x4*)(vtile + hq * 16384 + off_b(sr, cg)) = vv[i];
        }
        if (rd == 0) MX1_LOAD(1);
        __syncthreads();
        const int h = 2 * rd + hh;
        const LAS unsigned char* ct = ctile + hh * 16384; LAS unsigned char* kt = ktile + hh * 16384; const LAS unsigned char* vt = vtile + hh * 16384;
        if (wq >= 2) {
            f32x4 acc[4][4];
#pragma unroll
            for (int ms = 0; ms < 4; ++ms)
#pragma unroll
                for (int i = 0; i < 4; ++i) acc[ms][i] = (f32x4){0.f, 0.f, 0.f, 0.f};
#pragma unroll
            for (int ks = 0; ks < 4; ++ks) {
                bf16x8 wf[4];
#pragma unroll
                for (int i = 0; i < 4; ++i) wf[i] = ld_frag_g(wqkT + ((size_t)(h * 256 + 16 * (4 * wq + i) + fr)) * DH_ + 32 * ks + 8 * fq);
#pragma unroll
                for (int ms = 0; ms < 4; ++ms) { const bf16x8 cf = tile_row_read(ct, lane, ms, ks);
#pragma unroll
                    for (int i = 0; i < 4; ++i) acc[ms][i] = mfma16(wf[i], cf, acc[ms][i]); }
            }
#pragma unroll
            for (int ms = 0; ms < 4; ++ms) { const int sr = 16 * ms + fr; const float wsv = wsS[h * 64 + sr];
#pragma unroll
                for (int i = 0; i < 4; ++i) { const int nf = 4 * wq + i; const f32x4 v = acc[ms][i];
                    u32x2 o; o.x = cvt_pk_bf16(v[0], v[1]); o.y = cvt_pk_bf16(v[2], v[3]);
                    const f32x4 kr = (f32x4){bflo(o.x), bfhi(o.x), bflo(o.y), bfhi(o.y)};
                    { const int col = 16 * (nf - 8) + 4 * fq;
                        u32x2 o2; o2.x = cvt_pk_bf16(v[0] * wsv, v[1] * wsv); o2.y = cvt_pk_bf16(v[2] * wsv, v[3] * wsv); (void)kr;
                        *(LAS u32x2*)(kt + off_b(sr, col >> 3) + 2 * (col & 7)) = o2; } } }
        }
        __syncthreads();
        {
            f32x4 acc[2][8];
#pragma unroll
            for (int i = 0; i < 2; ++i)
#pragma unroll
                for (int nd = 0; nd < 8; ++nd) acc[i][nd] = (f32x4){0.f, 0.f, 0.f, 0.f};
#pragma unroll
            for (int ks = 0; ks < 2; ++ks) {
                s16x4 va[2][2], kbq[8][2];
                tile_tr_read4(tr_addr(vt, lane, 32 * ks + 8 * fq, 2 * wq), tr_addr(vt, lane, 32 * ks + 8 * fq + 4, 2 * wq), tr_addr(vt, lane, 32 * ks + 8 * fq, 2 * wq + 1), tr_addr(vt, lane, 32 * ks + 8 * fq + 4, 2 * wq + 1),
                              va[0][0], va[0][1], va[1][0], va[1][1]);
#pragma unroll
                for (int nd = 0; nd < 8; nd += 2)
                    tile_tr_read4(tr_addr(kt, lane, 32 * ks + 8 * fq, nd), tr_addr(kt, lane, 32 * ks + 8 * fq + 4, nd), tr_addr(kt, lane, 32 * ks + 8 * fq, nd + 1), tr_addr(kt, lane, 32 * ks + 8 * fq + 4, nd + 1),
                                  kbq[nd][0], kbq[nd][1], kbq[nd + 1][0], kbq[nd + 1][1]);
#pragma unroll
                for (int nd = 0; nd < 8; ++nd) { const bf16x8 kf = cat8(kbq[nd][0], kbq[nd][1]);
#pragma unroll
                    for (int i = 0; i < 2; ++i) acc[i][nd] = mfma16(kf, cat8(va[i][0], va[i][1]), acc[i][nd]); }
            }
            bf16_t* Cp = Csum + ((size_t)((b * H_ + h) * 32 + cc)) * DH_ * DH_;
#pragma unroll
            for (int i = 0; i < 2; ++i)
#pragma unroll
                for (int nd = 0; nd < 8; ++nd) { u32x2 o; o.x = cvt_pk_bf16(acc[i][nd][0], acc[i][nd][1]); o.y = cvt_pk_bf16(acc[i][nd][2], acc[i][nd][3]); *(u32x2*)(Cp + (size_t)(16 * (2 * wq + i) + fr) * DH_ + 16 * nd + 4 * fq) = o; }
            if ((tid & 255) < DH_) { float sacc = 0.f; const int d = tid & 255;
                for (int sr = 0; sr < 64; ++sr) sacc += bf2f(*(const LAS bf16_t*)(kt + off_b(sr, d >> 3) + 2 * (d & 7)));
                nsum[((size_t)((b * H_ + h) * 32 + cc)) * DH_ + d] = sacc; }
        }
        __syncthreads();
    }
}
#undef MX1_LOAD
DI void ph_mix1(PR p, const Ctx& c, int l, LAS unsigned char* lds) {
    for (int unit = c.bid; unit < NB_ * (S_ / 64); unit += c.G) mlstm_sum_unit(p, c, l, unit, lds);
    __syncthreads();
    GroupOrder S; S.A = (const char*)WSP<bf16_t>(p, WS_AS5); S.B = (const char*)(WSP<bf16_t>(p, WS_WET) + (size_t)l * G5_ * 256 * 256); S.astride = (size_t)S5R_ * S5K_ * 2; S.bstride = (size_t)256 * 256 * 2;
    S.lda = S5K_ * 2; S.nunits = G5_ * 4; S.G = c.G; S.c = (c.bid + c.G / 2) % c.G;
    EpiS5E E{WSP<bf16_t>(p, WS_ESUM)};
    gemm_phase<EpiS5E, GroupOrder>(lds, Gemm{(unsigned)(S5K_ * 2), 512u, 256}, S, E);
}

DI void ph_scan(PR p, const Ctx& c, int l, LAS unsigned char* lds) {
    const bf16_t* Csum = WSP<bf16_t>(p, WS_CSUM); const float* nsum = WSP<float>(p, WS_NSUM); const float* gG = WSP<float>(p, WS_GG); const float* mlG = WSP<float>(p, WS_MLG);
    bf16_t* CprevT = WSP<bf16_t>(p, WS_CPREV); float* nprev = WSP<float>(p, WS_NPREV); float* mprev = WSP<float>(p, WS_MPREV);
    const bf16_t* Esum = WSP<bf16_t>(p, WS_ESUM); const float* A16 = WSP<float>(p, WS_A16) + (size_t)l * G5_ * 128; bf16_t* AS5 = WSP<bf16_t>(p, WS_AS5);
    constexpr int NC1 = NB_ * H_ * DH_ * (DH_ / 4), NC2 = NC1 + NB_ * H_ * DH_, NC3 = NC2 + NB_ * G5_ * P5_;
    if (c.w < 4) for (int gid = c.bid * 256 + c.tid; gid < NC3; gid += c.G * 256) {
        if (gid < NC1) {
            const int bh = gid / (DH_ * DH_ / 4), r = gid % (DH_ * DH_ / 4);
            f32x4 C = (f32x4){0.f, 0.f, 0.f, 0.f}; float m = 0.f;
            const size_t base0 = ((size_t)bh * 32) * DH_ * DH_ + (size_t)r * 4;
#pragma unroll 1
            for (int c8 = 0; c8 < 32; c8 += 8) {
                f32x4 cv[8]; float gv[8], mv[8];
#pragma unroll
                for (int k = 0; k < 8; ++k) { const u32x2 cq = *(const u32x2*)(Csum + base0 + (size_t)(c8 + k) * DH_ * DH_); cv[k] = (f32x4){bflo(cq.x), bfhi(cq.x), bflo(cq.y), bfhi(cq.y)}; gv[k] = gG[bh * 32 + c8 + k]; mv[k] = mlG[bh * 32 + c8 + k]; }
#pragma unroll
                for (int k = 0; k < 8; ++k) {
                    u32x2 o; o.x = cvt_pk_bf16(C[0], C[1]); o.y = cvt_pk_bf16(C[2], C[3]); *(u32x2*)(CprevT + base0 + (size_t)(c8 + k) * DH_ * DH_) = o;
                    if (r == 0) mprev[bh * 32 + c8 + k] = m;
                    const float mn = fmaxf(gv[k] + m, mv[k]), so = __expf(gv[k] + m - mn), sn = __expf(mv[k] - mn);
                    C = C * so + cv[k] * sn; m = mn;
                }
            }
        } else if (gid < NC2) {
            const int i = gid - NC1; const int bh = i / DH_, d = i % DH_;
            float n = 0.f, m = 0.f;
#pragma unroll 1
            for (int c8 = 0; c8 < 32; c8 += 8) {
                float nv[8], gv[8], mv[8];
#pragma unroll
                for (int k = 0; k < 8; ++k) { nv[k] = nsum[(size_t)(bh * 32 + c8 + k) * DH_ + d]; gv[k] = gG[bh * 32 + c8 + k]; mv[k] = mlG[bh * 32 + c8 + k]; }
#pragma unroll
                for (int k = 0; k < 8; ++k) {
                    nprev[(size_t)(bh * 32 + c8 + k) * DH_ + d] = n;
                    const float mn = fmaxf(gv[k] + m, mv[k]), so = __expf(gv[k] + m - mn), sn = __expf(mv[k] - mn);
                    n = so * n + sn * nv[k]; m = mn;
                }
            }
        } else {
            const int i = gid - NC2; const int pp = i & 63, g = (i >> 6) & 31, b = i >> 11;
            const float ar = A16[(size_t)g * 128 + pp], ai = A16[(size_t)g * 128 + 64 + pp];
            float xr = 0.f, xi = 0.f;
            const size_t row0 = (size_t)g * S5R_ + b * (S_ / 16);
#pragma unroll 1
            for (int c16 = 0; c16 < S_ / 16; c16 += 16) {
                float er[16], ei[16];
#pragma unroll
                for (int k = 0; k < 16; ++k) { er[k] = bf2f(Esum[(row0 + c16 + k) * 128 + pp]); ei[k] = bf2f(Esum[(row0 + c16 + k) * 128 + 64 + pp]); }
#pragma unroll
                for (int k = 0; k < 16; ++k) { const size_t row = row0 + c16 + k;
                    AS5[row * S5K_ + 256 + pp] = f2bf(xr); AS5[row * S5K_ + 320 + pp] = f2bf(xi);
                    const float nr = ar * xr - ai * xi + er[k], ni = ar * xi + ai * xr + ei[k]; xr = nr; xi = ni; }
            }
        }
    }
    else { moe_weight_jobs(p, c, l, lds); if (MK_REP == 97) moe_weight_jobs(p, c, (l + 2) & 3, lds, true); }
    if (MK_REP == 98) { const size_t gt = (size_t)c.bid * NT_ + c.tid, nth = (size_t)c.G * NT_; bf16_t* dmy = WSP<bf16_t>(p, WS_HB);
        cvt_rows(IN(p, 28) + (size_t)l * NE_ * D_ * DE_, dmy, (size_t)NE_ * D_ * DE_ / 8, gt, nth); cvt_rows(IN(p, 29) + (size_t)l * NE_ * D_ * DE_, dmy + (size_t)NE_ * D_ * DE_, (size_t)NE_ * D_ * DE_ / 8, gt, nth);
        cvt_rows(IN(p, 30) + (size_t)l * NE_ * DE_ * D_, dmy + (size_t)2 * NE_ * D_ * DE_, (size_t)NE_ * DE_ * D_ / 8, gt, nth); }
}

DI void mlstm_out_unit(PR p, const Ctx& c, int l, int unit, LAS unsigned char* lds) {
    LAS unsigned char* vt0 = lds;
    LAS unsigned char* kt0 = lds + 32768;
    LAS unsigned char* ct0 = lds + 65536;
    LAS float* RT = (LAS float*)(lds + 131072);
    LAS float* CT = RT + 128;
    LAS float* INr = CT + 128;
    LAS float* EM = INr + 128;
    LAS float* NP = EM + 128;
    LAS unsigned char* cv0 = ct0;
    LAS unsigned char* qt0 = ct0 + 32768;
    const bf16_t* zb = WSP<bf16_t>(p, WS_ZB); const bf16_t* CprevT = WSP<bf16_t>(p, WS_CPREV);
    const bf16_t* wqkT = WSP<bf16_t>(p, WS_WQK) + (size_t)l * H_ * 256 * DH_; const bf16_t* cvb = WSP<bf16_t>(p, WS_QB);
    const float* nprev = WSP<float>(p, WS_NPREV); const float* mprev = WSP<float>(p, WS_MPREV); const float* igG = WSP<float>(p, WS_IGG); const float* bcumG = WSP<float>(p, WS_BCUM);
    const float* mh_g = IN(p, 9) + (size_t)l * DM_; bf16_t* yb = WSP<bf16_t>(p, WS_YB);
    const int tid = c.tid, lane = c.lane, w = c.w, fr = lane & 15, fq = lane >> 4, hh = w >> 2, nt = w & 3;
    const int b = unit / (S_ / 64), cc = unit % (S_ / 64); const int tok0 = b * S_ + cc * 64;
    u32x4 cp[8], vv[4], cvv[4];
#define MX2_LOADC(rdv) do { _Pragma("unroll") for (int i = 0; i < 8; ++i) { const int it = tid + i * NT_; const int hq = it >> 11, er = (it >> 4) & 127, cg = it & 15; const int bh = b * H_ + 2 * (rdv) + hq; \
            cp[i] = *(const u32x4*)(CprevT + ((size_t)(bh * 32 + cc) * DH_ + er) * DH_ + cg * 8); } } while (0)
#define MX2_LOAD(rdv) do { \
        _Pragma("unroll") for (int i = 0; i < 4; ++i) { const int it = tid + i * NT_; const int hq = it >> 10, sr = (it >> 4) & 63, cg = it & 15; const int ch0 = (2 * (rdv) + hq) * DH_ + cg * 8; \
            cvv[i] = *(const u32x4*)(cvb + (size_t)(tok0 + sr) * DM_ + ch0); } } while (0)
    MX2_LOAD(0);
    for (int rd = 0; rd < 2; ++rd) {
        int tq_ = c.tid; asm volatile("" : "+v"(tq_));
        const int tid = tq_ & 511, lane = tid & 63, fr = lane & 15, fq = lane >> 4;
        __syncthreads();
        MX2_LOADC(rd);
#pragma unroll
        for (int i = 0; i < 4; ++i) { const int it = tid + i * NT_; const int hq = it >> 10, sr = (it >> 4) & 63, cg = it & 15; const int ch0 = (2 * rd + hq) * DH_ + cg * 8;
            vv[i] = *(const u32x4*)(zb + (size_t)(tok0 + sr) * ZLD_ + 512 + ch0); *(LAS u32x4*)(cv0 + hq * 16384 + off_b(sr, cg)) = cvv[i]; }
        if (w < 2) { const int h = 2 * rd + w; const int tok = tok0 + lane; const int bh = b * H_ + h;
            const float ig = igG[(size_t)tok * 4 + h], bc = bcumG[(size_t)tok * 4 + h]; const float rt = ig - bc;
            float pm = rt;
#pragma unroll
            for (int o = 1; o < 64; o <<= 1) { const float t = __shfl_up(pm, o); if (lane >= o) pm = fmaxf(pm, t); }
            const float mp = mprev[bh * 32 + cc]; const float li = bc + mp; const float mt = fmaxf(li, bc + pm);
            RT[w * 64 + lane] = rt; CT[w * 64 + lane] = bc - mt; INr[w * 64 + lane] = __expf(li - mt); EM[w * 64 + lane] = __expf(-mt);
            NP[w * 128 + lane] = nprev[(size_t)(bh * 32 + cc) * DH_ + lane]; NP[w * 128 + 64 + lane] = nprev[(size_t)(bh * 32 + cc) * DH_ + 64 + lane];
        }
        __syncthreads();
        {
            const int h = 2 * rd + hh; const LAS unsigned char* cv = cv0 + hh * 16384; LAS unsigned char* qt = qt0 + hh * 16384; LAS unsigned char* ktw = kt0 + hh * 16384;
            f32x4 acc[4][4];
#pragma unroll
            for (int ms = 0; ms < 4; ++ms)
#pragma unroll
                for (int i = 0; i < 4; ++i) acc[ms][i] = (f32x4){0.f, 0.f, 0.f, 0.f};
#pragma unroll
            for (int ks = 0; ks < 4; ++ks) {
                bf16x8 wf[4];
#pragma unroll
                for (int i = 0; i < 4; ++i) wf[i] = ld_frag_g(wqkT + ((size_t)(h * 256 + 16 * (4 * nt + i) + fr)) * DH_ + 32 * ks + 8 * fq);
#pragma unroll
                for (int ms = 0; ms < 4; ++ms) { const bf16x8 cf = tile_row_read(cv, lane, ms, ks);
#pragma unroll
                    for (int i = 0; i < 4; ++i) acc[ms][i] = mfma16(wf[i], cf, acc[ms][i]); }
            }
#pragma unroll
            for (int ms = 0; ms < 4; ++ms) { const int sr = 16 * ms + fr;
#pragma unroll
                for (int i = 0; i < 4; ++i) { const int nf = 4 * nt + i; const f32x4 v = acc[ms][i];
                    u32x2 o; o.x = cvt_pk_bf16(v[0], v[1]); o.y = cvt_pk_bf16(v[2], v[3]);
                    const int col = 16 * (nf & 7) + 4 * fq;
                    *(LAS u32x2*)((nf < 8 ? qt : ktw) + off_b(sr, col >> 3) + 2 * (col & 7)) = o; } }
        }
        __syncthreads();
        {
            const int h = 2 * rd + hh; const LAS unsigned char* vt = vt0 + hh * 16384; const LAS unsigned char* kt = kt0 + hh * 16384; const LAS unsigned char* ct = ct0 + hh * 32768;
            const int trow = 16 * nt + fr;
            bf16x8 qf[4];
#pragma unroll
            for (int ks = 0; ks < 4; ++ks) qf[ks] = tile_row_read(qt0 + hh * 16384, lane, nt, ks);
            __syncthreads();
#pragma unroll
            for (int i = 0; i < 8; ++i) { const int it = tid + i * NT_; const int hq = it >> 11, er = (it >> 4) & 127, cg = it & 15; *(LAS u32x4*)(ct0 + hq * 32768 + off_b(er, cg)) = cp[i]; }
#pragma unroll
            for (int i = 0; i < 4; ++i) { const int it = tid + i * NT_; const int hq = it >> 10, sr = (it >> 4) & 63, cg = it & 15; *(LAS u32x4*)(vt0 + hq * 16384 + off_b(sr, cg)) = vv[i]; }
            if (rd == 0) MX2_LOAD(1);
            __syncthreads();
            f32x4 Sf[4];
#pragma unroll
            for (int ms = 0; ms < 4; ++ms) { Sf[ms] = (f32x4){0.f, 0.f, 0.f, 0.f};
                if (ms <= nt) {
#pragma unroll
                    for (int ks = 0; ks < 4; ++ks) Sf[ms] = mfma16(tile_row_read(kt, lane, ms, ks), qf[ks], Sf[ms]);
                } }
            const float ct_ = CT[hh * 64 + trow];
            float dsum = 0.f;
#pragma unroll
            for (int ms = 0; ms < 4; ++ms)
#pragma unroll
                for (int r = 0; r < 4; ++r) { const int sr = 16 * ms + 4 * fq + r; float v = 0.f;
                    if (ms <= nt && sr <= trow) v = Sf[ms][r] * __expf(RT[hh * 64 + sr] + ct_);
                    Sf[ms][r] = v; dsum += v; }
            dsum += __shfl_xor(dsum, 16); dsum += __shfl_xor(dsum, 32);
            float qn = 0.f;
#pragma unroll
            for (int ks = 0; ks < 4; ++ks)
#pragma unroll
                for (int j = 0; j < 8; ++j) qn += bf2f((bf16_t)qf[ks][j]) * NP[hh * 128 + 32 * ks + 8 * fq + j];
            qn += __shfl_xor(qn, 16); qn += __shfl_xor(qn, 32);
            const float inter = INr[hh * 64 + trow];
            float den = dsum + inter * qn; den = fmaxf(fabsf(den), EM[hh * 64 + trow]); const float rden = __builtin_amdgcn_rcpf(den);
            bf16x8 Pf[2];
#pragma unroll
            for (int k2 = 0; k2 < 2; ++k2) { u32x4 pk; pk.x = cvt_pk_bf16(Sf[2 * k2][0], Sf[2 * k2][1]); pk.y = cvt_pk_bf16(Sf[2 * k2][2], Sf[2 * k2][3]);
                pk.z = cvt_pk_bf16(Sf[2 * k2 + 1][0], Sf[2 * k2 + 1][1]); pk.w = cvt_pk_bf16(Sf[2 * k2 + 1][2], Sf[2 * k2 + 1][3]); Pf[k2] = __builtin_bit_cast(bf16x8, pk); }
            float hv[8][4]; float ssum = 0.f;
#pragma unroll
            for (int me = 0; me < 8; ++me) {
                f32x4 a1 = (f32x4){0.f, 0.f, 0.f, 0.f}, a2 = (f32x4){0.f, 0.f, 0.f, 0.f};
                s16x4 v0, v1, v2, v3;
                tile_tr_read4(tr_addr(vt, lane, 4 * fq, me), tr_addr(vt, lane, 16 + 4 * fq, me), tr_addr(vt, lane, 32 + 4 * fq, me), tr_addr(vt, lane, 48 + 4 * fq, me), v0, v1, v2, v3);
#pragma unroll
                for (int ks = 0; ks < 4; ++ks) a2 = mfma16(tile_row_read(ct, lane, me, ks), qf[ks], a2);
                a1 = mfma16(cat8(v0, v1), Pf[0], a1);
                if (nt >= 2) a1 = mfma16(cat8(v2, v3), Pf[1], a1);
                const u32x2 og = *(const u32x2*)(zb + (size_t)(tok0 + trow) * ZLD_ + 1024 + h * DH_ + 16 * me + 4 * fq);
                hv[me][0] = (a1[0] + inter * a2[0]) * rden * fast_sigmoid(bflo(og.x)); hv[me][1] = (a1[1] + inter * a2[1]) * rden * fast_sigmoid(bfhi(og.x));
                hv[me][2] = (a1[2] + inter * a2[2]) * rden * fast_sigmoid(bflo(og.y)); hv[me][3] = (a1[3] + inter * a2[3]) * rden * fast_sigmoid(bfhi(og.y));
                ssum += (hv[me][0] + hv[me][1]) + (hv[me][2] + hv[me][3]);
            }
            ssum += __shfl_xor(ssum, 16); ssum += __shfl_xor(ssum, 32);
            const float mu = ssum * (1.f / DH_); float qv = 0.f;
#pragma unroll
            for (int me = 0; me < 8; ++me)
#pragma unroll
                for (int r = 0; r < 4; ++r) { const float d0 = hv[me][r] - mu; qv += d0 * d0; }
            qv += __shfl_xor(qv, 16); qv += __shfl_xor(qv, 32);
            const float rstd = rsqrtf(qv * (1.f / DH_) + EPS_);
#pragma unroll
            for (int me = 0; me < 8; ++me) { const int e0 = h * DH_ + 16 * me + 4 * fq; const f32x4 gg = *(const f32x4*)(mh_g + e0);
                u32x2 o; o.x = cvt_pk_bf16((hv[me][0] - mu) * rstd * gg[0], (hv[me][1] - mu) * rstd * gg[1]); o.y = cvt_pk_bf16((hv[me][2] - mu) * rstd * gg[2], (hv[me][3] - mu) * rstd * gg[3]);
                *(u32x2*)(yb + (size_t)(tok0 + trow) * D_ + DM_ + e0) = o; }
        }
    }
}
#undef MX2_LOAD
#undef MX2_LOADC
DI void ph_mix2(PR p, const Ctx& c, int l, LAS unsigned char* lds) {
    for (int unit = c.bid; unit < NB_ * (S_ / 64); unit += c.G) mlstm_out_unit(p, c, l, unit, lds);
    __syncthreads();
    GroupOrder S; S.A = (const char*)WSP<bf16_t>(p, WS_AS5); S.B = (const char*)(WSP<bf16_t>(p, WS_WYT) + (size_t)l * G5_ * 256 * S5K_); S.astride = (size_t)S5R_ * S5K_ * 2; S.bstride = (size_t)256 * S5K_ * 2;
    S.lda = S5K_ * 2; S.nunits = G5_ * 4; S.G = c.G; S.c = (c.bid + c.G / 2) % c.G;
    EpiS5Y E{WSP<bf16_t>(p, WS_GYB)};
    gemm_phase<EpiS5Y, GroupOrder>(lds, Gemm{(unsigned)(S5K_ * 2), (unsigned)(S5K_ * 2), S5K_}, S, E);
}

DI void ph_glu(PR p, const Ctx& c, int l, LAS unsigned char* lds) {
    const int hg = c.G / 2;
    if (c.bid < hg) {
        DenseOrder S; S.init(WSP<bf16_t>(p, WS_GYB), WSP<bf16_t>(p, WS_WGLU) + (size_t)l * DM_ * DM_, DM_ * 2, DM_ * 2, M_, DM_, hg, c.bid);
        EpiGlu E{WSP<bf16_t>(p, WS_GYB), IN(p, 19) + (size_t)l * DM_, WSP<bf16_t>(p, WS_YB), WSP<float>(p, WS_SSQS)};
        gemm_phase<EpiGlu, DenseOrder>(lds, Gemm{(unsigned)(DM_ * 2), (unsigned)(DM_ * 2), DM_}, S, E);
    } else {
        DenseOrder S2; S2.init(WSP<bf16_t>(p, WS_PBF) + (size_t)l * M_ * PLE_, WSP<bf16_t>(p, WS_WPP) + (size_t)l * D_ * PLE_, PLE_ * 2, PLE_ * 2, M_, D_, c.G - hg, c.bid - hg);
        EpiT E2{WSP<bf16_t>(p, WS_TB), WSP<float>(p, WS_SSQT)};
        gemm_phase<EpiT, DenseOrder>(lds, Gemm{(unsigned)(PLE_ * 2), (unsigned)(PLE_ * 2), PLE_}, S2, E2);
    }
}
DI void ph_outproj(PR p, const Ctx& c, int l, LAS unsigned char* lds) {
    DenseOrder S; S.init(WSP<bf16_t>(p, WS_YB), WSP<bf16_t>(p, WS_WOUT) + (size_t)l * D_ * D_, D_ * 2, D_ * 2, M_, D_, c.G, c.bid);
    EpiOutLn E{WSP<bf16_t>(p, WS_XB), WSP<float>(p, WS_SSQS), WSP<bf16_t>(p, WS_GHL) + (size_t)l * 2 * 48 * D_, WSP<float>(p, WS_RTC) + l * 80, IN(p, 22) + (size_t)l * D_, IN(p, 23) + (size_t)l * D_,
               WSP<float>(p, WS_XCH), WSP<unsigned>(p, WS_LNC) + (size_t)l * 64 * 16, WSP<bf16_t>(p, WS_X1B), WSP<unsigned char>(p, WS_X1Q),
               WSP<unsigned>(p, WS_CUR) + (size_t)l * NE_ * 16, WSP<int>(p, WS_BUFT), WSP<float>(p, WS_BUFW), WSP<int>(p, WS_SLOT)};
    gemm_phase<EpiOutLn, DenseOrder>(lds, Gemm{(unsigned)(D_ * 2), (unsigned)(D_ * 2), D_}, S, E);
}
DI void ph_route(PR p, const Ctx& c, int l, LAS unsigned char* lds, bool dry = false) {
    LAS int* cntL = (LAS int*)lds; LAS int* baseL = cntL + 32; LAS int* tokE = baseL + 32; LAS float* tokW = (LAS float*)(tokE + 128);
    const float* logits = WSP<float>(p, WS_LOGIT);
    unsigned* cur = WSP<unsigned>(p, WS_CUR) + (size_t)(l + (dry ? L_ : 0)) * NE_ * 16; int* buf_t = WSP<int>(p, WS_BUFT); float* buf_w = WSP<float>(p, WS_BUFW); int* slot_of = WSP<int>(p, WS_SLOT);
    const int tid = c.tid;
    __syncthreads();
    if (tid < 32) cntL[tid] = 0;
    __syncthreads();
    for (int unit = c.bid; unit < M_ / 64; unit += c.G) {
        if (tid < 64) { const float* lg = logits + (size_t)(unit * 64 + tid) * 40;
            const f32x4 gl = *(const f32x4*)lg; float mx = gl[0]; int gi = 0;
#pragma unroll
            for (int i = 1; i < 4; ++i) if (gl[i] > mx) { mx = gl[i]; gi = i; }
            float se = 0.f;
#pragma unroll
            for (int i = 0; i < 4; ++i) se += expf(gl[i] - mx);
            const float pg = 1.0f / se;
            const f32x4 e0 = *(const f32x4*)(lg + 4 + gi * 8), e1 = *(const f32x4*)(lg + 8 + gi * 8);
            float ev[8];
#pragma unroll
            for (int i = 0; i < 4; ++i) { ev[i] = e0[i]; ev[4 + i] = e1[i]; }
            int i0 = 0;
#pragma unroll
            for (int i = 1; i < 8; ++i) if (ev[i] > ev[i0]) i0 = i;
            int i1 = (i0 == 0) ? 1 : 0;
#pragma unroll
            for (int i = 0; i < 8; ++i) if (i != i0 && ev[i] > ev[i1]) i1 = i;
            const float e1x = expf(ev[i1] - ev[i0]); const float w0 = 1.f / (1.f + e1x), w1 = e1x / (1.f + e1x);
            const int ea = gi * 8 + i0, eb = gi * 8 + i1;
            const int ra = atomicAdd((int*)&cntL[ea], 1), rb = atomicAdd((int*)&cntL[eb], 1);
            tokE[tid * 2] = (ea << 16) | ra; tokE[tid * 2 + 1] = (eb << 16) | rb; tokW[tid * 2] = pg * w0; tokW[tid * 2 + 1] = pg * w1;
        }
        __syncthreads();
        if (tid < 32) baseL[tid] = cntL[tid] ? (int)atomicAdd(&cur[tid * 16], (unsigned)cntL[tid]) : 0;
        __syncthreads();
        if (tid < 128 && !dry) { const int v = tokE[tid]; const int e = v >> 16, r = baseL[e] + (v & 0xffff); const int token = unit * 64 + (tid >> 1);
            buf_t[(size_t)e * ECAP_ + r] = token; buf_w[(size_t)e * ECAP_ + r] = tokW[tid]; slot_of[token * 2 + (tid & 1)] = (e << 16) | r; }
        __syncthreads();
        if (tid < 32) cntL[tid] = 0;
        __syncthreads();
    }
}

DI void treduce16(float (&a)[16], int lane) {
#pragma unroll
    for (int i = 0; i < 8; ++i) { const bool hi = lane & 32; const float send = hi ? a[i] : a[i + 8], keep = hi ? a[i + 8] : a[i]; a[i] = keep + __shfl_xor(send, 32); }
#pragma unroll
    for (int i = 0; i < 4; ++i) { const bool hi = lane & 16; const float send = hi ? a[i] : a[i + 4], keep = hi ? a[i + 4] : a[i]; a[i] = keep + __shfl_xor(send, 16); }
#pragma unroll
    for (int i = 0; i < 2; ++i) { const bool hi = lane & 8; const float send = hi ? a[i] : a[i + 2], keep = hi ? a[i + 2] : a[i]; a[i] = keep + __shfl_xor(send, 8); }
    { const bool hi = lane & 4; const float send = hi ? a[0] : a[1], keep = hi ? a[1] : a[0]; a[0] = keep + __shfl_xor(send, 4); }
    a[0] += __shfl_xor(a[0], 2); a[0] += __shfl_xor(a[0], 1);
}
DI void ph_router(PR p, const Ctx& c, int l, LAS unsigned char* lds, bool dry = false) {
    LAS float* W = (LAS float*)lds;
    LAS float* LG = (LAS float*)(lds + 147456);
    LAS int* cntL = (LAS int*)(lds + 147456 + 9216);
    LAS int* baseL = cntL + 32;
    LAS int* tokE = baseL + 32;
    LAS float* tokW = (LAS float*)(tokE + 128);
    const float* b_grp = IN(p, 25) + l * 4; const float* b_rt = IN(p, 27) + l * 32;
    const float* ln_g = IN(p, 22) + (size_t)l * D_; const float* ln_b = IN(p, 23) + (size_t)l * D_;
    const bf16_t* r1 = WSP<bf16_t>(p, WS_X2B); bf16_t* x1b = WSP<bf16_t>(p, WS_X1B); unsigned char* x1q = WSP<unsigned char>(p, WS_X1Q);
    unsigned* cur = WSP<unsigned>(p, WS_CUR) + (size_t)(l + (dry ? L_ : 0)) * NE_ * 16; int* buf_t = WSP<int>(p, WS_BUFT); float* buf_w = WSP<float>(p, WS_BUFW); int* slot_of = WSP<int>(p, WS_SLOT);
    const int tid = c.tid, lane = c.lane, w = c.w;
    __syncthreads();
    { const f32x4* wsrc = (const f32x4*)(WSP<float>(p, WS_WRT) + (size_t)l * 36 * D_); for (int idx = tid; idx < 36 * D_ / 4; idx += NT_) ((LAS f32x4*)W)[idx] = wsrc[idx]; }
    if (tid < 32) cntL[tid] = 0;
    __syncthreads();
    for (int unit = c.bid; unit < M_ / 64; unit += c.G) {
#pragma unroll 1
        for (int half = 0; half < 2; ++half) {
        const int tokb = unit * 64 + w * 8 + half * 4;
        f32x4 xv[4][4];
#pragma unroll
        for (int tk = 0; tk < 4; ++tk) { const bf16_t* rin = r1 + (size_t)(tokb + tk) * D_; float s = 0.f;
#pragma unroll
            for (int j = 0; j < 4; ++j) { const u32x2 rv = ((const u32x2*)rin)[lane + 64 * j]; xv[tk][j] = (f32x4){bflo(rv.x), bfhi(rv.x), bflo(rv.y), bfhi(rv.y)}; s += (xv[tk][j][0] + xv[tk][j][1]) + (xv[tk][j][2] + xv[tk][j][3]); }
            const float mu = wave_sum(s) * (1.f / D_); float qv = 0.f;
#pragma unroll
            for (int j = 0; j < 4; ++j) { xv[tk][j] = xv[tk][j] - mu; qv += (xv[tk][j][0] * xv[tk][j][0] + xv[tk][j][1] * xv[tk][j][1]) + (xv[tk][j][2] * xv[tk][j][2] + xv[tk][j][3] * xv[tk][j][3]); }
            const float rstd = rsqrtf(wave_sum(qv) * (1.f / D_) + EPS_);
#pragma unroll
            for (int j = 0; j < 4; ++j) { const f32x4 gg = ((const f32x4*)ln_g)[lane + 64 * j], bb = ((const f32x4*)ln_b)[lane + 64 * j];
                xv[tk][j] = xv[tk][j] * rstd * gg + bb;
                u32x2 o; o.x = cvt_pk_bf16(xv[tk][j][0], xv[tk][j][1]); o.y = cvt_pk_bf16(xv[tk][j][2], xv[tk][j][3]); ((u32x2*)(x1b + (size_t)(tokb + tk) * D_))[lane + 64 * j] = o;
                ((unsigned*)(x1q + (size_t)(tokb + tk) * D_))[lane + 64 * j] = pack4_fp8(xv[tk][j][0], xv[tk][j][1], xv[tk][j][2], xv[tk][j][3]); }
        }
        f32x2_ xq[2][4][4];
#pragma unroll
        for (int tp = 0; tp < 2; ++tp)
#pragma unroll
            for (int j = 0; j < 4; ++j)
#pragma unroll
                for (int e = 0; e < 4; ++e) xq[tp][j][e] = (f32x2_){xv[2 * tp][j][e], xv[2 * tp + 1][j][e]};
#pragma unroll 1
        for (int ob = 0; ob < 9; ++ob) {
            f32x2_ a2[2][4];
#pragma unroll
            for (int tp = 0; tp < 2; ++tp)
#pragma unroll
                for (int oo = 0; oo < 4; ++oo) a2[tp][oo] = (f32x2_){0.f, 0.f};
#pragma unroll
            for (int oo = 0; oo < 4; ++oo)
#pragma unroll
                for (int j = 0; j < 4; ++j) { const f32x4 wv = ((const LAS f32x4*)W)[(4 * ob + oo) * 256 + lane + 64 * j];
#pragma unroll
                    for (int e = 0; e < 4; ++e) { const f32x2_ wb = (f32x2_){wv[e], wv[e]};
                        a2[0][oo] = __builtin_elementwise_fma(xq[0][j][e], wb, a2[0][oo]); a2[1][oo] = __builtin_elementwise_fma(xq[1][j][e], wb, a2[1][oo]); } }
            float part[16];
#pragma unroll
            for (int tp = 0; tp < 2; ++tp)
#pragma unroll
                for (int oo = 0; oo < 4; ++oo) { part[(2 * tp) * 4 + oo] = a2[tp][oo][0]; part[(2 * tp + 1) * 4 + oo] = a2[tp][oo][1]; }
            treduce16(part, lane);
            if ((lane & 3) == 0) { const int idx = lane >> 2; LG[(w * 8 + half * 4 + (idx >> 2)) * 36 + 4 * ob + (idx & 3)] = part[0]; }
        }
        }
        __builtin_amdgcn_s_waitcnt(0xC07F); __builtin_amdgcn_wave_barrier();
        if (lane < 8) { const LAS float* lg = LG + (w * 8 + lane) * 36;
            float gl[4]; float mx = -1e30f; int gi = 0;
#pragma unroll
            for (int i = 0; i < 4; ++i) { gl[i] = lg[i] + b_grp[i]; if (gl[i] > mx) { mx = gl[i]; gi = i; } }
            float se = 0.f;
#pragma unroll
            for (int i = 0; i < 4; ++i) se += expf(gl[i] - mx);
            const float pg = 1.0f / se;
            float ev[8];
#pragma unroll
            for (int i = 0; i < 8; ++i) ev[i] = lg[4 + gi * 8 + i] + b_rt[gi * 8 + i];
            int i0 = 0;
#pragma unroll
            for (int i = 1; i < 8; ++i) if (ev[i] > ev[i0]) i0 = i;
            int i1 = (i0 == 0) ? 1 : 0;
#pragma unroll
            for (int i = 0; i < 8; ++i) if (i != i0 && ev[i] > ev[i1]) i1 = i;
            const float e1 = expf(ev[i1] - ev[i0]); const float w0 = 1.f / (1.f + e1), w1 = e1 / (1.f + e1);
            const int ea = gi * 8 + i0, eb = gi * 8 + i1;
            const int ra = atomicAdd((int*)&cntL[ea], 1), rb = atomicAdd((int*)&cntL[eb], 1);
            tokE[(w * 8 + lane) * 2] = (ea << 16) | ra; tokE[(w * 8 + lane) * 2 + 1] = (eb << 16) | rb; tokW[(w * 8 + lane) * 2] = pg * w0; tokW[(w * 8 + lane) * 2 + 1] = pg * w1;
        }
        __syncthreads();
        if (tid < 32) baseL[tid] = cntL[tid] ? (int)atomicAdd(&cur[tid * 16], (unsigned)cntL[tid]) : 0;
        __syncthreads();
        if (tid < 128 && !dry) { const int v = tokE[tid]; const int e = v >> 16, r = baseL[e] + (v & 0xffff); const int token = unit * 64 + (tid >> 1);
            buf_t[(size_t)e * ECAP_ + r] = token; buf_w[(size_t)e * ECAP_ + r] = tokW[tid]; slot_of[token * 2 + (tid & 1)] = (e << 16) | r; }
        __syncthreads();
        if (tid < 32) cntL[tid] = 0;
        __syncthreads();
    }
}

DI void moe_tables(PR p, const Ctx& c, int l, LAS int* cnt, LAS int* tbase) {
    unsigned* cur = WSP<unsigned>(p, WS_CUR) + (size_t)l * NE_ * 16;
    __syncthreads();
    if (c.tid < 32) cnt[c.tid] = (int)xb_ld(&cur[c.tid * 16]);
    __syncthreads();
    if (c.tid == 0) { int run = 0; for (int e = 0; e < 32; ++e) { tbase[e] = run; run += (cnt[e] + 255) >> 8; } tbase[32] = run; }
    __syncthreads();
}
DI void ph_moe(PR p, const Ctx& c, int l, LAS unsigned char* lds, bool dry = false) {
    LAS int* cnt = (LAS int*)(lds + STAGE_BYTES); LAS int* tbase = cnt + 32;
    moe_tables(p, c, l, cnt, tbase);
    unsigned* done = WSP<unsigned>(p, WS_DONE) + (size_t)(l + (dry ? L_ : 0)) * MT_ * 16;
    const int nu = tbase[32] * 4;
    {
        MoeOrder<true> S; S.A = (const char*)WSP<unsigned char>(p, WS_X1Q); S.B = (const char*)WSP<unsigned char>(p, WS_WGU); S.lda = D_; S.ldb = D_; S.bstride = (size_t)D_ * D_;
        S.tbase = tbase; S.cnt = cnt; S.buf_t = WSP<int>(p, WS_BUFT); S.done = done; S.nunits = nu; S.G = c.G; S.c = c.bid; S.n3 = 0; S.nb = 0;
        EpiSiluMul E{WSP<unsigned char>(p, WS_HB), done};
        gemm_phase<EpiSiluMul, MoeOrder<true>>(lds, Gemm{(unsigned)D_, (unsigned)D_, D_ / 2}, S, E);
    }
    __syncthreads();
    {
        MoeOrder<false> S; S.A = (const char*)WSP<unsigned char>(p, WS_HB); S.B = (const char*)WSP<unsigned char>(p, WS_WED); S.lda = DE_; S.ldb = DE_; S.bstride = (size_t)D_ * DE_;
        S.tbase = tbase; S.cnt = cnt; S.buf_t = WSP<int>(p, WS_BUFT); S.done = done; S.nunits = nu; S.G = c.G; S.c = c.bid;
        { const int maxups = (nu + c.G - 1) / c.G; S.n3 = (nu % c.G) ? nu - (maxups - 1) * c.G : c.G; S.nb = (c.G - S.n3) < nu ? (c.G - S.n3) : nu; }
        EpiDown E{WSP<unsigned char>(p, WS_YE), WSP<float>(p, WS_BUFW), cnt};
        gemm_phase<EpiDown, MoeOrder<false>>(lds, Gemm{(unsigned)DE_, (unsigned)DE_, DE_ / 2}, S, E);
    }
}
DI void ph_ln2(PR p, const Ctx& c, int l, LAS unsigned char* lds) {
    LAS int* cnt = (LAS int*)(lds + STAGE_BYTES); LAS int* tbase = cnt + 32;
    moe_tables(p, c, l, cnt, tbase);
    const bf16_t* x1b = WSP<bf16_t>(p, WS_X1B); const unsigned char* ye = WSP<unsigned char>(p, WS_YE); const int* slot_of = WSP<int>(p, WS_SLOT);
    const float* ln_g = IN(p, 31) + (size_t)l * D_; const float* ln_b = IN(p, 32) + (size_t)l * D_; bf16_t* x2b = WSP<bf16_t>(p, WS_X2B);
    const int lane = c.lane;
    const float* ssqT = WSP<float>(p, WS_SSQT); float* rstdT = WSP<float>(p, WS_RSTDT);
    for (int tok = c.bid * 8 + c.w; tok < M_; tok += c.G * 8) {
        { float tq = (lane < 16) ? ssqT[(size_t)tok * 16 + lane] : 0.f; tq += __shfl_xor(tq, 8); tq += __shfl_xor(tq, 4); tq += __shfl_xor(tq, 2); tq += __shfl_xor(tq, 1);
          if (lane == 0) rstdT[tok] = rsqrtf(tq * (1.f / D_) + EPS_); }
        const int s0 = slot_of[tok * 2], s1 = slot_of[tok * 2 + 1];
        const size_t r0 = ((size_t)(tbase[s0 >> 16] + ((s0 & 0xffff) >> 8)) * 256 + (s0 & 255)) * D_, r1 = ((size_t)(tbase[s1 >> 16] + ((s1 & 0xffff) >> 8)) * 256 + (s1 & 255)) * D_;
        f32x4 v[4]; float s = 0.f;
#pragma unroll
        for (int j = 0; j < 4; ++j) { const u32x2 xr = ((const u32x2*)(x1b + (size_t)tok * D_))[lane + 64 * j]; const f32x4 xv = (f32x4){bflo(xr.x), bfhi(xr.x), bflo(xr.y), bfhi(xr.y)};
            const int a = ((const int*)(ye + r0))[lane + 64 * j], bq = ((const int*)(ye + r1))[lane + 64 * j];
            v[j][0] = ALPHA_ * xv[0] + YE_INV * (__builtin_amdgcn_cvt_f32_fp8(a, 0) + __builtin_amdgcn_cvt_f32_fp8(bq, 0)); v[j][1] = ALPHA_ * xv[1] + YE_INV * (__builtin_amdgcn_cvt_f32_fp8(a, 1) + __builtin_amdgcn_cvt_f32_fp8(bq, 1));
            v[j][2] = ALPHA_ * xv[2] + YE_INV * (__builtin_amdgcn_cvt_f32_fp8(a, 2) + __builtin_amdgcn_cvt_f32_fp8(bq, 2)); v[j][3] = ALPHA_ * xv[3] + YE_INV * (__builtin_amdgcn_cvt_f32_fp8(a, 3) + __builtin_amdgcn_cvt_f32_fp8(bq, 3));
            s += (v[j][0] + v[j][1]) + (v[j][2] + v[j][3]); }
        const float mu = wave_sum(s) * (1.f / D_); float qv = 0.f;
#pragma unroll
        for (int j = 0; j < 4; ++j) { v[j] = v[j] - mu; qv += (v[j][0] * v[j][0] + v[j][1] * v[j][1]) + (v[j][2] * v[j][2] + v[j][3] * v[j][3]); }
        const float rstd = rsqrtf(wave_sum(qv) * (1.f / D_) + EPS_);
#pragma unroll
        for (int j = 0; j < 4; ++j) { const f32x4 gg = ((const f32x4*)ln_g)[lane + 64 * j], bb = ((const f32x4*)ln_b)[lane + 64 * j]; const f32x4 o = v[j] * rstd * gg + bb;
            u32x2 ob; ob.x = cvt_pk_bf16(o[0], o[1]); ob.y = cvt_pk_bf16(o[2], o[3]); ((u32x2*)(x2b + (size_t)tok * D_))[lane + 64 * j] = ob; }
    }
}
DI void ph_ple(PR p, const Ctx& c, int l, LAS unsigned char* lds) {
    DenseOrder S; S.init(WSP<bf16_t>(p, WS_X2B), WSP<bf16_t>(p, WS_WPG) + (size_t)l * D_ * D_, D_ * 2, D_ * 2, M_, D_, c.G, c.bid);
    EpiPle E{WSP<bf16_t>(p, WS_X2B), WSP<bf16_t>(p, WS_TB), WSP<float>(p, WS_RSTDT), IN(p, 34) + (size_t)l * D_, IN(p, 36) + (size_t)l * D_, (l == L_ - 1) ? p.out : (float*)nullptr, WSP<bf16_t>(p, WS_XB)};
    gemm_phase<EpiPle, DenseOrder>(lds, Gemm{(unsigned)(D_ * 2), (unsigned)(D_ * 2), D_}, S, E);
}

DI Ctx mk_ctx() { Ctx c; int t = threadIdx.x; asm volatile("" : "+v"(t)); t &= 511; int g = gridDim.x, b = blockIdx.x; asm volatile("" : "+s"(g), "+s"(b)); c.G = g; c.bid = b; c.tid = t; c.lane = t & 63; c.w = __builtin_amdgcn_readfirstlane(t >> 6); return c; }

DI PR getP() { const __attribute__((address_space(4))) P* q = (const __attribute__((address_space(4))) P*)__builtin_amdgcn_kernarg_segment_ptr(); asm volatile("" : "+s"(q)); return *q; }
template <int PH> DI void run_phase(int l, LAS unsigned char* lds0) {
    unsigned la = (unsigned)(size_t)lds0; asm volatile("" : "+s"(la)); LAS unsigned char* lds = (LAS unsigned char*)(size_t)la;
    PR p = getP(); const Ctx c = mk_ctx();
    if constexpr (PH == 0) ph_prologue(p, c, lds);
    if constexpr (PH >= 200 && PH < 216) ph_prologue(p, c, lds, PH - 200);
    if constexpr (PH == 1) ph_inproj(p, c, l, lds);
    if constexpr (PH == 2) ph_mix1(p, c, l, lds);
    if constexpr (PH == 3) ph_scan(p, c, l, lds);
    if constexpr (PH == 4) ph_mix2(p, c, l, lds);
    if constexpr (PH == 5) ph_glu(p, c, l, lds);
    if constexpr (PH == 6) ph_outproj(p, c, l, lds);
    if constexpr (PH == 7) ph_route(p, c, l, lds, false);
    if constexpr (PH == 107) ph_route(p, c, l, lds, true);
    if constexpr (PH == 8) ph_moe(p, c, l, lds, false);
    if constexpr (PH == 108) ph_moe(p, c, l, lds, true);
    if constexpr (PH == 10) ph_ln2(p, c, l, lds);
    if constexpr (PH == 11) ph_ple(p, c, l, lds);
}
DI void grid_bar(LAS unsigned char* lds) {
    PR p = getP();
    XcdBarrier b; b.bar = WSP<unsigned>(p, WS_BAR); b.x = xb_xcc_id(); b.st = (volatile LAS unsigned*)(lds + LDS_BYTES - 16);
    xcd_barrier(b);
}

#if MK_MULTI
template <int PH> __global__ __launch_bounds__(512, 2) void k_phase(P p, int l) {
    extern __shared__ __attribute__((aligned(16))) unsigned char smem[];
    (void)p;
    run_phase<PH>(l, (LAS unsigned char*)smem);
}
#else
__global__ __launch_bounds__(512, 2) void k_fwd(P p) {
    extern __shared__ __attribute__((aligned(16))) unsigned char smem[];
    LAS unsigned char* lds = (LAS unsigned char*)smem;
    volatile LAS unsigned* bst = (volatile LAS unsigned*)(lds + LDS_BYTES - 16);
    if (threadIdx.x < 4) bst[threadIdx.x] = 0u;
    __syncthreads();
    (void)xcd_barrier_post((unsigned*)(p.ws + WS_BAR), bst);
    run_phase<0>(0, lds); grid_bar(lds);
    if (MK_REP == 0) { run_phase<0>(0, lds); grid_bar(lds); }
    if (MK_REP >= 200 && MK_REP < 216) { run_phase<(MK_REP >= 200 && MK_REP < 216) ? MK_REP : 200>(0, lds); grid_bar(lds); }
#define MK_PH(k, l) do { run_phase<k>(l, lds); if (MK_REP == k) { grid_bar(lds); run_phase<(k == 7 ? 107 : k == 8 ? 108 : k)>(l, lds); } } while (0)
#define MK_LAYER(l, lastbar) do { MK_PH(1, l); grid_bar(lds); MK_PH(2, l); grid_bar(lds); MK_PH(3, l); grid_bar(lds); MK_PH(4, l); grid_bar(lds); \
        MK_PH(5, l); grid_bar(lds); MK_PH(6, l); grid_bar(lds); MK_PH(8, l); grid_bar(lds); \
        MK_PH(10, l); grid_bar(lds); MK_PH(11, l); if (lastbar) grid_bar(lds); if (MK_REP == 99) { for (int q_ = 0; q_ < 10; ++q_) grid_bar(lds); } } while (0)
    MK_LAYER(0, true); MK_LAYER(1, true); MK_LAYER(2, true); MK_LAYER(3, false);
#undef MK_LAYER
#undef MK_PH
}
#endif
}

#if MK_MULTI
template <int PH> static void launch_phase(const P& p, int l, int grid, hipStream_t st) {
    static bool attr_set = false;
    if (!attr_set) { (void)hipFuncSetAttribute((const void*)k_phase<PH>, hipFuncAttributeMaxDynamicSharedMemorySize, LDS_BYTES); attr_set = true; }
    hipLaunchKernelGGL(k_phase<PH>, dim3(grid), dim3(NT_), LDS_BYTES, st, p, l);
}
#endif

extern "C" void kernel_launch(void* const* d_in, const int* in_sizes, int n_in, void* d_out, int out_size, void* d_ws, size_t ws_size, hipStream_t stream) {
    (void)in_sizes; (void)n_in; (void)out_size; (void)ws_size;
    static int grid = 0;
    if (grid == 0) { int dev = 0, cus = 0; (void)hipGetDevice(&dev); (void)hipDeviceGetAttribute(&cus, hipDeviceAttributeMultiprocessorCount, dev); grid = cus > 0 ? cus : 256; }
    P p{};
    for (int i = 0; i < 37; ++i) p.in[i] = (const float*)d_in[i];
    p.out = (float*)d_out; p.ws = (unsigned char*)d_ws;
    (void)hipMemsetAsync(d_ws, 0, WS_CTL_END, stream);
#if MK_MULTI
    launch_phase<0>(p, 0, grid, stream);
    for (int l = 0; l < L_; ++l) {
        launch_phase<1>(p, l, grid, stream); launch_phase<2>(p, l, grid, stream); launch_phase<3>(p, l, grid, stream); launch_phase<4>(p, l, grid, stream);
        launch_phase<5>(p, l, grid, stream); launch_phase<6>(p, l, grid, stream); launch_phase<8>(p, l, grid, stream);
        launch_phase<10>(p, l, grid, stream); launch_phase<11>(p, l, grid, stream);
    }
#else
    static bool attr_set = false;
    if (!attr_set) { (void)hipFuncSetAttribute((const void*)k_fwd, hipFuncAttributeMaxDynamicSharedMemorySize, LDS_BYTES); attr_set = true; }
    hipLaunchKernelGGL(k_fwd, dim3(grid), dim3(NT_), LDS_BYTES, stream, p);
#endif
}
```
